# Optimizing an MI355X kernel written in HIP

```python
import math
import jax, jax.numpy as jnp
from jax import lax
import numpy as np

D_MODEL = 1024
BATCH = 2
SEQ = 8192
DEPTH = 4
DEC_BATCH = 32
DEC_SEQ = 1
PAST_LEN = 8192
PAGE_SIZE = 128

N_RG_LAYERS = DEPTH // 2
N_ATT_LAYERS = DEPTH - N_RG_LAYERS
LRU_WIDTH = D_MODEL
N_GATE_BLOCKS = 8
GATE_BLOCK = LRU_WIDTH // N_GATE_BLOCKS
CONV_WIDTH = 4
LRU_C = 8.0
N_HEADS = 8
HEAD_DIM = D_MODEL // N_HEADS
N_KV_HEADS = 4
KV_DIM = N_KV_HEADS * HEAD_DIM
ROT_DIM = HEAD_DIM // 4
ROPE_THETA = 500000.0
MOBA_BLOCK = 256
MOBA_TOPK = 3
Q_CHUNK = 32
D_FF = -(-8 * D_MODEL // (3 * 256)) * 256
EPS = 1e-6
NEG = -1e30

kernel_name = "yoco_griffin_moba_decoder_step"


def rmsnorm(x, g):
    xf = x.astype(jnp.float32)
    y = xf * lax.rsqrt(jnp.mean(xf * xf, axis=-1, keepdims=True) + EPS)
    return (y * g.astype(jnp.float32)).astype(x.dtype)


def partial_rope(x, pos):
    half = ROT_DIM // 2
    inv = ROPE_THETA ** (-jnp.arange(half, dtype=jnp.float32) / half)
    ang = pos.astype(jnp.float32)[:, None] * inv[None, :]
    cos = jnp.cos(ang)[:, None, :]
    sin = jnp.sin(ang)[:, None, :]
    xr = x[..., :ROT_DIM].astype(jnp.float32)
    x1, x2 = xr[..., :half], xr[..., half:]
    rot = jnp.concatenate([x1 * cos - x2 * sin, x2 * cos + x1 * sin], axis=-1).astype(x.dtype)
    return jnp.concatenate([rot, x[..., ROT_DIM:]], axis=-1)


def swiglu_ffn(x, g, w_in, w_out):
    h = rmsnorm(x, g) @ w_in
    gate, up = h[..., :D_FF], h[..., D_FF:]
    return x + (jax.nn.silu(gate) * up) @ w_out


def causal_conv(u, conv_state, w, b):
    T = u.shape[1]
    ext = jnp.concatenate([conv_state.astype(u.dtype), u], axis=1)
    out = b + ext[:, 0:T] * w[0]
    for j in range(1, CONV_WIDTH):
        out = out + ext[:, j:j + T] * w[j]
    return out, ext[:, T:]


def rglru(xc, h0, wa, ba, wi, bi, lam):
    B, T, C = xc.shape
    xb = xc.reshape(B, T, N_GATE_BLOCKS, GATE_BLOCK)
    r = jax.nn.sigmoid(jnp.einsum('btnc,ncd->btnd', xb, wa).reshape(B, T, C) + ba)
    i = jax.nn.sigmoid(jnp.einsum('btnc,ncd->btnd', xb, wi).reshape(B, T, C) + bi)
    log_a = (-LRU_C * r.astype(jnp.float32)) * jax.nn.softplus(-lam.astype(jnp.float32))
    a = jnp.exp(log_a)
    b = jnp.sqrt(-jnp.expm1(2.0 * log_a)) * (i * xc).astype(jnp.float32)
    b = b.at[:, 0].add(a[:, 0] * h0.astype(jnp.float32))

    def combine(left, right):
        return (left[0] * right[0], right[0] * left[1] + right[1])

    _, h = lax.associative_scan(combine, (a, b), axis=1)
    return h, h[:, -1]


def recurrent_block(x, conv_state, h0, g, w_in, conv_w, conv_b, wa, ba, wi, bi, lam, w_out):
    xn = rmsnorm(x, g)
    proj = xn @ w_in
    gate, u = proj[..., :LRU_WIDTH], proj[..., LRU_WIDTH:]
    uc, new_conv = causal_conv(u, conv_state, conv_w, conv_b)
    h, h_last = rglru(uc, h0, wa, ba, wi, bi, lam)
    y = (h.astype(x.dtype) * jax.nn.gelu(gate)) @ w_out
    return x + y, new_conv, h_last.astype(x.dtype)


def shared_kv(x, pos, g_kv, w_kv):
    B, T, _ = x.shape
    kv = rmsnorm(x, g_kv) @ w_kv
    k = kv[..., :KV_DIM].reshape(B, T, N_KV_HEADS, HEAD_DIM)
    v = kv[..., KV_DIM:].reshape(B, T, N_KV_HEADS, HEAD_DIM)
    return partial_rope(k, pos), v


def to_blocks(k, v):
    B, L = k.shape[:2]
    nb = -(-L // MOBA_BLOCK)
    pad = nb * MOBA_BLOCK - L
    widths = ((0, 0), (0, pad), (0, 0), (0, 0))
    kb = jnp.pad(k, widths).reshape(B, nb, MOBA_BLOCK, N_KV_HEADS, HEAD_DIM)
    vb = jnp.pad(v, widths).reshape(B, nb, MOBA_BLOCK, N_KV_HEADS, HEAD_DIM)
    km = jnp.mean(kb.astype(jnp.float32), axis=2)
    return kb, vb, km


def moba_chunk(q, qpos, kb, vb, km, topk):
    B, NB = kb.shape[:2]
    Tq = q.shape[1]
    grp = N_HEADS // N_KV_HEADS
    means_h = jnp.repeat(km, grp, axis=2)
    own = qpos // MOBA_BLOCK
    gate = jnp.einsum('bqhd,bnhd->bqhn', q.astype(jnp.float32), means_h)
    past = jnp.arange(NB)[None, :] < own[:, None]
    gate = jnp.where(past[None, :, None, :], gate, NEG)
    _, sel = lax.top_k(gate, topk)
    sel_ok = jnp.arange(topk)[None, :] < own[:, None]
    own_b = jnp.broadcast_to(own[None, :, None, None], (B, Tq, N_HEADS, 1)).astype(sel.dtype)
    blk = jnp.concatenate([sel, own_b], axis=-1)
    b_idx = jnp.arange(B)[:, None, None, None]
    g_idx = (jnp.arange(N_HEADS) // grp)[None, None, :, None]
    kg = kb[b_idx, blk, :, g_idx, :]
    vg = vb[b_idx, blk, :, g_idx, :]
    logits = jnp.einsum('bqhd,bqhnkd->bqhnk', q, kg,
                        preferred_element_type=jnp.float32) * (1.0 / math.sqrt(HEAD_DIM))
    kpos = blk[..., None] * MOBA_BLOCK + jnp.arange(MOBA_BLOCK)
    slot_ok = jnp.concatenate([sel_ok, jnp.ones((Tq, 1), dtype=bool)], axis=-1)
    mask = slot_ok[None, :, None, :, None] & (kpos <= qpos[None, :, None, None, None])
    logits = jnp.where(mask, logits, NEG)
    p = jax.nn.softmax(logits.reshape(B, Tq, N_HEADS, -1), axis=-1).reshape(logits.shape)
    out = jnp.einsum('bqhnk,bqhnkd->bqhd', p, vg.astype(jnp.float32))
    return out.astype(q.dtype)


def moba_layer(x, pos, kb, vb, km, g, w_q, w_o, chunked):
    B, T, _ = x.shape
    topk = min(MOBA_TOPK, kb.shape[1])
    q = partial_rope((rmsnorm(x, g) @ w_q).reshape(B, T, N_HEADS, HEAD_DIM), pos)
    if chunked:
        nc = T // Q_CHUNK
        qc = q.reshape(B, nc, Q_CHUNK, N_HEADS, HEAD_DIM).transpose(1, 0, 2, 3, 4)
        pc = pos.reshape(nc, Q_CHUNK)
        o = lax.map(lambda a: moba_chunk(a[0], a[1], kb, vb, km, topk), (qc, pc))
        o = o.transpose(1, 0, 2, 3, 4)
    else:
        o = moba_chunk(q, pos, kb, vb, km, topk)
    return x + o.reshape(B, T, N_HEADS * HEAD_DIM) @ w_o


def trunk(x, pos, conv_state, h_state, past_k, past_v, chunked,
          g_mix, g_ffn, w_rg_in, rg_conv_w, rg_conv_b, rg_gate_a_w, rg_gate_a_b,
          rg_gate_i_w, rg_gate_i_b, rg_lambda, w_rg_out, g_kv, w_kv, w_q, w_o,
          w_ffn_in, w_ffn_out, g_final):
    new_conv, new_h = [], []
    k_new = v_new = kb = vb = km = None
    for l in range(DEPTH):
        if l < N_RG_LAYERS:
            x, c, h = recurrent_block(x, conv_state[l], h_state[l], g_mix[l], w_rg_in[l],
                                      rg_conv_w[l], rg_conv_b[l], rg_gate_a_w[l], rg_gate_a_b[l],
                                      rg_gate_i_w[l], rg_gate_i_b[l], rg_lambda[l], w_rg_out[l])
            new_conv.append(c)
            new_h.append(h)
        else:
            if l == N_RG_LAYERS:
                k_new, v_new = shared_kv(x, pos, g_kv, w_kv)
                if past_k is None:
                    kb, vb, km = to_blocks(k_new, v_new)
                else:
                    kb, vb, km = to_blocks(jnp.concatenate([past_k, k_new], axis=1),
                                           jnp.concatenate([past_v, v_new], axis=1))
            a = l - N_RG_LAYERS
            x = moba_layer(x, pos, kb, vb, km, g_mix[l], w_q[a], w_o[a], chunked)
        x = swiglu_ffn(x, g_ffn[l], w_ffn_in[l], w_ffn_out[l])
    return rmsnorm(x, g_final), jnp.stack(new_conv), jnp.stack(new_h), k_new, v_new


def setup_inputs(seed: int = 0) -> dict:
    key = jax.random.key(seed)
    ks = jax.random.split(key, 32)
    f32 = jnp.float32
    n_pages = PAST_LEN // PAGE_SIZE
    n_used = DEC_BATCH * n_pages
    n_pool = n_used + max(1, n_used // 4)
    page_table = jax.random.permutation(ks[0], n_pool)[:n_used].astype(jnp.int32).reshape(DEC_BATCH, n_pages)

    def nrm(k, shape, scale):
        return jax.random.normal(k, shape, f32) * scale

    a_base = jax.random.uniform(ks[1], (N_RG_LAYERS, LRU_WIDTH), f32, 0.9, 0.999)
    s = a_base ** (1.0 / LRU_C)
    rg_lambda = jnp.log(s) - jnp.log1p(-s)
    return {
        "x_prompt": nrm(ks[2], (BATCH, SEQ, D_MODEL), 1.0),
        "x_sample": nrm(ks[3], (DEC_BATCH, DEC_SEQ, D_MODEL), 1.0),
        "cache_k": nrm(ks[4], (n_pool, PAGE_SIZE, N_KV_HEADS, HEAD_DIM), 1.0),
        "cache_v": nrm(ks[5], (n_pool, PAGE_SIZE, N_KV_HEADS, HEAD_DIM), 1.0),
        "state_conv": nrm(ks[6], (N_RG_LAYERS, DEC_BATCH, CONV_WIDTH - 1, LRU_WIDTH), 1.0),
        "state_h": nrm(ks[7], (N_RG_LAYERS, DEC_BATCH, LRU_WIDTH), 0.5),
        "page_table": page_table,
        "g_mix": 1.0 + nrm(ks[8], (DEPTH, D_MODEL), 0.02),
        "g_ffn": 1.0 + nrm(ks[9], (DEPTH, D_MODEL), 0.02),
        "w_rg_in": nrm(ks[10], (N_RG_LAYERS, D_MODEL, 2 * LRU_WIDTH), D_MODEL ** -0.5),
        "rg_conv_w": nrm(ks[11], (N_RG_LAYERS, CONV_WIDTH, LRU_WIDTH), CONV_WIDTH ** -0.5),
        "rg_conv_b": nrm(ks[12], (N_RG_LAYERS, LRU_WIDTH), 0.05),
        "rg_gate_a_w": nrm(ks[13], (N_RG_LAYERS, N_GATE_BLOCKS, GATE_BLOCK, GATE_BLOCK), GATE_BLOCK ** -0.5),
        "rg_gate_a_b": nrm(ks[14], (N_RG_LAYERS, LRU_WIDTH), 0.05),
        "rg_gate_i_w": nrm(ks[15], (N_RG_LAYERS, N_GATE_BLOCKS, GATE_BLOCK, GATE_BLOCK), GATE_BLOCK ** -0.5),
        "rg_gate_i_b": nrm(ks[16], (N_RG_LAYERS, LRU_WIDTH), 0.05),
        "rg_lambda": rg_lambda,
        "w_rg_out": nrm(ks[17], (N_RG_LAYERS, LRU_WIDTH, D_MODEL), LRU_WIDTH ** -0.5),
        "g_kv": 1.0 + nrm(ks[18], (D_MODEL,), 0.02),
        "w_kv": nrm(ks[19], (D_MODEL, 2 * KV_DIM), D_MODEL ** -0.5),
        "w_q": nrm(ks[20], (N_ATT_LAYERS, D_MODEL, N_HEADS * HEAD_DIM), D_MODEL ** -0.5),
        "w_o": nrm(ks[21], (N_ATT_LAYERS, N_HEADS * HEAD_DIM, D_MODEL), (N_HEADS * HEAD_DIM) ** -0.5),
        "w_ffn_in": nrm(ks[22], (DEPTH, D_MODEL, 2 * D_FF), D_MODEL ** -0.5),
        "w_ffn_out": nrm(ks[23], (DEPTH, D_FF, D_MODEL), D_FF ** -0.5),
        "g_final": 1.0 + nrm(ks[24], (D_MODEL,), 0.02),
    }


def reference(x_prompt, x_sample, cache_k, cache_v, state_conv, state_h, page_table,
              g_mix, g_ffn, w_rg_in, rg_conv_w, rg_conv_b, rg_gate_a_w, rg_gate_a_b,
              rg_gate_i_w, rg_gate_i_b, rg_lambda, w_rg_out, g_kv, w_kv, w_q, w_o,
              w_ffn_in, w_ffn_out, g_final):
    weights = (g_mix, g_ffn, w_rg_in, rg_conv_w, rg_conv_b, rg_gate_a_w, rg_gate_a_b,
               rg_gate_i_w, rg_gate_i_b, rg_lambda, w_rg_out, g_kv, w_kv, w_q, w_o,
               w_ffn_in, w_ffn_out, g_final)
    B, S, _ = x_prompt.shape
    pos_p = jnp.arange(S, dtype=jnp.int32)
    conv0 = jnp.zeros((N_RG_LAYERS, B, CONV_WIDTH - 1, LRU_WIDTH), x_prompt.dtype)
    h0 = jnp.zeros((N_RG_LAYERS, B, LRU_WIDTH), x_prompt.dtype)
    y_prompt, p_conv, p_h, p_k, p_v = trunk(x_prompt, pos_p, conv0, h0, None, None, True, *weights)
    DB, T, _ = x_sample.shape
    past_len = page_table.shape[1] * PAGE_SIZE
    pos_s = past_len + jnp.arange(T, dtype=jnp.int32)
    past_k = cache_k[page_table].reshape(DB, past_len, N_KV_HEADS, HEAD_DIM)
    past_v = cache_v[page_table].reshape(DB, past_len, N_KV_HEADS, HEAD_DIM)
    y_sample, s_conv, s_h, s_k, s_v = trunk(x_sample, pos_s, state_conv, state_h, past_k, past_v,
                                            False, *weights)
    return (y_prompt, y_sample, p_conv, p_h, p_k, p_v, s_conv, s_h, s_k, s_v)
```

```cpp
#include <hip/hip_runtime.h>
#include <cstdio>
#include <cstdint>
#include <cstring>
#define MK_MULTI 1
namespace pg8 {
#define PG8_LAS __attribute__((address_space(3)))
typedef unsigned short bf16_t;
typedef short bf16x8 __attribute__((ext_vector_type(8)));
typedef float f32x4 __attribute__((ext_vector_type(4)));
typedef unsigned u32x4 __attribute__((ext_vector_type(4)));
constexpr int BM = 256, BK = 64, HALF = 128, HTB = HALF * BK * 2  , STAGE_BYTES = 8 * HTB, NXCD = 8, WGM = 8;

__host__ __device__ __forceinline__ int lds_byte(int r, int c) { const int st = (r >> 4) * 2 + (c >> 5), rr = r & 15, cc = c & 31, ob = rr * 64 + cc * 2; return st * 1024 + (ob ^ (((ob >> 9) & 1) << 5)); }
__host__ __device__ __forceinline__ void stage_rc(int b, int& R, int& C) { const int st = b / 1024, sb = b % 1024, swz = sb ^ (((sb >> 9) & 1) << 5); R = (st >> 1) * 16 + swz / 64; C = (st & 1) * 32 + (swz % 64) / 2; }
__host__ __device__ __forceinline__ int perm32(int rho) { const int n = rho >> 4, i = rho & 15; return 8 * (i >> 2) + 4 * n + (i & 3); }

struct Unit { int pm, pn; };
struct Gemm { const bf16_t* A; const bf16_t* Bt; int M, N, K; };

struct StaticOrder {
    int nM, nN, nwg, G, c;
    __host__ __device__ void init(int M, int N, int G_, int c_) { nM = M / BM; nN = N / BM; nwg = nM * nN; G = G_; c = c_; }
    __host__ __device__ bool next(int i, Unit& u) const {
        const long L = (long)i * G + c; if (L >= nwg) return false;
        int wgid = (int)L; { const int q = nwg / NXCD, r = nwg % NXCD, xcd = wgid % NXCD, off = wgid / NXCD; wgid = (xcd < r ? xcd * (q + 1) : r * (q + 1) + (xcd - r) * q) + off; }
        const int nig = WGM * nN, gid = wgid / nig, fm = gid * WGM, gsz = (nM - fm) < WGM ? (nM - fm) : WGM;
        u.pm = fm + ((wgid % nig) % gsz); u.pn = (wgid % nig) / gsz; return true;
    }
    __device__ __forceinline__ void a_ready(const Unit&) const {}
    __device__ __forceinline__ void done(const Unit&) const {}
};


__device__ __forceinline__ unsigned cvt_pk_bf16(float lo, float hi) { unsigned r; asm volatile("v_cvt_pk_bf16_f32 %0, %1, %2" : "=v"(r) : "v"(lo), "v"(hi)); return r; }
typedef float f32x2 __attribute__((ext_vector_type(2)));
typedef unsigned u32x2 __attribute__((ext_vector_type(2)));
constexpr float RMS_EPS = 1e-6f;
__device__ __forceinline__ float fast_rcp(float x) { return __builtin_amdgcn_rcpf(x); }
__device__ __forceinline__ float fast_exp2(float x) { return __builtin_amdgcn_exp2f(x); }
__device__ __forceinline__ float sigmoidf_(float z) { return fast_rcp(1.0f + fast_exp2(-1.44269504089f * z)); }
__device__ __forceinline__ float gelu_tanh(float x) { const float z = 1.5957691216057308f * (x + 0.044715f * x * x * x); return x * sigmoidf_(z); }
__device__ __forceinline__ float silu_(float x) { return x * sigmoidf_(x); }
typedef unsigned long long rss_t;
constexpr float RSS_SCALE = 16777216.0f, RSS_INV = 1.0f / (16777216.0f * 1024.0f);
__device__ __forceinline__ float row_rs(const rss_t* rowss, int r) { return 1.0f / sqrtf((float)rowss[r] * RSS_INV + RMS_EPS); }

struct EpiRgIn {
    static constexpr bool PERM = true, AFTER_DRAIN = false;
    const rss_t* rowss; bf16_t* gate; bf16_t* u; float* pconv;
    __device__ __forceinline__ void operator()(const f32x4 (&acc)[2][2][4][2], const Unit& un, int wr, int wc, int fr, int fq) const {
        const bool isU = un.pn >= 4; const int colb = (un.pn & 3) * BM + wc * 32 + 8 * fq;
#pragma unroll
        for (int ai = 0; ai < 2; ++ai)
#pragma unroll
            for (int m = 0; m < 4; ++m) { const int r = un.pm * BM + ai * HALF + wr * 64 + m * 16 + fr; const float rs = row_rs(rowss, r);
#pragma unroll
                for (int bj = 0; bj < 2; ++bj) { f32x4 v0 = acc[ai][bj][m][0] * rs, v1 = acc[ai][bj][m][1] * rs; const int c = colb + bj * HALF;
                    if (!isU) {
#pragma unroll
                        for (int j = 0; j < 4; ++j) { v0[j] = gelu_tanh(v0[j]); v1[j] = gelu_tanh(v1[j]); }
                        u32x4 w; w.x = cvt_pk_bf16(v0[0], v0[1]); w.y = cvt_pk_bf16(v0[2], v0[3]); w.z = cvt_pk_bf16(v1[0], v1[1]); w.w = cvt_pk_bf16(v1[2], v1[3]);
                        *(u32x4*)(gate + (size_t)r * 1024 + c) = w;
                    } else {
                        u32x4 w; w.x = cvt_pk_bf16(v0[0], v0[1]); w.y = cvt_pk_bf16(v0[2], v0[3]); w.z = cvt_pk_bf16(v1[0], v1[1]); w.w = cvt_pk_bf16(v1[2], v1[3]);
                        *(u32x4*)(u + (size_t)r * 1024 + c) = w;
                        const int t = r & 8191;
                        if (t >= 8189) { float* pc = pconv + (size_t)((r >> 13) * 3 + (t - 8189)) * 1024 + c; *(f32x4*)pc = v0; *(f32x4*)(pc + 4) = v1; }
                    } } }
    }
};

struct EpiResid {
    static constexpr bool PERM = true, AFTER_DRAIN = false;
    const float* xin; float* xout; bf16_t* xb; rss_t* rowss_out;
    __device__ __forceinline__ void operator()(const f32x4 (&acc)[2][2][4][2], const Unit& un, int wr, int wc, int fr, int fq) const {
        const int colb = un.pn * BM + wc * 32 + 8 * fq;
#pragma unroll
        for (int ai = 0; ai < 2; ++ai)
#pragma unroll
            for (int m = 0; m < 4; ++m) { const int r = un.pm * BM + ai * HALF + wr * 64 + m * 16 + fr; float ss = 0.f;
#pragma unroll
                for (int bj = 0; bj < 2; ++bj) { const size_t off = (size_t)r * 1024 + colb + bj * HALF;
                    const f32x4 x0 = *(const f32x4*)(xin + off) + acc[ai][bj][m][0], x1 = *(const f32x4*)(xin + off + 4) + acc[ai][bj][m][1];
                    *(f32x4*)(xout + off) = x0; *(f32x4*)(xout + off + 4) = x1;
                    u32x4 w; w.x = cvt_pk_bf16(x0[0], x0[1]); w.y = cvt_pk_bf16(x0[2], x0[3]); w.z = cvt_pk_bf16(x1[0], x1[1]); w.w = cvt_pk_bf16(x1[2], x1[3]);
                    *(u32x4*)(xb + off) = w;
                    ss += (x0[0] * x0[0] + x0[1] * x0[1]) + (x0[2] * x0[2] + x0[3] * x0[3]) + (x1[0] * x1[0] + x1[1] * x1[1]) + (x1[2] * x1[2] + x1[3] * x1[3]); }
                ss += __shfl_xor(ss, 16); ss += __shfl_xor(ss, 32);
                if (fq == 0) atomicAdd(rowss_out + r, (rss_t)(ss * RSS_SCALE));
                asm volatile("" ::: "memory"); }
    }
};

struct EpiFfnIn {
    static constexpr bool PERM = true, AFTER_DRAIN = false;
    const rss_t* rowss; bf16_t* act;
    __device__ __forceinline__ void operator()(const f32x4 (&acc)[2][2][4][2], const Unit& un, int wr, int wc, int fr, int fq) const {
        const int colb = un.pn * HALF + wc * 32 + 8 * fq;
#pragma unroll
        for (int ai = 0; ai < 2; ++ai)
#pragma unroll
            for (int m = 0; m < 4; ++m) { const int r = un.pm * BM + ai * HALF + wr * 64 + m * 16 + fr; const float rs = row_rs(rowss, r);
                f32x4 g0 = acc[ai][0][m][0] * rs, g1 = acc[ai][0][m][1] * rs; const f32x4 u0 = acc[ai][1][m][0] * rs, u1 = acc[ai][1][m][1] * rs;
#pragma unroll
                for (int j = 0; j < 4; ++j) { g0[j] = silu_(g0[j]) * u0[j]; g1[j] = silu_(g1[j]) * u1[j]; }
                u32x4 w; w.x = cvt_pk_bf16(g0[0], g0[1]); w.y = cvt_pk_bf16(g0[2], g0[3]); w.z = cvt_pk_bf16(g1[0], g1[1]); w.w = cvt_pk_bf16(g1[2], g1[3]);
                *(u32x4*)(act + (size_t)r * 2816 + colb) = w; }
    }
};

constexpr float QSCALE = 0.08838834764831845f * 1.4426950408889634f;
struct EpiQkv {
    static constexpr bool PERM = false, AFTER_DRAIN = false;
    const rss_t* rowss; bf16_t* q; bf16_t* kb; bf16_t* vt; float* pk; float* pv; float* km;
    __device__ __forceinline__ void operator()(const f32x4 (&acc)[2][2][4][2], const Unit& un, int wr, int wc, int fr, int fq) const {
        const int kind = un.pn < 4 ? 0 : (un.pn < 6 ? 1 : 2);
        float inv[4];
#pragma unroll
        for (int i = 0; i < 4; ++i) inv[i] = fast_exp2(-(float)(4 * fq + i) * (18.931568569324174f / 16.0f)) * 0.15915494309189535f;
        f32x4 cs[2][2];
#pragma unroll
        for (int bj = 0; bj < 2; ++bj)
#pragma unroll
            for (int n = 0; n < 2; ++n) cs[bj][n] = (f32x4){0.f, 0.f, 0.f, 0.f};
#pragma unroll
        for (int ai = 0; ai < 2; ++ai)
#pragma unroll
            for (int m = 0; m < 4; ++m) { const int r = un.pm * BM + ai * HALF + wr * 64 + m * 16 + fr; const float rs = row_rs(rowss, r); const int t = r & 8191, b = r >> 13;
                float co[4], si[4];
                if (kind < 2 && wc == 0) {
#pragma unroll
                    for (int i = 0; i < 4; ++i) { float rev = (float)t * inv[i]; rev = rev - floorf(rev); co[i] = __builtin_amdgcn_cosf(rev); si[i] = __builtin_amdgcn_sinf(rev); } }
#pragma unroll
                for (int bj = 0; bj < 2; ++bj) { f32x4 v0 = acc[ai][bj][m][0] * rs, v1 = acc[ai][bj][m][1] * rs;
                    if (kind < 2 && wc == 0) {
#pragma unroll
                        for (int i = 0; i < 4; ++i) { const float x1 = v0[i], x2 = v1[i]; v0[i] = x1 * co[i] - x2 * si[i]; v1[i] = x2 * co[i] + x1 * si[i]; } }
                    const int d0 = wc * 32 + 4 * fq;
                    if (kind == 0) { const int h = un.pn * 2 + bj; bf16_t* qp = q + (size_t)r * 1024 + h * 128 + d0;
                        u32x2 w0, w1; w0.x = cvt_pk_bf16(v0[0] * QSCALE, v0[1] * QSCALE); w0.y = cvt_pk_bf16(v0[2] * QSCALE, v0[3] * QSCALE); w1.x = cvt_pk_bf16(v1[0] * QSCALE, v1[1] * QSCALE); w1.y = cvt_pk_bf16(v1[2] * QSCALE, v1[3] * QSCALE);
                        *(u32x2*)qp = w0; *(u32x2*)(qp + 16) = w1;
                    } else if (kind == 1) { const int g = (un.pn - 4) * 2 + bj; const size_t o = ((size_t)r * 4 + g) * 128 + d0;
                        *(f32x4*)(pk + o) = v0; *(f32x4*)(pk + o + 16) = v1;
                        u32x2 w0, w1; w0.x = cvt_pk_bf16(v0[0], v0[1]); w0.y = cvt_pk_bf16(v0[2], v0[3]); w1.x = cvt_pk_bf16(v1[0], v1[1]); w1.y = cvt_pk_bf16(v1[2], v1[3]);
                        *(u32x2*)(kb + o) = w0; *(u32x2*)(kb + o + 16) = w1;
                        cs[bj][0] += v0; cs[bj][1] += v1;
                    } else { const int g = (un.pn - 6) * 2 + bj; const size_t o = ((size_t)r * 4 + g) * 128 + d0;
                        *(f32x4*)(pv + o) = v0; *(f32x4*)(pv + o + 16) = v1;
                        bf16_t* vp = vt + ((size_t)(b * 4 + g) * 128 + d0) * 8192 + t;
#pragma unroll
                        for (int i = 0; i < 4; ++i) { vp[(size_t)i * 8192] = (bf16_t)(cvt_pk_bf16(v0[i], 0.f) & 0xffffu); vp[(size_t)(16 + i) * 8192] = (bf16_t)(cvt_pk_bf16(v1[i], 0.f) & 0xffffu); }
                    } } }
        if (kind == 1) {
            const int b = un.pm >> 5, blk = un.pm & 31;
#pragma unroll
            for (int bj = 0; bj < 2; ++bj)
#pragma unroll
                for (int n = 0; n < 2; ++n)
#pragma unroll
                    for (int i = 0; i < 4; ++i) { float s = cs[bj][n][i]; s += __shfl_xor(s, 1); s += __shfl_xor(s, 2); s += __shfl_xor(s, 4); s += __shfl_xor(s, 8);
                        if (fr == 0) unsafeAtomicAdd(km + (size_t)(b * 32 + blk) * 512 + ((un.pn - 4) * 2 + bj) * 128 + wc * 32 + 16 * n + 4 * fq + i, s * (1.0f / 256.0f)); }
        }
    }
};
template <class Epi, class Sched, bool ALIGN_EPI = false, bool SP2 = false>
__device__ __forceinline__ void gemm_phase(PG8_LAS unsigned char* lds, const Gemm g, const Sched& S, const Epi& E) {
    int tid_l = threadIdx.x; asm volatile("" : "+v"(tid_l));
    const int tid = tid_l, wid = __builtin_amdgcn_readfirstlane(tid >> 6), lane = tid & 63, wr = wid >> 2, wc = wid & 3, fr = lane & 15, fq = lane >> 4;
    const int K = g.K, nt = K / BK;
    unsigned voffA[2], voffB[2];
#pragma unroll
    for (int i = 0; i < 2; ++i) { int R, C; stage_rc(tid * 16 + i * 8192, R, C); const int Rb = Epi::PERM ? ((R & ~31) + perm32(R & 31)) : R;
        voffA[i] = (unsigned)(R * K + C) * 2u; voffB[i] = (unsigned)(Rb * K + C) * 2u; }
    const size_t kstep = (size_t)(BK * 2);
    const size_t hstep = (size_t)HALF * K * 2;
    const size_t tstep = 2 * hstep;
    const unsigned ldsw = (unsigned)wid * 1024u;
    const int aoff = lds_byte(wr * 64 + fr, fq * 8), boff = lds_byte(wc * 32 + fr, fq * 8);
#define PG8_SA(b, h) (((b) * 2 + (h)) * HTB)
#define PG8_SB(b, h) ((4 + (b) * 2 + (h)) * HTB)
#define PG8_STAGE(bufoff, gbase, voff) do { _Pragma("unroll") for (int _i = 0; _i < 2; ++_i) \
        __builtin_amdgcn_global_load_lds((const unsigned*)((const char*)(gbase) + (voff)[_i]), (PG8_LAS unsigned*)(lds + (bufoff) + ldsw + _i * 8192), 16, 0, 0); } while (0)
#define PG8_LDA(dst, b, h) do { _Pragma("unroll") for (int m = 0; m < 4; ++m) _Pragma("unroll") for (int k = 0; k < 2; ++k) dst[m][k] = *(const PG8_LAS bf16x8*)(lds + PG8_SA(b, h) + aoff + m * 2048 + k * 1024); } while (0)
#define PG8_LDB(dst, b, h) do { _Pragma("unroll") for (int n = 0; n < 2; ++n) _Pragma("unroll") for (int k = 0; k < 2; ++k) dst[n][k] = *(const PG8_LAS bf16x8*)(lds + PG8_SB(b, h) + boff + n * 2048 + k * 1024); } while (0)
#define PG8_MMA(ai, bj, At, Bt) do { __builtin_amdgcn_s_setprio(1); _Pragma("unroll") for (int m = 0; m < 4; ++m) _Pragma("unroll") for (int n = 0; n < 2; ++n) _Pragma("unroll") for (int k = 0; k < 2; ++k) \
        acc[ai][bj][m][n] = __builtin_amdgcn_mfma_f32_16x16x32_bf16(Bt[n][k], At[m][k], acc[ai][bj][m][n], 0, 0, 0); __builtin_amdgcn_s_setprio(0); } while (0)
#define PG8_WAIT_V(n) asm volatile("s_waitcnt vmcnt(" #n ")" ::: "memory")
#define PG8_WAIT_L(n) asm volatile("s_waitcnt lgkmcnt(" #n ")" ::: "memory")
#define PG8_BAR __builtin_amdgcn_s_barrier()
#define PG8_SCHED __builtin_amdgcn_sched_barrier(0)
    Unit cur, nxt; int ui = 0;
    if (!S.next(0, cur)) return;
    f32x4 acc[2][2][4][2];
#pragma unroll
    for (int a = 0; a < 2; ++a)
#pragma unroll
        for (int b = 0; b < 2; ++b)
#pragma unroll
            for (int m = 0; m < 4; ++m)
#pragma unroll
                for (int n = 0; n < 2; ++n) acc[a][b][m][n] = (f32x4){0.f, 0.f, 0.f, 0.f};
    bf16x8 At[4][2], B0[2][2], B1[2][2];
    const char* cA = (const char*)g.A + (size_t)cur.pm * tstep; const char* cB = (const char*)g.Bt + (size_t)cur.pn * tstep;
    S.a_ready(cur);
    if constexpr (SP2) {
        PG8_STAGE(PG8_SB(0, 0), cB, voffB); PG8_STAGE(PG8_SB(0, 1), cB + hstep, voffB); PG8_STAGE(PG8_SA(0, 0), cA, voffA); PG8_STAGE(PG8_SA(0, 1), cA + hstep, voffA);
        if (wr == 1) PG8_BAR;
        PG8_WAIT_V(2); PG8_BAR;
        PG8_STAGE(PG8_SB(1, 0), cB + kstep, voffB); PG8_STAGE(PG8_SA(1, 0), cA + kstep, voffA); PG8_STAGE(PG8_SB(1, 1), cB + hstep + kstep, voffB);
        PG8_WAIT_V(6); PG8_BAR;
    } else {
        PG8_STAGE(PG8_SB(0, 0), cB, voffB); PG8_STAGE(PG8_SA(0, 0), cA, voffA); PG8_STAGE(PG8_SB(0, 1), cB + hstep, voffB); PG8_STAGE(PG8_SA(0, 1), cA + hstep, voffA);
        if (wr == 1) PG8_BAR;
        PG8_WAIT_V(4); PG8_BAR;
        PG8_STAGE(PG8_SB(1, 0), cB + kstep, voffB); PG8_STAGE(PG8_SA(1, 0), cA + kstep, voffA); PG8_STAGE(PG8_SB(1, 1), cB + hstep + kstep, voffB);
        PG8_WAIT_V(6); PG8_BAR;
    }
    for (;;) {
        const bool has_next = S.next(ui + 1, nxt);
        const char* nA = has_next ? (const char*)g.A + (size_t)nxt.pm * tstep : cA; const char* nB = has_next ? (const char*)g.Bt + (size_t)nxt.pn * tstep : cB;
        for (int t = 0; t < nt; t += 2) {
            const bool last = (t == nt - 2);
            const char* a1 = cA + (size_t)(t + 1) * kstep;
            const char* a2 = last ? nA : cA + (size_t)(t + 2) * kstep; const char* b2 = last ? nB : cB + (size_t)(t + 2) * kstep;
            const char* a3 = a2 + kstep; const char* b3 = b2 + kstep;
            if (last && has_next) S.a_ready(nxt);
            if constexpr (SP2) {
            PG8_LDB(B0, 0, 0); PG8_LDB(B1, 0, 1); PG8_SCHED; PG8_LDA(At, 0, 0); PG8_STAGE(PG8_SA(1, 1), a1 + hstep, voffA);
            PG8_WAIT_V(8); PG8_WAIT_L(0); PG8_BAR; PG8_MMA(0, 0, At, B0); PG8_MMA(0, 1, At, B1); PG8_BAR; PG8_SCHED;
            PG8_LDA(At, 0, 1); PG8_STAGE(PG8_SB(0, 0), b2, voffB); PG8_STAGE(PG8_SB(0, 1), b2 + hstep, voffB); PG8_STAGE(PG8_SA(0, 0), a2, voffA);
            PG8_WAIT_V(8); PG8_WAIT_L(0); PG8_BAR; PG8_MMA(1, 0, At, B0); PG8_MMA(1, 1, At, B1); PG8_BAR; PG8_SCHED;
            PG8_LDB(B0, 1, 0); PG8_LDB(B1, 1, 1); PG8_SCHED; PG8_LDA(At, 1, 0); PG8_STAGE(PG8_SA(0, 1), a2 + hstep, voffA);
            PG8_WAIT_V(8); PG8_WAIT_L(0); PG8_BAR; PG8_MMA(0, 0, At, B0); PG8_MMA(0, 1, At, B1); PG8_BAR; PG8_SCHED;
            PG8_LDA(At, 1, 1); PG8_STAGE(PG8_SB(1, 0), b3, voffB); PG8_STAGE(PG8_SB(1, 1), b3 + hstep, voffB); PG8_STAGE(PG8_SA(1, 0), a3, voffA);
            PG8_WAIT_V(8); PG8_WAIT_L(0); PG8_BAR; PG8_MMA(1, 0, At, B0); PG8_MMA(1, 1, At, B1); PG8_BAR; PG8_SCHED;
            } else {
            PG8_LDB(B0, 0, 0); PG8_SCHED; PG8_LDA(At, 0, 0); PG8_STAGE(PG8_SA(1, 1), a1 + hstep, voffA);
            PG8_WAIT_L(8); PG8_BAR; PG8_WAIT_L(0); PG8_MMA(0, 0, At, B0); PG8_BAR; PG8_SCHED;
            PG8_LDB(B1, 0, 1); PG8_STAGE(PG8_SB(0, 0), b2, voffB);
            PG8_BAR; PG8_WAIT_L(0); PG8_MMA(0, 1, At, B1); PG8_BAR;
            PG8_LDA(At, 0, 1); PG8_STAGE(PG8_SA(0, 0), a2, voffA);
            PG8_BAR; PG8_WAIT_L(0); PG8_MMA(1, 0, At, B0); PG8_BAR; PG8_SCHED;
            PG8_STAGE(PG8_SB(0, 1), b2 + hstep, voffB);
            PG8_WAIT_V(6); PG8_BAR; PG8_MMA(1, 1, At, B1); PG8_BAR;
            PG8_LDB(B0, 1, 0); PG8_SCHED; PG8_LDA(At, 1, 0); PG8_STAGE(PG8_SA(0, 1), a2 + hstep, voffA);
            PG8_WAIT_L(8); PG8_BAR; PG8_WAIT_L(0); PG8_MMA(0, 0, At, B0); PG8_BAR; PG8_SCHED;
            PG8_LDB(B1, 1, 1); PG8_STAGE(PG8_SB(1, 0), b3, voffB);
            PG8_BAR; PG8_WAIT_L(0); PG8_MMA(0, 1, At, B1); PG8_BAR;
            PG8_LDA(At, 1, 1); PG8_STAGE(PG8_SA(1, 0), a3, voffA);
            PG8_BAR; PG8_WAIT_L(0); PG8_MMA(1, 0, At, B0); PG8_BAR; PG8_SCHED;
            PG8_STAGE(PG8_SB(1, 1), b3 + hstep, voffB);
            PG8_WAIT_V(6); PG8_BAR; PG8_MMA(1, 1, At, B1); PG8_BAR;
            }
        }
        if constexpr (ALIGN_EPI) { if (wr == 0) PG8_BAR; }
        if constexpr (!Epi::AFTER_DRAIN) { E(acc, cur, wr, wc, fr, fq); S.done(cur); }
        if (!has_next) break;
#pragma unroll
        for (int a = 0; a < 2; ++a)
#pragma unroll
            for (int b = 0; b < 2; ++b)
#pragma unroll
                for (int m = 0; m < 4; ++m)
#pragma unroll
                    for (int n = 0; n < 2; ++n) acc[a][b][m][n] = (f32x4){0.f, 0.f, 0.f, 0.f};
        cur = nxt; cA = nA; cB = nB; ++ui;
        if constexpr (ALIGN_EPI) { if (wr == 1) PG8_BAR; }
    }
    PG8_WAIT_V(0);
    if constexpr (!ALIGN_EPI) { if (wr == 0) PG8_BAR; }
    PG8_BAR;
    if constexpr (Epi::AFTER_DRAIN) { E.fused(acc, cur, wr, wc, fr, fq, lds, wid, lane); S.done(cur); }
#undef PG8_SA
#undef PG8_SB
#undef PG8_STAGE
#undef PG8_LDA
#undef PG8_LDB
#undef PG8_MMA
#undef PG8_WAIT_V
#undef PG8_WAIT_L
#undef PG8_BAR
#undef PG8_SCHED
}
}
#define GAS __attribute__((address_space(1)))
#define LAS __attribute__((address_space(3)))
typedef unsigned short bf16;
typedef unsigned v4u __attribute__((ext_vector_type(4)));
typedef float f32x4 __attribute__((ext_vector_type(4)));
typedef short bf16x8 __attribute__((ext_vector_type(8)));
typedef GAS unsigned gu32;
typedef GAS unsigned long long gu64;
#define RLX_AGENT __ATOMIC_RELAXED, __HIP_MEMORY_SCOPE_AGENT
#define LDS_WAIT() asm volatile("s_waitcnt lgkmcnt(0)" ::: "memory")
#define VM_WAIT() asm volatile("s_waitcnt vmcnt(0)" ::: "memory")
__device__ __forceinline__ unsigned long long rt() { return __builtin_amdgcn_s_memrealtime(); }
__device__ __forceinline__ unsigned f2bf(float f) { unsigned u = __builtin_bit_cast(unsigned, f); return (u + 0x7fffu + ((u >> 16) & 1u)) >> 16; }
__device__ __forceinline__ unsigned pk2(float lo, float hi) { return f2bf(lo) | (f2bf(hi) << 16); }

#define XB_TMO      128
#define XB_XCNT(j)  (256  + 64 * (j))
#define XB_XSUB(j)  (1280 + 64 * (j))
#define XB_XGEN(j)  (2304 + 64 * (j))
#define XB_TOP      3328
#define XB_TOPGEN   3392
#define XCD_BAR_WORDS 3456
#define XB_SPIN_CAP (1u << 18)

__device__ __forceinline__ unsigned xb_ld(unsigned* p)              { return __hip_atomic_load(p, __ATOMIC_RELAXED, __HIP_MEMORY_SCOPE_AGENT); }
__device__ __forceinline__ unsigned xb_add(unsigned* p, unsigned v) { return __hip_atomic_fetch_add(p, v, __ATOMIC_RELAXED, __HIP_MEMORY_SCOPE_AGENT); }
__device__ __forceinline__ unsigned xb_xcc_id() { return (unsigned)__builtin_amdgcn_s_getreg((3 << 11) | 20) & 0xFu; }
#define XB_SPIN(cond, bar) do { unsigned _sp = 0; while (cond) { __builtin_amdgcn_s_sleep(1); \
    if ((++_sp & 255u) == 0u) { if (xb_ld(&(bar)[XB_TMO])) break; if (_sp > XB_SPIN_CAP) { atomicAdd(&(bar)[XB_TMO], 1u); break; } } } } while (0)

struct XcdBarrier {
    unsigned* bar; unsigned x;
    volatile LAS unsigned* st;
};

__device__ __forceinline__ XcdBarrier xcd_barrier_post(unsigned* bar, volatile LAS unsigned* st) {
    XcdBarrier b; b.bar = bar; b.x = xb_xcc_id(); b.st = st;
    if (threadIdx.x == 0) (void)xb_add(&bar[XB_XCNT(b.x)], 1u);
    return b;
}
__device__ __forceinline__ void xcd_barrier_complete(unsigned* bar, unsigned x, unsigned& nloc, unsigned& nx) {
    const unsigned G = gridDim.x * gridDim.y * gridDim.z;
    unsigned sum, cnt, mine, sp = 0u;
    for (;;) {
        sum = 0u; cnt = 0u; mine = 0u;
#pragma unroll
        for (unsigned j = 0; j < 16; ++j) { const unsigned c = xb_ld(&bar[XB_XCNT(j)]); sum += c; cnt += (c > 0u) ? 1u : 0u; mine = (j == x) ? c : mine; }
        if (sum == G) break;
        __builtin_amdgcn_s_sleep(1);
        if ((++sp & 255u) == 0u) { if (xb_ld(&bar[XB_TMO])) break; if (sp > XB_SPIN_CAP) { atomicAdd(&bar[XB_TMO], 1u); break; } }
    }
    nloc = mine > 0u ? mine : 1u; nx = cnt > 0u ? cnt : 1u;
}

__device__ __forceinline__ void xcd_barrier(const XcdBarrier& b) {
    asm volatile("s_waitcnt vmcnt(0)" ::: "memory");
    __syncthreads();
    if (threadIdx.x == 0) {
        unsigned* bar = b.bar;
        __builtin_amdgcn_s_waitcnt(0);
        unsigned nloc = b.st[0], nx = b.st[1];
        if (nloc == 0u) { xcd_barrier_complete(bar, b.x, nloc, nx); b.st[0] = nloc; b.st[1] = nx; }
        const unsigned old = xb_add(&bar[XB_XSUB(b.x)], 1u);
        const unsigned gen = old / nloc;
        if (old + 1u == (gen + 1u) * nloc) {
            __builtin_amdgcn_fence(__ATOMIC_RELEASE, "agent");
            asm volatile("s_waitcnt vmcnt(0)" ::: "memory");
            const unsigned og = xb_add(&bar[XB_TOP], 1u);
            const unsigned tg = og / nx;
            if (og + 1u == (tg + 1u) * nx) xb_add(&bar[XB_TOPGEN], 1u);
            else XB_SPIN(xb_ld(&bar[XB_TOPGEN]) == tg, bar);
            __builtin_amdgcn_fence(__ATOMIC_ACQUIRE, "agent");
            xb_add(&bar[XB_XGEN(b.x)], 1u);
            asm volatile("s_waitcnt vmcnt(0)" ::: "memory");
        } else {
            XB_SPIN(xb_ld(&bar[XB_XGEN(b.x)]) == gen, bar);
            __builtin_amdgcn_fence(__ATOMIC_ACQUIRE, "agent");
            asm volatile("s_waitcnt vmcnt(0)" ::: "memory");
        }
    }
    __syncthreads();
}

constexpr int NWAVES = 8, NTHR = 512;
constexpr int D = 1024, T = 8192, NB = 2, M = NB * T, SB = 32, FF = 2816, NF2 = 5632, NH = 8, HD = 128, KVH = 4, KVD = 512;
constexpr int NPG = 64, PAGE = 128;
constexpr int NBLK = 32;
constexpr float EPS = 1e-6f;
constexpr size_t O_YP = 0, O_YS = 16777216, O_PCONV = 16809984, O_PH = 16822272, O_PK = 16826368, O_PV = 25214976, O_SCONV = 33603584, O_SH = 33800192, O_SK = 33865728, O_SV = 33882112, O_END = 33898496;
constexpr size_t MiB = 1u << 20;
constexpr size_t WS_CTL = 0;
constexpr size_t WS_RSS = 1 * MiB;
constexpr size_t WS_RSSS = 2 * MiB + 256 * 1024;
constexpr size_t WS_KM = 2 * MiB + 512 * 1024;
constexpr size_t WS_CNT = 2 * MiB + 768 * 1024;
constexpr size_t ZERO_BYTES = 3 * MiB;
constexpr size_t WS_WRGIN = 4 * MiB;
constexpr size_t WS_WG = WS_WRGIN + 8 * MiB;
constexpr size_t WS_WRGOUT = WS_WG + 1 * MiB;
constexpr size_t WS_WFIN = WS_WRGOUT + 4 * MiB;
constexpr size_t WS_WFOUT = WS_WFIN + 44 * MiB;
constexpr size_t WS_WQKV = WS_WFOUT + 22 * MiB;
constexpr size_t WS_WO = WS_WQKV + 6 * MiB;
constexpr size_t WS_X = WS_WO + 4 * MiB;
constexpr size_t WS_XB = WS_X + 64 * MiB;
constexpr size_t WS_GATE = WS_XB + 32 * MiB;
constexpr size_t WS_U = WS_GATE + 32 * MiB;
constexpr size_t WS_HG = WS_U + 32 * MiB;
constexpr size_t WS_ACT = WS_HG + 32 * MiB;
constexpr size_t WS_Q = WS_ACT + 88 * MiB;
constexpr size_t WS_KB = WS_Q + 32 * MiB;
constexpr size_t WS_VT = WS_KB + 16 * MiB;
constexpr size_t WS_OB = WS_VT + 16 * MiB;
constexpr size_t WS_PARTO = WS_OB + 32 * MiB;
constexpr size_t WS_PARTML = WS_PARTO + 96 * MiB;
constexpr size_t WS_LIST = WS_PARTML + 3 * MiB;
constexpr size_t WS_SUMM = WS_LIST + 16 * MiB;
constexpr size_t WS_KMC = WS_SUMM + 1 * MiB;
constexpr size_t WS_S = WS_KMC + 2 * MiB;
constexpr size_t WS_XS = WS_S, WS_XSB = WS_S + 128 * 1024, WS_PROJS = WS_S + 192 * 1024, WS_HGS = WS_S + 448 * 1024, WS_ACTS = WS_S + 512 * 1024, WS_QS = WS_S + 704 * 1024, WS_OSB = WS_S + 832 * 1024;
constexpr size_t WS_END = WS_S + 1 * MiB;
constexpr int RING_OFF = 0, RING_BYTES = 131072;
constexpr int LDS_MISC_OFF = 144384;
constexpr int LDS_BYTES = 147456;
constexpr int CW_BAR = 4096;

typedef unsigned short bf16;
typedef pg8::bf16x8 bf16x8;
typedef float f32x16 __attribute__((ext_vector_type(16)));
typedef unsigned u32x2 __attribute__((ext_vector_type(2)));
using pg8::rss_t; using pg8::RSS_SCALE; using pg8::RSS_INV; using pg8::cvt_pk_bf16; using pg8::fast_exp2; using pg8::fast_rcp; using pg8::sigmoidf_; using pg8::gelu_tanh; using pg8::silu_;

struct Args { const void* in[25]; float* out; unsigned char* ws; int ph_lo, ph_hi; };
struct Frame { LAS unsigned char* lds; int tid, lane, wave, bid, G; unsigned char* ws; float* out; };
__device__ __forceinline__ Frame make_frame(const Args& args, LAS unsigned char* lds) {
    Frame F; int t = threadIdx.x; asm volatile("" : "+v"(t)); F.tid = t; F.lane = t & 63; F.wave = __builtin_amdgcn_readfirstlane(t >> 6);
    F.bid = blockIdx.x; F.G = gridDim.x; F.lds = lds;
    GAS unsigned char* w = (GAS unsigned char*)args.ws; asm volatile("" : "+s"(w)); F.ws = (unsigned char*)w; GAS float* o = (GAS float*)args.out; asm volatile("" : "+s"(o)); F.out = (float*)o; return F;
}

__device__ __forceinline__ float wave_sum(float v) {
#pragma unroll
    for (int o = 1; o < 64; o <<= 1) v += __shfl_xor(v, o);
    return v;
}
__device__ __forceinline__ float wave_max(float v) {
#pragma unroll
    for (int o = 1; o < 64; o <<= 1) v = fmaxf(v, __shfl_xor(v, o));
    return v;
}
__device__ __forceinline__ unsigned short f2bf1(float f) { return (unsigned short)(cvt_pk_bf16(f, 0.f) & 0xffffu); }
__device__ __forceinline__ float bf2f(unsigned short b) { return __uint_as_float(((unsigned)b) << 16); }
__device__ __forceinline__ float bflo(unsigned w) { return __uint_as_float(w << 16); }
__device__ __forceinline__ float bfhi(unsigned w) { return __uint_as_float(w & 0xffff0000u); }

__device__ __forceinline__ void p0_transpose_item(const float* W, const float* g, int K, int N, bf16* WT, int mode, int row_off, LAS float* scr, int item, int lane) {
    const int nblk = N / 32, kb = item / nblk, nb = item % nblk, k0 = 64 * kb, n0 = 32 * nb;
    int drow0 = row_off + n0;
    if (mode == 1) { const int c = n0 < FF ? n0 : n0 - FF; drow0 = 256 * (c >> 7) + (c & 127) + (n0 < FF ? 0 : 128); }
#pragma unroll 8
    for (int i = 0; i < 32; ++i) { const int kk = 2 * i + (lane >> 5); float v = W[(size_t)(k0 + kk) * N + n0 + (lane & 31)]; if (g) v *= g[k0 + kk]; scr[kk * 33 + (lane & 31)] = v; }
    LDS_WAIT(); asm volatile("" ::: "memory");
    const int c = lane & 7;
#pragma unroll
    for (int j = 0; j < 4; ++j) { const int n = (lane >> 3) + 8 * j; const LAS float* s = scr + (8 * c) * 33 + n;
        v4u o; o.x = cvt_pk_bf16(s[0 * 33], s[1 * 33]); o.y = cvt_pk_bf16(s[2 * 33], s[3 * 33]); o.z = cvt_pk_bf16(s[4 * 33], s[5 * 33]); o.w = cvt_pk_bf16(s[6 * 33], s[7 * 33]);
        *(v4u*)(WT + (size_t)(drow0 + n) * K + k0 + 8 * c) = o; }
    LDS_WAIT(); asm volatile("" ::: "memory");
}
__device__ __forceinline__ void p0_row(const float* xrow, bf16* orow, rss_t* ss_out, int lane) {
    const f32x4* xr = (const f32x4*)xrow + lane; f32x4 v[4]; float s = 0.f;
#pragma unroll
    for (int j = 0; j < 4; ++j) { v[j] = xr[64 * j]; s += (v[j].x * v[j].x + v[j].y * v[j].y) + (v[j].z * v[j].z + v[j].w * v[j].w); }
    s = wave_sum(s);
    u32x2* o8 = (u32x2*)orow + lane;
#pragma unroll
    for (int j = 0; j < 4; ++j) { u32x2 w; w.x = cvt_pk_bf16(v[j].x, v[j].y); w.y = cvt_pk_bf16(v[j].z, v[j].w); o8[64 * j] = w; }
    if (lane == 0) *ss_out = (rss_t)(s * RSS_SCALE);
}
__device__ __forceinline__ void p0_prologue(Frame& F, const Args& A) {
    LAS float* scr = (LAS float*)(F.lds + F.wave * 16384);
    const int gw = F.bid * NWAVES + F.wave, NGW = F.G * NWAVES;
    unsigned char* ws = F.ws;
    const float* g_mix = (const float*)A.in[7]; const float* g_ffn = (const float*)A.in[8];
    constexpr int I_RGIN = 16 * 64, I_G = 2 * 4, I_RGOUT = 16 * 32, I_FIN = 16 * 176, I_FOUT = 44 * 32, I_SQ = 16 * 32;
    constexpr int NITEMS = 2 * I_RGIN + 32 * I_G + 2 * I_RGOUT + 4 * I_FIN + 4 * I_FOUT + 3 * I_SQ + 2 * I_SQ;
    for (int it = gw; it < NITEMS; it += NGW) {
        int r = it;
        if (r < 2 * I_RGIN) { const int l = r / I_RGIN; p0_transpose_item((const float*)A.in[9] + (size_t)l * 1024 * 2048, g_mix + l * 1024, 1024, 2048, (bf16*)(ws + WS_WRGIN) + (size_t)l * 2048 * 1024, 0, 0, scr, r % I_RGIN, F.lane); continue; } r -= 2 * I_RGIN;
        if (r < 32 * I_G) { const int q = r / I_G, l = q >> 4, nb = (q >> 1) & 7, sel = q & 1;
            p0_transpose_item((const float*)A.in[sel ? 14 : 12] + (size_t)(l * 8 + nb) * 128 * 128, nullptr, 128, 128, (bf16*)(ws + WS_WG) + (size_t)(l * 8 + nb) * 256 * 128, 0, sel * 128, scr, r % I_G, F.lane); continue; } r -= 32 * I_G;
        if (r < 2 * I_RGOUT) { const int l = r / I_RGOUT; p0_transpose_item((const float*)A.in[17] + (size_t)l * 1024 * 1024, nullptr, 1024, 1024, (bf16*)(ws + WS_WRGOUT) + (size_t)l * 1024 * 1024, 0, 0, scr, r % I_RGOUT, F.lane); continue; } r -= 2 * I_RGOUT;
        if (r < 4 * I_FIN) { const int l = r / I_FIN; p0_transpose_item((const float*)A.in[22] + (size_t)l * 1024 * NF2, g_ffn + l * 1024, 1024, NF2, (bf16*)(ws + WS_WFIN) + (size_t)l * NF2 * 1024, 1, 0, scr, r % I_FIN, F.lane); continue; } r -= 4 * I_FIN;
        if (r < 4 * I_FOUT) { const int l = r / I_FOUT; p0_transpose_item((const float*)A.in[23] + (size_t)l * FF * 1024, nullptr, FF, 1024, (bf16*)(ws + WS_WFOUT) + (size_t)l * 1024 * FF, 0, 0, scr, r % I_FOUT, F.lane); continue; } r -= 4 * I_FOUT;
        if (r < I_SQ) { p0_transpose_item((const float*)A.in[20], g_mix + 2 * 1024, 1024, 1024, (bf16*)(ws + WS_WQKV), 0, 0, scr, r, F.lane); continue; } r -= I_SQ;
        if (r < I_SQ) { p0_transpose_item((const float*)A.in[19], (const float*)A.in[18], 1024, 1024, (bf16*)(ws + WS_WQKV), 0, 1024, scr, r, F.lane); continue; } r -= I_SQ;
        if (r < I_SQ) { p0_transpose_item((const float*)A.in[20] + (size_t)1024 * 1024, g_mix + 3 * 1024, 1024, 1024, (bf16*)(ws + WS_WQKV) + (size_t)2048 * 1024, 0, 0, scr, r, F.lane); continue; } r -= I_SQ;
        { const int a = r / I_SQ; p0_transpose_item((const float*)A.in[21] + (size_t)a * 1024 * 1024, nullptr, 1024, 1024, (bf16*)(ws + WS_WO) + (size_t)a * 1024 * 1024, 0, 0, scr, r % I_SQ, F.lane); }
    }
    for (int m = gw; m < M + SB; m += NGW) {
        if (m < M) p0_row((const float*)A.in[0] + (size_t)m * D, (bf16*)(ws + WS_XB) + (size_t)m * D, (rss_t*)(ws + WS_RSS) + m, F.lane);
        else p0_row((const float*)A.in[1] + (size_t)(m - M) * D, (bf16*)(ws + WS_XSB) + (size_t)(m - M) * D, (rss_t*)(ws + WS_RSSS) + (m - M), F.lane);
    }
    __syncthreads();
    {
        const float* ck = (const float*)A.in[2]; const int* pt = (const int*)A.in[6];
        LAS f32x4* red = (LAS f32x4*)F.lds;
        const int c4 = F.tid & 127, rg = F.tid >> 7;
        for (int u = F.bid; u < SB * NBLK; u += F.G) {
            const int b = u >> 5, j = u & 31; f32x4 s = (f32x4){0.f, 0.f, 0.f, 0.f};
#pragma unroll
            for (int pg = 0; pg < 2; ++pg) { const int page = pt[b * NPG + 2 * j + pg]; const f32x4* base = (const f32x4*)(ck + (size_t)page * PAGE * KVD) + c4;
#pragma unroll 8
                for (int k = 0; k < 32; ++k) s += base[(size_t)(rg + 4 * k) * 128]; }
            red[rg * 128 + c4] = s; __syncthreads();
            if (F.tid < 128) { const f32x4 t = (red[c4] + red[128 + c4]) + (red[256 + c4] + red[384 + c4]); *((f32x4*)((float*)(ws + WS_KMC) + (size_t)u * 512) + c4) = t * (1.0f / 256.0f); }
            __syncthreads();
        }
    }
}

template <int NG>
__device__ __forceinline__ void sgemm_tile(Frame& F, const bf16* A, int lda, const bf16* Bt, int ldb, int K, int n0a, int n0b, LAS float* part, LAS float* fin) {
    const int ksl = K / 8, r = F.lane & 31, h = F.lane >> 5;
    f32x16 acc[NG];
#pragma unroll
    for (int g = 0; g < NG; ++g)
#pragma unroll
        for (int i = 0; i < 16; ++i) acc[g][i] = 0.f;
    const bf16* ap = A + (size_t)r * lda + F.wave * ksl + 8 * h;
    const bf16* bp0 = Bt + (size_t)(n0a + r) * ldb + F.wave * ksl + 8 * h;
    const bf16* bp1 = Bt + (size_t)(n0b + r) * ldb + F.wave * ksl + 8 * h;
    for (int k = 0; k < ksl; k += 16) {
        const bf16x8 a = *(const bf16x8*)(ap + k); const bf16x8 b0 = *(const bf16x8*)(bp0 + k);
        acc[0] = __builtin_amdgcn_mfma_f32_32x32x16_bf16(a, b0, acc[0], 0, 0, 0);
        if (NG == 2) { const bf16x8 b1 = *(const bf16x8*)(bp1 + k); acc[NG - 1] = __builtin_amdgcn_mfma_f32_32x32x16_bf16(a, b1, acc[NG - 1], 0, 0, 0); }
    }
#pragma unroll
    for (int g = 0; g < NG; ++g)
#pragma unroll
        for (int i = 0; i < 16; ++i) { const int row = (i & 3) + 8 * (i >> 2) + 4 * h; part[((g * 8 + F.wave) * 32 + row) * 32 + r] = acc[g][i]; }
    __syncthreads();
    for (int e = F.tid; e < NG * 1024; e += NTHR) { const int g = e >> 10, idx = e & 1023; float s = 0.f;
#pragma unroll
        for (int w = 0; w < 8; ++w) s += part[(g * 8 + w) * 1024 + idx];
        fin[g * 32 * 33 + (idx >> 5) * 33 + (idx & 31)] = s; }
    __syncthreads();
}
enum { SG_RGIN = 0, SG_RESID = 1, SG_FFNIN = 2, SG_QKV = 3 };
struct SgArgs { const bf16* A; int lda; const bf16* Bt; int K; int nunits; const rss_t* rss_in; rss_t* rss_out; const float* xin; float* xout; bf16* xbout; float* fout; bf16* bout; float* sk; float* sv; };
template <int KIND>
__device__ __forceinline__ void sgemm_units(Frame& F, const SgArgs& S, int shift) {
    LAS float* part = (LAS float*)F.lds; LAS float* fin = (LAS float*)(F.lds + 65536);
    for (int su = (F.bid + F.G - (shift % F.G)) % F.G; su < S.nunits; su += F.G) {
        if (KIND == SG_FFNIN) { const int n0 = 256 * (su >> 2) + 32 * (su & 3); sgemm_tile<2>(F, S.A, S.lda, S.Bt, S.K, S.K, n0, n0 + 128, part, fin); }
        else sgemm_tile<1>(F, S.A, S.lda, S.Bt, S.K, S.K, 32 * su, 32 * su, part, fin);
        for (int e = F.tid; e < 1024; e += NTHR) { const int m = e >> 5, n = e & 31; const float v = fin[m * 33 + n];
            if (KIND == SG_RGIN) { const float rs = 1.0f / sqrtf((float)S.rss_in[m] * RSS_INV + EPS); S.fout[m * 2048 + 32 * su + n] = v * rs; }
            if (KIND == SG_RESID) { const int c = 32 * su + n; const float x = S.xin[m * 1024 + c] + v; S.xout[m * 1024 + c] = x; S.xbout[m * 1024 + c] = f2bf1(x);
                float ss = x * x;
#pragma unroll
                for (int o = 1; o < 32; o <<= 1) ss += __shfl_xor(ss, o);
                if (n == 0) atomicAdd(S.rss_out + m, (rss_t)(ss * RSS_SCALE)); }
            if (KIND == SG_FFNIN) { const float rs = 1.0f / sqrtf((float)S.rss_in[m] * RSS_INV + EPS); const float g = v * rs, u = fin[32 * 33 + m * 33 + n] * rs; S.bout[m * FF + 32 * su + n] = f2bf1(silu_(g) * u); }
            if (KIND == SG_QKV) { const float rs = 1.0f / sqrtf((float)S.rss_in[m] * RSS_INV + EPS); const int c = 32 * su + n; float x = v * rs;
                if (c < 1536 && (su & 3) == 0) {
                    const int d = n & 15; float rev = 8192.0f * fast_exp2(-(float)d * (18.931568569324174f / 16.0f)) * 0.15915494309189535f; rev = rev - floorf(rev);
                    const float co = __builtin_amdgcn_cosf(rev), si = __builtin_amdgcn_sinf(rev); const float other = fin[m * 33 + (n ^ 16)] * rs;
                    x = n < 16 ? x * co - other * si : x * co + other * si; }
                if (c < 1024) S.fout[m * 1024 + c] = x * pg8::QSCALE; else if (c < 1536) S.sk[m * 512 + (c - 1024)] = x; else S.sv[m * 512 + (c - 1536)] = x; }
        }
        __syncthreads();
    }
}

__device__ __forceinline__ bf16x8 ld_bf16x8_g(const bf16* p) { return *(const bf16x8*)p; }
__device__ __forceinline__ f32x4 mfma16(const bf16x8 a, const bf16x8 b, const f32x4 c) { return __builtin_amdgcn_mfma_f32_16x16x32_bf16(a, b, c, 0, 0, 0); }
__device__ __forceinline__ float one_minus_exp(float x) {
    if (x > -0.3f) { const float p = x * (1.0f + x * (0.5f + x * (1.0f / 6.0f + x * (1.0f / 24.0f + x * (1.0f / 120.0f + x * (1.0f / 720.0f + x * (1.0f / 5040.0f))))))); return -p; }
    return 1.0f - fast_exp2(1.44269504089f * x);
}
__device__ __forceinline__ float softplus_neg(float lam) { return (lam > 15.f) ? __expf(-lam) : ((lam < -15.f) ? -lam : log1pf(__expf(-lam))); }
__device__ __forceinline__ void lru_ab(float pa, float pi, float cch, float uc, float& a, float& bb) {
    const float r = sigmoidf_(pa), ig = sigmoidf_(pi); const float la = cch * r;
    a = fast_exp2(1.44269504089f * la); bb = sqrtf(one_minus_exp(2.0f * la)) * (ig * uc);
}
constexpr int SC_RAWU = 0, SC_RAWG = 17408, SC_AT = 33792, SC_UCF = 51200, SC_AT_PITCH = 272, SC_UCF_PITCH = 132;
template <int PASS>
__device__ __forceinline__ void scan_phase(Frame& F, const Args& A, int l) {
    unsigned char* ws = F.ws;
    const bf16* U = (const bf16*)(ws + WS_U); const bf16* GT = (const bf16*)(ws + WS_GATE); bf16* HG = (bf16*)(ws + WS_HG);
    float* SUMM = (float*)(ws + WS_SUMM);
    const int lane = F.lane, fr = lane & 15, fq = lane >> 4, w = F.wave, tid = F.tid;
    LAS unsigned char* lds = F.lds;
    for (int unit = F.bid; unit < 256; unit += F.G) {
        const int b = unit >> 7, cb = (unit >> 4) & 7, c = unit & 15, ch0 = cb * 128, chl = 16 * w + fr, ch = ch0 + chl;
        const float ba = ((const float*)A.in[13])[l * 1024 + ch], bi = ((const float*)A.in[15])[l * 1024 + ch];
        const float lam = ((const float*)A.in[16])[l * 1024 + ch];
        const float sp = softplus_neg(lam);
        const float cch = -8.0f * sp;
        bf16x8 Ba[4], Bi[4];
        { const bf16* wg = (const bf16*)(ws + WS_WG) + ((size_t)(l * 8 + cb) * 256 + chl) * 128 + 8 * fq;
#pragma unroll
          for (int ks = 0; ks < 4; ++ks) { Ba[ks] = ld_bf16x8_g(wg + 32 * ks); Bi[ks] = ld_bf16x8_g(wg + 128 * 128 + 32 * ks); } }
        const int cg = tid & 15;
        float cw[4][8], cbias[8];
#pragma unroll
        for (int j = 0; j < 8; ++j) { cbias[j] = ((const float*)A.in[11])[l * 1024 + ch0 + 8 * cg + j];
#pragma unroll
            for (int q = 0; q < 4; ++q) cw[q][j] = ((const float*)A.in[10])[(l * 4 + q) * 1024 + ch0 + 8 * cg + j]; }
        float hin = 0.f, Arun = 1.f, Brun = 0.f;
        if (PASS == 2) { for (int j = 0; j < c; ++j) { const float* s = SUMM + (size_t)((b * 8 + cb) * 16 + j) * 256 + chl; hin = s[0] * hin + s[128]; } }
        const int tc0 = c * 512;
        v4u pu[3], pgt[2];
#define SC_PREFETCH(st_) do { const int t0_ = tc0 + (st_) * 64; \
            _Pragma("unroll") for (int k = 0; k < 3; ++k) { const int p = tid + 512 * k; pu[k] = (v4u){0u, 0u, 0u, 0u}; \
                if (p < 67 * 16) { const int t = t0_ - 3 + (p >> 4); if (t >= 0) pu[k] = *(const v4u*)(U + ((size_t)(b * T + t)) * 1024 + ch0 + 8 * (p & 15)); } } \
            if (PASS == 2) { _Pragma("unroll") for (int k = 0; k < 2; ++k) { const int p = tid + 512 * k; pgt[k] = *(const v4u*)(GT + ((size_t)(b * T + t0_ + (p >> 4))) * 1024 + ch0 + 8 * (p & 15)); } } } while (0)
        SC_PREFETCH(0);
        for (int st = 0; st < 8; ++st) {
            const int t0 = tc0 + st * 64;
            __syncthreads();
#pragma unroll
            for (int k = 0; k < 3; ++k) { const int p = tid + 512 * k; if (p < 67 * 16) *(LAS v4u*)(lds + SC_RAWU + p * 16) = pu[k]; }
            if (PASS == 2) {
#pragma unroll
                for (int k = 0; k < 2; ++k) { const int p = tid + 512 * k; *(LAS v4u*)(lds + SC_RAWG + p * 16) = pgt[k]; } }
            __syncthreads();
            if (st + 1 < 8) SC_PREFETCH(st + 1);
#pragma unroll
            for (int k = 0; k < 2; ++k) { const int t = (tid >> 4) + 32 * k; float uc[8];
#pragma unroll
                for (int j = 0; j < 8; ++j) uc[j] = cbias[j];
#pragma unroll
                for (int q = 0; q < 4; ++q) { const v4u rw = *(const LAS v4u*)(lds + SC_RAWU + ((t + q) * 16 + cg) * 16);
                    uc[0] += cw[q][0] * bflo(rw.x); uc[1] += cw[q][1] * bfhi(rw.x); uc[2] += cw[q][2] * bflo(rw.y); uc[3] += cw[q][3] * bfhi(rw.y);
                    uc[4] += cw[q][4] * bflo(rw.z); uc[5] += cw[q][5] * bfhi(rw.z); uc[6] += cw[q][6] * bflo(rw.w); uc[7] += cw[q][7] * bfhi(rw.w); }
                v4u o; o.x = cvt_pk_bf16(uc[0], uc[1]); o.y = cvt_pk_bf16(uc[2], uc[3]); o.z = cvt_pk_bf16(uc[4], uc[5]); o.w = cvt_pk_bf16(uc[6], uc[7]);
                *(LAS v4u*)(lds + SC_AT + t * SC_AT_PITCH + cg * 16) = o;
                LAS float* uf = (LAS float*)(lds + SC_UCF) + t * SC_UCF_PITCH + 8 * cg;
                *(LAS f32x4*)uf = (f32x4){uc[0], uc[1], uc[2], uc[3]}; *(LAS f32x4*)(uf + 4) = (f32x4){uc[4], uc[5], uc[6], uc[7]}; }
            __syncthreads();
#pragma unroll 1
            for (int s = 0; s < 4; ++s) {
                f32x4 aa = (f32x4){0.f, 0.f, 0.f, 0.f}, ai = (f32x4){0.f, 0.f, 0.f, 0.f};
#pragma unroll
                for (int ks = 0; ks < 4; ++ks) { const bf16x8 af = *(const LAS bf16x8*)(lds + SC_AT + (16 * s + fr) * SC_AT_PITCH + ks * 64 + fq * 16); aa = mfma16(af, Ba[ks], aa); ai = mfma16(af, Bi[ks], ai); }
                float av[4], bv[4];
#pragma unroll
                for (int i = 0; i < 4; ++i) { const int tl = 16 * s + 4 * fq + i; const float ucv = ((const LAS float*)(lds + SC_UCF))[tl * SC_UCF_PITCH + chl]; lru_ab(aa[i] + ba, ai[i] + bi, cch, ucv, av[i], bv[i]); }
                float Ac = 1.f, Bc = 0.f;
#pragma unroll
                for (int i = 0; i < 4; ++i) { Bc = av[i] * Bc + bv[i]; Ac = av[i] * Ac; }
                { const float Ap = __shfl_up(Ac, 16), Bp = __shfl_up(Bc, 16); if (fq >= 1) { Bc = Ac * Bp + Bc; Ac = Ac * Ap; } }
                { const float Ap = __shfl_up(Ac, 32), Bp = __shfl_up(Bc, 32); if (fq >= 2) { Bc = Ac * Bp + Bc; Ac = Ac * Ap; } }
                const float Atot = __shfl(Ac, 48 + fr), Btot = __shfl(Bc, 48 + fr);
                if (PASS == 1) { Brun = Atot * Brun + Btot; Arun = Atot * Arun; }
                else {
                    float Ae = __shfl_up(Ac, 16), Be = __shfl_up(Bc, 16); if (fq == 0) { Ae = 1.f; Be = 0.f; }
                    float h = Ae * hin + Be;
#pragma unroll
                    for (int i = 0; i < 4; ++i) { const int tl = 16 * s + 4 * fq + i; h = av[i] * h + bv[i];
                        const float gv = bf2f(((const LAS unsigned short*)(lds + SC_RAWG))[tl * 128 + chl]);
                        HG[((size_t)(b * T + t0 + tl)) * 1024 + ch] = f2bf1(h * gv);
                        if (c == 15 && st == 7 && s == 3 && fq == 3 && i == 3) F.out[O_PH + (size_t)(l * 2 + b) * 1024 + ch] = h; }
                    hin = Atot * hin + Btot;
                }
            }
        }
        if (PASS == 1 && fq == 0) { float* s = SUMM + (size_t)((b * 8 + cb) * 16 + c) * 256 + chl; s[0] = Arun; s[128] = Brun; }
        __syncthreads();
    }
}
__device__ __forceinline__ void srg_step(Frame& F, const Args& A, int l) {
    unsigned char* ws = F.ws; LAS unsigned char* lds = F.lds;
    const float* PROJ = (const float*)(ws + WS_PROJS); bf16* HGS = (bf16*)(ws + WS_HGS);
    const int lane = F.lane, fr = lane & 15, fq = lane >> 4, w = F.wave, tid = F.tid;
    for (int cb = F.bid; cb < 8; cb += F.G) {
        const int ch0 = cb * 128, chl = 16 * w + fr, ch = ch0 + chl;
        __syncthreads();
        { const int b = tid >> 4, cg = tid & 15; float uc[8];
          const float* sc = (const float*)A.in[4] + (size_t)((l * SB + b) * 3) * 1024 + ch0 + 8 * cg;
          float* sco = F.out + O_SCONV + (size_t)((l * SB + b) * 3) * 1024 + ch0 + 8 * cg;
#pragma unroll
          for (int j = 0; j < 8; ++j) { const int cc = ch0 + 8 * cg + j; const float* cwp = (const float*)A.in[10] + (size_t)l * 4 * 1024 + cc;
              const float s0 = sc[j], s1 = sc[1024 + j], s2 = sc[2048 + j], un = PROJ[b * 2048 + 1024 + cc];
              uc[j] = ((const float*)A.in[11])[l * 1024 + cc] + cwp[0] * s0 + cwp[1024] * s1 + cwp[2048] * s2 + cwp[3072] * un;
              sco[j] = s1; sco[1024 + j] = s2; sco[2048 + j] = un; }
          v4u o; o.x = cvt_pk_bf16(uc[0], uc[1]); o.y = cvt_pk_bf16(uc[2], uc[3]); o.z = cvt_pk_bf16(uc[4], uc[5]); o.w = cvt_pk_bf16(uc[6], uc[7]);
          *(LAS v4u*)(lds + SC_AT + b * SC_AT_PITCH + cg * 16) = o;
          LAS float* uf = (LAS float*)(lds + SC_UCF) + b * SC_UCF_PITCH + 8 * cg;
          *(LAS f32x4*)uf = (f32x4){uc[0], uc[1], uc[2], uc[3]}; *(LAS f32x4*)(uf + 4) = (f32x4){uc[4], uc[5], uc[6], uc[7]}; }
        __syncthreads();
        const float ba = ((const float*)A.in[13])[l * 1024 + ch], bi = ((const float*)A.in[15])[l * 1024 + ch];
        const float lam = ((const float*)A.in[16])[l * 1024 + ch];
        const float sp = softplus_neg(lam); const float cch = -8.0f * sp;
        const bf16* wg = (const bf16*)(ws + WS_WG) + ((size_t)(l * 8 + cb) * 256 + chl) * 128 + 8 * fq;
#pragma unroll
        for (int s = 0; s < 2; ++s) {
            f32x4 aa = (f32x4){0.f, 0.f, 0.f, 0.f}, ai = (f32x4){0.f, 0.f, 0.f, 0.f};
#pragma unroll
            for (int ks = 0; ks < 4; ++ks) { const bf16x8 af = *(const LAS bf16x8*)(lds + SC_AT + (16 * s + fr) * SC_AT_PITCH + ks * 64 + fq * 16);
                aa = mfma16(af, ld_bf16x8_g(wg + 32 * ks), aa); ai = mfma16(af, ld_bf16x8_g(wg + 128 * 128 + 32 * ks), ai); }
#pragma unroll
            for (int i = 0; i < 4; ++i) { const int b = 16 * s + 4 * fq + i; const float ucv = ((const LAS float*)(lds + SC_UCF))[b * SC_UCF_PITCH + chl]; float a, bb; lru_ab(aa[i] + ba, ai[i] + bi, cch, ucv, a, bb);
                const float h = a * ((const float*)A.in[5])[(size_t)(l * SB + b) * 1024 + ch] + bb;
                F.out[O_SH + (size_t)(l * SB + b) * 1024 + ch] = h;
                HGS[b * 1024 + ch] = f2bf1(h * gelu_tanh(PROJ[b * 2048 + ch])); }
        }
    }
}

constexpr int AT_K = 0, AT_KP = 272, AT_V = 69632, AT_VP = 528, AT_MISC = 137216;
__device__ __forceinline__ void sel_phase(Frame& F, int a) {
    unsigned char* ws = F.ws; LAS unsigned char* lds = F.lds;
    const bf16* Q = (const bf16*)(ws + WS_Q); const float* KM = (const float*)(ws + WS_KM);
    unsigned* CNT = (unsigned*)(ws + WS_CNT) + a * 256; unsigned* LIST = (unsigned*)(ws + WS_LIST);
    LAS unsigned* cnt = (LAS unsigned*)(lds + AT_MISC); LAS unsigned* base = cnt + 32;
    const int lane = F.lane, r32 = lane & 31, hh5 = lane >> 5, tid = F.tid;
    for (int u = F.bid; u < 248; u += F.G) {
        const int bg = u / 31, qt = u % 31 + 1, b = bg >> 2, g = bg & 3;
        __syncthreads();
        if (tid < 32) cnt[tid] = 0u;
        __syncthreads();
        bf16x8 kmh[8], kml[8];
        { const float* kp = KM + (size_t)(b * 32 + r32) * 512 + g * 128 + 8 * hh5;
#pragma unroll
          for (int ks = 0; ks < 8; ++ks) { const f32x4 x0 = *(const f32x4*)(kp + 16 * ks), x1 = *(const f32x4*)(kp + 16 * ks + 4); float x[8] = {x0[0], x0[1], x0[2], x0[3], x1[0], x1[1], x1[2], x1[3]};
              unsigned hw[4], lw[4];
#pragma unroll
              for (int j = 0; j < 4; ++j) { hw[j] = cvt_pk_bf16(x[2 * j], x[2 * j + 1]); lw[j] = cvt_pk_bf16(x[2 * j] - bflo(hw[j]), x[2 * j + 1] - bfhi(hw[j])); }
              v4u hv = (v4u){hw[0], hw[1], hw[2], hw[3]}, lv = (v4u){lw[0], lw[1], lw[2], lw[3]};
              kmh[ks] = __builtin_bit_cast(bf16x8, hv); kml[ks] = __builtin_bit_cast(bf16x8, lv); } }
        int selj[2][3]; unsigned rank[2][3];
        const int nsel = qt < 3 ? qt : 3;
#pragma unroll
        for (int tk = 0; tk < 2; ++tk) {
            const int task = F.wave + 8 * tk, hh = task >> 3, s32 = task & 7, h = 2 * g + hh;
            const bf16* qp = Q + ((size_t)(b * T + 256 * qt + 32 * s32 + r32)) * 1024 + h * 128 + 8 * hh5;
            f32x16 acc;
#pragma unroll
            for (int i = 0; i < 16; ++i) acc[i] = 0.f;
#pragma unroll
            for (int ks = 0; ks < 8; ++ks) { const bf16x8 qf = ld_bf16x8_g(qp + 16 * ks);
                acc = __builtin_amdgcn_mfma_f32_32x32x16_bf16(kmh[ks], qf, acc, 0, 0, 0); acc = __builtin_amdgcn_mfma_f32_32x32x16_bf16(kml[ks], qf, acc, 0, 0, 0); }
            float sc[16];
#pragma unroll
            for (int i = 0; i < 16; ++i) { const int blk = (i & 3) + 8 * (i >> 2) + 4 * hh5; sc[i] = blk < qt ? acc[i] : -3.0e38f; }
#pragma unroll
            for (int rd = 0; rd < 3; ++rd) {
                float bv = -3.4e38f; int bi = 64;
#pragma unroll
                for (int i = 0; i < 16; ++i) { const int blk = (i & 3) + 8 * (i >> 2) + 4 * hh5; if (sc[i] > bv) { bv = sc[i]; bi = blk; } }
                const float ov = __shfl_xor(bv, 32); const int oi = __shfl_xor(bi, 32);
                if (ov > bv || (ov == bv && oi < bi)) { bv = ov; bi = oi; }
                selj[tk][rd] = bi;
#pragma unroll
                for (int i = 0; i < 16; ++i) { const int blk = (i & 3) + 8 * (i >> 2) + 4 * hh5; if (blk == bi) sc[i] = -3.4e38f; }
            }
            if (lane < 32) {
#pragma unroll
                for (int sl = 0; sl < 3; ++sl) if (sl < nsel) rank[tk][sl] = atomicAdd((unsigned*)(cnt + selj[tk][sl]), 1u);
            }
        }
        __syncthreads();
        if (tid < 32) { const unsigned n = cnt[tid]; base[tid] = n ? atomicAdd(CNT + (b * 4 + g) * 32 + tid, n) : 0u; }
        __syncthreads();
        if (lane < 32) {
#pragma unroll
            for (int tk = 0; tk < 2; ++tk) { const int task = F.wave + 8 * tk, hh = task >> 3, s32 = task & 7; const unsigned t = (unsigned)(256 * qt + 32 * s32 + r32);
#pragma unroll
                for (int sl = 0; sl < 3; ++sl) if (sl < nsel) { const int j = selj[tk][sl]; LIST[((size_t)((b * 4 + g) * 32 + j)) * 16384 + base[j] + rank[tk][sl]] = t | ((unsigned)hh << 13) | ((unsigned)sl << 14); } }
        }
    }
}
__device__ __forceinline__ void load_kv_block(Frame& F, int b, int g, int j) {
    const bf16* KB = (const bf16*)(F.ws + WS_KB) + ((size_t)(b * T + 256 * j)) * 512 + g * 128;
    const bf16* VT = (const bf16*)(F.ws + WS_VT) + ((size_t)(b * 4 + g) * 128) * 8192 + 256 * j;
    v4u kr[8], vr[8];
#pragma unroll
    for (int k = 0; k < 8; ++k) { const int p = F.tid + 512 * k; kr[k] = *(const v4u*)(KB + (size_t)(p >> 4) * 512 + 8 * (p & 15)); }
#pragma unroll
    for (int k = 0; k < 8; ++k) { const int p = F.tid + 512 * k; vr[k] = *(const v4u*)(VT + (size_t)(p >> 5) * 8192 + 8 * (p & 31)); }
#pragma unroll
    for (int k = 0; k < 8; ++k) { const int p = F.tid + 512 * k; *(LAS v4u*)(F.lds + AT_K + (p >> 4) * AT_KP + (p & 15) * 16) = kr[k]; }
#pragma unroll
    for (int k = 0; k < 8; ++k) { const int p = F.tid + 512 * k; *(LAS v4u*)(F.lds + AT_V + (p >> 5) * AT_VP + (p & 31) * 16) = vr[k]; }
}
template <bool CAUSAL>
__device__ __forceinline__ void attn_tile(LAS const unsigned char* lds, const bf16x8 (&qf)[4], int npair, int qidx, int fr, int fq, float& m_out, float& l_out, f32x4 (&o)[8]) {
    f32x4 s[16];
#pragma unroll
    for (int p = 0; p < 8; ++p) {
        if (p < npair) {
#pragma unroll
            for (int odd = 0; odd < 2; ++odd) { const int key = 32 * p + 8 * (fr >> 2) + 4 * odd + (fr & 3); f32x4 acc = (f32x4){0.f, 0.f, 0.f, 0.f};
#pragma unroll
                for (int ks = 0; ks < 4; ++ks) { const bf16x8 kf = *(const LAS bf16x8*)(lds + AT_K + key * AT_KP + ks * 64 + fq * 16); acc = mfma16(kf, qf[ks], acc); }
                if (CAUSAL) {
#pragma unroll
                    for (int i = 0; i < 4; ++i) if (32 * p + 8 * fq + 4 * odd + i > qidx) acc[i] = -1.0e30f; }
                s[2 * p + odd] = acc; }
        } else { s[2 * p] = (f32x4){-1.0e30f, -1.0e30f, -1.0e30f, -1.0e30f}; s[2 * p + 1] = s[2 * p]; }
    }
    float m = -1.0e30f;
#pragma unroll
    for (int t = 0; t < 16; ++t) m = fmaxf(fmaxf(fmaxf(s[t][0], s[t][1]), fmaxf(s[t][2], s[t][3])), m);
    m = fmaxf(m, __shfl_xor(m, 16)); m = fmaxf(m, __shfl_xor(m, 32));
    float l = 0.f;
#pragma unroll
    for (int t = 0; t < 16; ++t)
#pragma unroll
        for (int i = 0; i < 4; ++i) { const float e = fast_exp2(s[t][i] - m); s[t][i] = e; l += e; }
    l += __shfl_xor(l, 16); l += __shfl_xor(l, 32);
#pragma unroll
    for (int dt = 0; dt < 8; ++dt) o[dt] = (f32x4){0.f, 0.f, 0.f, 0.f};
#pragma unroll
    for (int p = 0; p < 8; ++p) {
        if (p < npair) {
            v4u pw; pw.x = cvt_pk_bf16(s[2 * p][0], s[2 * p][1]); pw.y = cvt_pk_bf16(s[2 * p][2], s[2 * p][3]); pw.z = cvt_pk_bf16(s[2 * p + 1][0], s[2 * p + 1][1]); pw.w = cvt_pk_bf16(s[2 * p + 1][2], s[2 * p + 1][3]);
            const bf16x8 pf = __builtin_bit_cast(bf16x8, pw);
#pragma unroll
            for (int dt = 0; dt < 8; ++dt) { const bf16x8 vf = *(const LAS bf16x8*)(lds + AT_V + (16 * dt + fr) * AT_VP + p * 64 + fq * 16); o[dt] = mfma16(vf, pf, o[dt]); }
        }
    }
    m_out = m; l_out = l;
}
__device__ __forceinline__ void att1_phase(Frame& F, int a) {
    unsigned char* ws = F.ws; LAS unsigned char* lds = F.lds;
    const bf16* Q = (const bf16*)(ws + WS_Q); const unsigned* CNT = (const unsigned*)(ws + WS_CNT) + a * 256; const unsigned* LIST = (const unsigned*)(ws + WS_LIST);
    bf16* PARTO = (bf16*)(ws + WS_PARTO); float* PARTML = (float*)(ws + WS_PARTML);
    LAS int* pre = (LAS int*)(lds + AT_MISC);
    const int lane = F.lane, fr = lane & 15, fq = lane >> 4, tid = F.tid;
    __syncthreads();
    if (tid < 256) pre[tid + 1] = (int)((CNT[tid] + 127u) >> 7);
    if (tid == 0) pre[0] = 0;
    __syncthreads();
    if (tid == 0) { int s = 0; for (int i = 1; i <= 256; ++i) { s += pre[i]; pre[i] = s; } }
    __syncthreads();
    const int NI = pre[256];
    const int i0 = (int)(((long)F.bid * NI) / F.G), i1 = (int)(((long)(F.bid + 1) * NI) / F.G);
    int li = 0, cur = -1;
    for (int it = i0; it < i1; ++it) {
        while (pre[li + 1] <= it) ++li;
        const int chunk = it - pre[li], b = li >> 7, g = (li >> 5) & 3, j = li & 31;
        if (li != cur) { __syncthreads(); load_kv_block(F, b, g, j); __syncthreads(); cur = li; }
        const int n = (int)CNT[li], e0 = chunk * 128 + 16 * F.wave;
        if (e0 < n) {
            const int eidx = e0 + fr; const bool valid = eidx < n;
            const unsigned ent = LIST[(size_t)li * 16384 + (valid ? eidx : e0)];
            const int t = ent & 8191, hh = (ent >> 13) & 1, sl = ent >> 14, h = 2 * g + hh; const size_t row = (size_t)(b * T + t);
            bf16x8 qf[4];
#pragma unroll
            for (int ks = 0; ks < 4; ++ks) qf[ks] = ld_bf16x8_g(Q + row * 1024 + h * 128 + 32 * ks + 8 * fq);
            float m, l; f32x4 o[8];
            attn_tile<false>(lds, qf, 8, 0, fr, fq, m, l, o);
            if (valid) { const float inv = 1.0f / l; const size_t pb = (row * 8 + h) * 3 + sl;
#pragma unroll
                for (int dt = 0; dt < 8; ++dt) { u32x2 w; w.x = cvt_pk_bf16(o[dt][0] * inv, o[dt][1] * inv); w.y = cvt_pk_bf16(o[dt][2] * inv, o[dt][3] * inv); *(u32x2*)(PARTO + pb * 128 + 16 * dt + 4 * fq) = w; }
                if (fq == 0) { PARTML[pb * 2] = m; PARTML[pb * 2 + 1] = l; } }
        }
    }
}
__device__ __forceinline__ void att2_phase(Frame& F) {
    unsigned char* ws = F.ws; LAS unsigned char* lds = F.lds;
    const bf16* Q = (const bf16*)(ws + WS_Q); const bf16* PARTO = (const bf16*)(ws + WS_PARTO); const float* PARTML = (const float*)(ws + WS_PARTML); bf16* OB = (bf16*)(ws + WS_OB);
    const int lane = F.lane, fr = lane & 15, fq = lane >> 4;
    for (int u = F.bid; u < 256; u += F.G) {
        const int b = u >> 7, g = (u >> 5) & 3, qb = u & 31;
        __syncthreads(); load_kv_block(F, b, g, qb); __syncthreads();
        const int nsl = qb < 3 ? qb : 3;
#pragma unroll 1
        for (int k = 0; k < 4; ++k) {
            const int wt = F.wave + 8 * k, hh = wt >> 4, s16 = wt & 15, h = 2 * g + hh, qidx = 16 * s16 + fr; const size_t row = (size_t)(b * T + 256 * qb + qidx);
            bf16x8 qf[4];
#pragma unroll
            for (int ks = 0; ks < 4; ++ks) qf[ks] = ld_bf16x8_g(Q + row * 1024 + h * 128 + 32 * ks + 8 * fq);
            float m, l; f32x4 o[8];
            attn_tile<true>(lds, qf, (s16 >> 1) + 1, qidx, fr, fq, m, l, o);
            float ms[3], lsv[3]; float mm = m;
#pragma unroll
            for (int sl = 0; sl < 3; ++sl) { ms[sl] = -1.0e30f; lsv[sl] = 0.f; if (sl < nsl) { const size_t pb = (row * 8 + h) * 3 + sl; ms[sl] = PARTML[pb * 2]; lsv[sl] = PARTML[pb * 2 + 1]; mm = fmaxf(mm, ms[sl]); } }
            const float eo = fast_exp2(m - mm); float den = eo * l; float wsl[3];
#pragma unroll
            for (int sl = 0; sl < 3; ++sl) { wsl[sl] = (sl < nsl) ? lsv[sl] * fast_exp2(ms[sl] - mm) : 0.f; den += wsl[sl]; }
            const float inv = 1.0f / den;
#pragma unroll
            for (int dt = 0; dt < 8; ++dt) { f32x4 r = o[dt] * eo;
#pragma unroll
                for (int sl = 0; sl < 3; ++sl) if (sl < nsl) { const u32x2 pw = *(const u32x2*)(PARTO + ((row * 8 + h) * 3 + sl) * 128 + 16 * dt + 4 * fq);
                    r[0] += wsl[sl] * bflo(pw.x); r[1] += wsl[sl] * bfhi(pw.x); r[2] += wsl[sl] * bflo(pw.y); r[3] += wsl[sl] * bfhi(pw.y); }
                u32x2 w; w.x = cvt_pk_bf16(r[0] * inv, r[1] * inv); w.y = cvt_pk_bf16(r[2] * inv, r[3] * inv);
                *(u32x2*)(OB + row * 1024 + h * 128 + 16 * dt + 4 * fq) = w; }
        }
    }
}
constexpr int SA_Q = 0, SA_SC = 512, SA_SEL = 640, SA_LG = 1024, SA_RED = 4352, SA_OP = 4608;
__device__ __forceinline__ void satt_phase(Frame& F, const Args& A) {
    unsigned char* ws = F.ws; LAS unsigned char* lds = F.lds;
    const float* QS = (const float*)(ws + WS_QS); const float* KMC = (const float*)(ws + WS_KMC); bf16* OSB = (bf16*)(ws + WS_OSB);
    const float* ck = (const float*)A.in[2]; const float* cv = (const float*)A.in[3]; const int* pt = (const int*)A.in[6];
    const float* sk = F.out + O_SK; const float* sv = F.out + O_SV;
    LAS float* q_s = (LAS float*)(lds + SA_Q); LAS float* sc_s = (LAS float*)(lds + SA_SC); LAS int* sel_s = (LAS int*)(lds + SA_SEL); LAS float* lg = (LAS float*)(lds + SA_LG);
    LAS float* red = (LAS float*)(lds + SA_RED); LAS f32x4* op = (LAS f32x4*)(lds + SA_OP);
    const int tid = F.tid, lane = F.lane;
    for (int u = F.bid; u < SB * NH; u += F.G) {
        const int b = u >> 3, h = u & 7, g = h >> 1;
        __syncthreads();
        if (tid < 128) q_s[tid] = QS[b * 1024 + h * 128 + tid];
        __syncthreads();
        { const int j = tid >> 4, dg = tid & 15; const float* kp = KMC + (size_t)(b * 32 + j) * 512 + g * 128 + 8 * dg; float s = 0.f;
#pragma unroll
          for (int i = 0; i < 8; ++i) s += q_s[8 * dg + i] * kp[i];
          s += __shfl_xor(s, 1); s += __shfl_xor(s, 2); s += __shfl_xor(s, 4); s += __shfl_xor(s, 8);
          if (dg == 0) sc_s[j] = s; }
        __syncthreads();
        if (tid == 0) { float v[32];
#pragma unroll
            for (int i = 0; i < 32; ++i) v[i] = sc_s[i];
#pragma unroll
            for (int rd = 0; rd < 3; ++rd) { float bv = -3.4e38f; int bi = 0;
#pragma unroll
                for (int i = 0; i < 32; ++i) if (v[i] > bv) { bv = v[i]; bi = i; }
                sel_s[rd] = bi;
#pragma unroll
                for (int i = 0; i < 32; ++i) if (i == bi) v[i] = -3.4e38f; } }
        __syncthreads();
        const int r32 = lane & 31, hw = tid >> 5;
        const f32x4 q4 = *(const LAS f32x4*)(q_s + 4 * r32);
        for (int kk = hw; kk < 768; kk += 16) {
            const int blk = sel_s[kk >> 8], wi = kk & 255, page = pt[b * NPG + 2 * blk + (wi >> 7)], slot = wi & 127;
            const f32x4 k4 = *((const f32x4*)(ck + ((size_t)(page * PAGE + slot) * 4 + g) * 128) + r32);
            float s = q4[0] * k4[0] + q4[1] * k4[1] + q4[2] * k4[2] + q4[3] * k4[3];
            s += __shfl_xor(s, 1); s += __shfl_xor(s, 2); s += __shfl_xor(s, 4); s += __shfl_xor(s, 8); s += __shfl_xor(s, 16);
            if (r32 == 0) lg[kk] = s;
        }
        if (hw == 0) { const f32x4 k4 = *((const f32x4*)(sk + (size_t)(b * 4 + g) * 128) + r32); float s = q4[0] * k4[0] + q4[1] * k4[1] + q4[2] * k4[2] + q4[3] * k4[3];
            s += __shfl_xor(s, 1); s += __shfl_xor(s, 2); s += __shfl_xor(s, 4); s += __shfl_xor(s, 8); s += __shfl_xor(s, 16);
            if (r32 == 0) lg[768] = s; }
        __syncthreads();
        float mx = -3.4e38f;
        for (int i = tid; i < 769; i += NTHR) mx = fmaxf(mx, lg[i]);
        mx = wave_max(mx); if (lane == 0) red[F.wave] = mx;
        __syncthreads();
        mx = red[0];
#pragma unroll
        for (int i = 1; i < 8; ++i) mx = fmaxf(mx, red[i]);
        __syncthreads();
        float sm = 0.f;
        for (int i = tid; i < 769; i += NTHR) { const float e = fast_exp2(lg[i] - mx); lg[i] = e; sm += e; }
        sm = wave_sum(sm); if (lane == 0) red[F.wave] = sm;
        __syncthreads();
        sm = 0.f;
#pragma unroll
        for (int i = 0; i < 8; ++i) sm += red[i];
        f32x4 acc = (f32x4){0.f, 0.f, 0.f, 0.f};
        for (int kk = hw; kk < 768; kk += 16) {
            const int blk = sel_s[kk >> 8], wi = kk & 255, page = pt[b * NPG + 2 * blk + (wi >> 7)], slot = wi & 127;
            const f32x4 v4 = *((const f32x4*)(cv + ((size_t)(page * PAGE + slot) * 4 + g) * 128) + r32);
            acc += v4 * lg[kk];
        }
        if (hw == 0) { const f32x4 v4 = *((const f32x4*)(sv + (size_t)(b * 4 + g) * 128) + r32); acc += v4 * lg[768]; }
        op[hw * 32 + r32] = acc;
        __syncthreads();
        if (tid < 32) { f32x4 t = op[tid];
#pragma unroll
            for (int i = 1; i < 16; ++i) t += op[i * 32 + tid];
            t = t * (1.0f / sm);
            u32x2 w; w.x = cvt_pk_bf16(t[0], t[1]); w.y = cvt_pk_bf16(t[2], t[3]); *(u32x2*)(OSB + b * 1024 + h * 128 + 4 * tid) = w; }
    }
}
__device__ __forceinline__ void final_phase(Frame& F, const Args& A) {
    unsigned char* ws = F.ws; const float* gf = (const float*)A.in[24];
    const int gw = F.bid * NWAVES + F.wave, NGW = F.G * NWAVES;
    f32x4 gv[4];
#pragma unroll
    for (int j = 0; j < 4; ++j) gv[j] = *((const f32x4*)gf + F.lane + 64 * j);
    for (int m = gw; m < M + SB; m += NGW) {
        const bool P = m < M; const int r = P ? m : m - M;
        const float* x = P ? (const float*)(ws + WS_X) + (size_t)r * D : (const float*)(ws + WS_XS) + (size_t)r * D;
        const float ss = (float)(P ? ((const rss_t*)(ws + WS_RSS))[8 * M + r] : ((const rss_t*)(ws + WS_RSSS))[8 * SB + r]) * (1.0f / 16777216.0f);
        float* y = P ? F.out + O_YP + (size_t)r * D : F.out + O_YS + (size_t)r * D;
        const float rs = 1.0f / sqrtf(ss * (1.0f / 1024.0f) + EPS);
#pragma unroll
        for (int j = 0; j < 4; ++j) { const f32x4 v = *((const f32x4*)x + F.lane + 64 * j); *((f32x4*)y + F.lane + 64 * j) = v * rs * gv[j]; }
    }
}

constexpr int NPH = 30;
#ifndef MK_MULTI
#define MK_MULTI 0
#endif
__global__ void __launch_bounds__(NTHR, 2) yoco_fwd(Args args) {
    extern __shared__ __attribute__((aligned(16))) unsigned char lds_raw[];
    LAS unsigned char* const lds_base = (LAS unsigned char*)lds_raw;
    volatile LAS unsigned* MISC = (volatile LAS unsigned*)(lds_base + LDS_MISC_OFF);
    if (threadIdx.x < 32) MISC[threadIdx.x] = 0u;
    __syncthreads();
    const int lo = args.ph_lo, hi = args.ph_hi;
    unsigned* ctl = (unsigned*)(args.ws + WS_CTL);
    XcdBarrier bar; bar.bar = ctl + CW_BAR; bar.x = 0; bar.st = MISC + 8;
    if (hi - lo > 1) bar = xcd_barrier_post(ctl + CW_BAR, MISC + 8);
#ifndef PHMASK
#define PHMASK 0xFFFFFFFFu
#endif
#define PH_BEGIN(id, bit) if (((PHMASK >> (bit)) & 1u) && lo <= (id) && (id) < hi) { Frame F = make_frame(args, lds_base); unsigned char* ws = F.ws; \
    rss_t* RSS = (rss_t*)(ws + WS_RSS); rss_t* RSSS = (rss_t*)(ws + WS_RSSS); bf16* XB = (bf16*)(ws + WS_XB); float* X = (float*)(ws + WS_X); float* XS = (float*)(ws + WS_XS); bf16* XSB = (bf16*)(ws + WS_XSB); \
    LAS unsigned char* ring = F.lds + RING_OFF; (void)RSS; (void)RSSS; (void)XB; (void)X; (void)XS; (void)XSB; (void)ring; \
    const rss_t* rss_in = RSS + (size_t)(2 * l) * M; rss_t* rss_mid = RSS + (size_t)(2 * l + 1) * M; rss_t* rss_out = RSS + (size_t)(2 * l + 2) * M; \
    const rss_t* rsss_in = RSSS + (2 * l) * SB; rss_t* rsss_mid = RSSS + (2 * l + 1) * SB; rss_t* rsss_out = RSSS + (2 * l + 2) * SB; (void)rss_in; (void)rss_mid; (void)rss_out; (void)rsss_in; (void)rsss_mid; (void)rsss_out;
#define PH_END(id) if ((id) + 1 < hi) xcd_barrier(bar); }

    { const int l = 0; PH_BEGIN(0, 0) p0_prologue(F, args); PH_END(0) }

    for (int l = 0; l < 4; ++l) {
        const int pb = 1 + 7 * l;
        if (l < 2) {
            PH_BEGIN(pb + 0, 1)
                { SgArgs S{}; S.A = XSB; S.lda = 1024; S.Bt = (const bf16*)(ws + WS_WRGIN) + (size_t)l * 2048 * 1024; S.K = 1024; S.nunits = 64; S.rss_in = rsss_in; S.fout = (float*)(ws + WS_PROJS);
                  sgemm_units<SG_RGIN>(F, S, 0); }
                { pg8::Gemm g{XB, (const bf16*)(ws + WS_WRGIN) + (size_t)l * 2048 * 1024, M, 2048, 1024}; pg8::StaticOrder S; S.init(M, 2048, F.G, F.bid);
                  pg8::EpiRgIn E{rss_in, (bf16*)(ws + WS_GATE), (bf16*)(ws + WS_U), F.out + O_PCONV + (size_t)l * 2 * 3 * 1024};
                  pg8::gemm_phase<pg8::EpiRgIn, pg8::StaticOrder, true, true>(ring, g, S, E); }
            PH_END(pb + 0)
            PH_BEGIN(pb + 1, 2) scan_phase<1>(F, args, l); srg_step(F, args, l); PH_END(pb + 1)
            PH_BEGIN(pb + 2, 3) scan_phase<2>(F, args, l); PH_END(pb + 2)
            PH_BEGIN(pb + 4, 4)
                { SgArgs S{}; S.A = (const bf16*)(ws + WS_HGS); S.lda = 1024; S.Bt = (const bf16*)(ws + WS_WRGOUT) + (size_t)l * 1024 * 1024; S.K = 1024; S.nunits = 32;
                  S.xin = l == 0 ? (const float*)args.in[1] : XS; S.xout = XS; S.xbout = XSB; S.rss_out = rsss_mid; sgemm_units<SG_RESID>(F, S, 0); }
                { pg8::Gemm g{(const bf16*)(ws + WS_HG), (const bf16*)(ws + WS_WRGOUT) + (size_t)l * 1024 * 1024, M, 1024, 1024}; pg8::StaticOrder S; S.init(M, 1024, F.G, F.bid);
                  pg8::EpiResid E{l == 0 ? (const float*)args.in[0] : X, X, XB, rss_mid};
                  pg8::gemm_phase<pg8::EpiResid, pg8::StaticOrder, true, true>(ring, g, S, E); }
            PH_END(pb + 4)
        } else {
            const int a = l - 2;
            PH_BEGIN(pb + 0, 5)
                { SgArgs S{}; S.A = XSB; S.lda = 1024; S.Bt = (const bf16*)(ws + WS_WQKV) + (size_t)(a ? 2048 : 0) * 1024; S.K = 1024; S.nunits = a ? 32 : 64; S.rss_in = rsss_in;
                  S.fout = (float*)(ws + WS_QS); S.sk = F.out + O_SK; S.sv = F.out + O_SV; sgemm_units<SG_QKV>(F, S, 0); }
                { const int N = a ? 1024 : 2048; pg8::Gemm g{XB, (const bf16*)(ws + WS_WQKV) + (size_t)(a ? 2048 : 0) * 1024, M, N, 1024}; pg8::StaticOrder S; S.init(M, N, F.G, F.bid);
                  pg8::EpiQkv E{rss_in, (bf16*)(ws + WS_Q), (bf16*)(ws + WS_KB), (bf16*)(ws + WS_VT), F.out + O_PK, F.out + O_PV, (float*)(ws + WS_KM)};
                  pg8::gemm_phase<pg8::EpiQkv, pg8::StaticOrder, true, true>(ring, g, S, E); }
            PH_END(pb + 0)
            PH_BEGIN(pb + 1, 6) sel_phase(F, a); satt_phase(F, args); PH_END(pb + 1)
            PH_BEGIN(pb + 2, 7) att1_phase(F, a); PH_END(pb + 2)
            PH_BEGIN(pb + 3, 8) att2_phase(F); PH_END(pb + 3)
            PH_BEGIN(pb + 4, 9)
                { SgArgs S{}; S.A = (const bf16*)(ws + WS_OSB); S.lda = 1024; S.Bt = (const bf16*)(ws + WS_WO) + (size_t)a * 1024 * 1024; S.K = 1024; S.nunits = 32;
                  S.xin = XS; S.xout = XS; S.xbout = XSB; S.rss_out = rsss_mid; sgemm_units<SG_RESID>(F, S, 0); }
                { pg8::Gemm g{(const bf16*)(ws + WS_OB), (const bf16*)(ws + WS_WO) + (size_t)a * 1024 * 1024, M, 1024, 1024}; pg8::StaticOrder S; S.init(M, 1024, F.G, F.bid);
                  pg8::EpiResid E{X, X, XB, rss_mid};
                  pg8::gemm_phase<pg8::EpiResid, pg8::StaticOrder, true, true>(ring, g, S, E); }
            PH_END(pb + 4)
        }
        PH_BEGIN(pb + 5, 10)
            { SgArgs S{}; S.A = XSB; S.lda = 1024; S.Bt = (const bf16*)(ws + WS_WFIN) + (size_t)l * NF2 * 1024; S.K = 1024; S.nunits = 88; S.rss_in = rsss_mid; S.bout = (bf16*)(ws + WS_ACTS);
              sgemm_units<SG_FFNIN>(F, S, 128); }
            { pg8::Gemm g{XB, (const bf16*)(ws + WS_WFIN) + (size_t)l * NF2 * 1024, M, NF2, 1024}; pg8::StaticOrder S; S.init(M, NF2, F.G, F.bid);
              pg8::EpiFfnIn E{rss_mid, (bf16*)(ws + WS_ACT)};
              pg8::gemm_phase<pg8::EpiFfnIn, pg8::StaticOrder, true, true>(ring, g, S, E); }
        PH_END(pb + 5)
        PH_BEGIN(pb + 6, 11)
            { SgArgs S{}; S.A = (const bf16*)(ws + WS_ACTS); S.lda = FF; S.Bt = (const bf16*)(ws + WS_WFOUT) + (size_t)l * 1024 * FF; S.K = FF; S.nunits = 32;
              S.xin = XS; S.xout = XS; S.xbout = XSB; S.rss_out = rsss_out; sgemm_units<SG_RESID>(F, S, 0); }
            { pg8::Gemm g{(const bf16*)(ws + WS_ACT), (const bf16*)(ws + WS_WFOUT) + (size_t)l * 1024 * FF, M, 1024, FF}; pg8::StaticOrder S; S.init(M, 1024, F.G, F.bid);
              pg8::EpiResid E{X, X, XB, rss_out};
              pg8::gemm_phase<pg8::EpiResid, pg8::StaticOrder, true, true>(ring, g, S, E); }
        PH_END(pb + 6)
    }
    { const int l = 0; PH_BEGIN(29, 12) final_phase(F, args); PH_END(29) }
#undef PH_BEGIN
#undef PH_END
}

extern "C" void kernel_launch(void* const* d_in, const int* in_sizes, int n_in, void* d_out, int out_size, void* d_ws, size_t ws_size, hipStream_t stream) {
    static int grid = 0;
    if (grid == 0) {
        if (n_in != 25 || out_size != (int)O_END || ws_size < WS_END) { fprintf(stderr, "kernel_launch: unexpected shapes (n_in %d, out %d, ws %zu); nothing launched\n", n_in, out_size, ws_size); grid = -1; return; }
        int dev = 0, cus = 0, per_cu = 0;
        if (hipGetDevice(&dev) != hipSuccess || hipDeviceGetAttribute(&cus, hipDeviceAttributeMultiprocessorCount, dev) != hipSuccess) { fprintf(stderr, "kernel_launch: device query failed\n"); grid = -1; return; }
        if (hipFuncSetAttribute((const void*)yoco_fwd, hipFuncAttributeMaxDynamicSharedMemorySize, LDS_BYTES) != hipSuccess) { fprintf(stderr, "kernel_launch: hipFuncSetAttribute failed\n"); grid = -1; return; }
        if (hipOccupancyMaxActiveBlocksPerMultiprocessor(&per_cu, (const void*)yoco_fwd, NTHR, LDS_BYTES) != hipSuccess || per_cu < 1) { fprintf(stderr, "kernel_launch: occupancy query says %d blocks per CU\n", per_cu); per_cu = 1; }
        (void)hipGetLastError();
        grid = cus;
    }
    if (grid < 0) return;
    (void)in_sizes;
    if (hipMemsetAsync(d_ws, 0, ZERO_BYTES, stream) != hipSuccess) { fprintf(stderr, "kernel_launch: memset failed\n"); return; }
    Args a; memset(&a, 0, sizeof(a));
    for (int i = 0; i < 25; ++i) a.in[i] = d_in[i];
    a.out = (float*)d_out; a.ws = (unsigned char*)d_ws;
#if MK_MULTI
    for (int p = 0; p < NPH; ++p) {
        if (p >= 1 && p <= 28) { const int l = (p - 1) / 7, k = (p - 1) % 7; if (l < 2 && k == 3) continue; }
        a.ph_lo = p; a.ph_hi = p + 1;
        hipLaunchKernelGGL(yoco_fwd, dim3(grid), dim3(NTHR), LDS_BYTES, stream, a);
    }
#else
    a.ph_lo = 0; a.ph_hi = NPH;
    hipLaunchKernelGGL(yoco_fwd, dim3(grid), dim3(NTHR), LDS_BYTES, stream, a);
#endif
    const hipError_t le = hipPeekAtLastError();
    if (le != hipSuccess) fprintf(stderr, "kernel_launch: launch failed: %s\n", hipGetErrorName(le));
}
```

```cpp
#include <hip/hip_runtime.h>
#include <cstdio>
#include <cstdint>
#include <cstring>
#define MK_MULTI 0
namespace pg8 {
#define PG8_LAS __attribute__((address_space(3)))
typedef unsigned short bf16_t;
typedef short bf16x8 __attribute__((ext_vector_type(8)));
typedef float f32x4 __attribute__((ext_vector_type(4)));
typedef unsigned u32x4 __attribute__((ext_vector_type(4)));
constexpr int BM = 256, BK = 64, HALF = 128, HTB = HALF * BK * 2  , STAGE_BYTES = 8 * HTB, NXCD = 8, WGM = 8;

__host__ __device__ __forceinline__ int lds_byte(int r, int c) { const int st = (r >> 4) * 2 + (c >> 5), rr = r & 15, cc = c & 31, ob = rr * 64 + cc * 2; return st * 1024 + (ob ^ (((ob >> 9) & 1) << 5)); }
__host__ __device__ __forceinline__ void stage_rc(int b, int& R, int& C) { const int st = b / 1024, sb = b % 1024, swz = sb ^ (((sb >> 9) & 1) << 5); R = (st >> 1) * 16 + swz / 64; C = (st & 1) * 32 + (swz % 64) / 2; }
__host__ __device__ __forceinline__ int perm32(int rho) { const int n = rho >> 4, i = rho & 15; return 8 * (i >> 2) + 4 * n + (i & 3); }

struct Unit { int pm, pn, rofs; };
struct Gemm { const bf16_t* A; const bf16_t* Bt; int M, N, K; int wv = 0; };
__device__ __forceinline__ int tid_of(int wave) { int l_; asm volatile("v_mbcnt_lo_u32_b32 %0, -1, 0\n\tv_mbcnt_hi_u32_b32 %0, -1, %0" : "=&v"(l_));
    return l_ + 64 * wave; }

struct StaticOrder {
    int nM, nN, nwg, G, c;
    __host__ __device__ void init(int M, int N, int G_, int c_) { nM = M / BM; nN = N / BM; nwg = nM * nN; G = G_; c = c_; }
    __host__ __device__ __forceinline__ bool next(int i, Unit& u) const {
        const long L = (long)i * G + c; if (L >= nwg) return false;
        int wgid = (int)L; { const int q = nwg / NXCD, r = nwg % NXCD, xcd = wgid % NXCD, off = wgid / NXCD; wgid = (xcd < r ? xcd * (q + 1) : r * (q + 1) + (xcd - r) * q) + off; }
        const int nig = WGM * nN, gid = wgid / nig, fm = gid * WGM, gsz = (nM - fm) < WGM ? (nM - fm) : WGM;
        u.pm = fm + ((wgid % nig) % gsz); u.pn = (wgid % nig) / gsz; u.rofs = 0; return true;
    }
    __device__ __forceinline__ void a_ready(const Unit&) const {}
    __device__ __forceinline__ void done(const Unit&) const {}
};
struct RoundsOrder : StaticOrder { int maxr; __host__ __device__ bool next(int i, Unit& u) const { return i < maxr && StaticOrder::next(i, u); } };
struct HalfOrder : StaticOrder { int maxr; __host__ __device__ bool next(int i, Unit& u) const { if (i != 0) return false; StaticOrder t = *this; t.c = c >> 1; if (!t.next(maxr, u)) return false; u.rofs = (c & 1) * HALF; return true; } };


__device__ __forceinline__ unsigned cvt_pk_bf16(float lo, float hi) { unsigned r; asm volatile("v_cvt_pk_bf16_f32 %0, %1, %2" : "=v"(r) : "v"(lo), "v"(hi)); return r; }
typedef float f32x2 __attribute__((ext_vector_type(2)));
typedef unsigned u32x2 __attribute__((ext_vector_type(2)));
constexpr float RMS_EPS = 1e-6f;
__device__ __forceinline__ float fast_rcp(float x) { return __builtin_amdgcn_rcpf(x); }
__device__ __forceinline__ float fast_exp2(float x) { return __builtin_amdgcn_exp2f(x); }
__device__ __forceinline__ float sigmoidf_(float z) { return fast_rcp(1.0f + fast_exp2(-1.44269504089f * z)); }
__device__ __forceinline__ float gelu_tanh(float x) { const float z = 1.5957691216057308f * (x + 0.044715f * x * x * x); return x * sigmoidf_(z); }
__device__ __forceinline__ float silu_(float x) { return x * sigmoidf_(x); }
typedef unsigned long long rss_t;
constexpr float RSS_SCALE = 16777216.0f, RSS_INV = 1.0f / (16777216.0f * 1024.0f);
__device__ __forceinline__ float row_rs(const rss_t* rowss, int r) { return __builtin_amdgcn_rsqf((float)rowss[r] * RSS_INV + RMS_EPS); }
__device__ __forceinline__ float rs_of(rss_t raw) { return __builtin_amdgcn_rsqf((float)raw * RSS_INV + RMS_EPS); }

struct EpiRgIn {
    static constexpr bool PERM = true, AFTER_DRAIN = false;
    const rss_t* rowss; bf16_t* gate; bf16_t* u; float* pconv;
    const PG8_LAS float* rsl = nullptr; int rs_pm = -1;
    __device__ __forceinline__ void operator()(const f32x4 (&acc)[2][2][4][2], const Unit& un, int wr, int wc, int fr, int fq) const {
        const bool isU = un.pn >= 4; const int colb = (un.pn & 3) * BM + wc * 32 + 8 * fq;
        rss_t rsw[2][4]; float rsv[2][4];
        if (un.pm == rs_pm) {
#pragma unroll
        for (int ai = 0; ai < 2; ++ai)
#pragma unroll
            for (int m = 0; m < 4; ++m) rsv[ai][m] = rsl[ai * HALF + wr * 64 + m * 16 + fr];
        } else {
#pragma unroll
        for (int ai = 0; ai < 2; ++ai)
#pragma unroll
            for (int m = 0; m < 4; ++m) rsw[ai][m] = rowss[un.pm * BM + ai * HALF + wr * 64 + m * 16 + fr];
#pragma unroll
        for (int ai = 0; ai < 2; ++ai)
#pragma unroll
            for (int m = 0; m < 4; ++m) rsv[ai][m] = rs_of(rsw[ai][m]);
        }
#pragma unroll
        for (int ai = 0; ai < 2; ++ai)
#pragma unroll
            for (int m = 0; m < 4; ++m) { const int r = un.pm * BM + ai * HALF + wr * 64 + m * 16 + fr; const float rs = rsv[ai][m];
#pragma unroll
                for (int bj = 0; bj < 2; ++bj) { f32x4 v0 = acc[ai][bj][m][0] * rs, v1 = acc[ai][bj][m][1] * rs; const int c = colb + bj * HALF;
                    if (!isU) {
#pragma unroll
                        for (int hv = 0; hv < 2; ++hv) { f32x4& x = hv ? v1 : v0;
                            const f32x4 z = (x * (x * x * 0.044715f + 1.0f)) * (-1.44269504089f * 1.5957691216057308f);
                            const f32x4 d = (f32x4){fast_exp2(z[0]), fast_exp2(z[1]), fast_exp2(z[2]), fast_exp2(z[3])} + 1.0f;
                            x = x * (f32x4){fast_rcp(d[0]), fast_rcp(d[1]), fast_rcp(d[2]), fast_rcp(d[3])}; }
                        u32x4 w; w.x = cvt_pk_bf16(v0[0], v0[1]); w.y = cvt_pk_bf16(v0[2], v0[3]); w.z = cvt_pk_bf16(v1[0], v1[1]); w.w = cvt_pk_bf16(v1[2], v1[3]);
                        *(u32x4*)(gate + (size_t)r * 1024 + c) = w;
                    } else {
                        u32x4 w; w.x = cvt_pk_bf16(v0[0], v0[1]); w.y = cvt_pk_bf16(v0[2], v0[3]); w.z = cvt_pk_bf16(v1[0], v1[1]); w.w = cvt_pk_bf16(v1[2], v1[3]);
                        *(u32x4*)(u + (size_t)r * 1024 + c) = w;
                        const int t = r & 8191;
                        if (t >= 8189) { float* pc = pconv + (size_t)((r >> 13) * 3 + (t - 8189)) * 1024 + c; *(f32x4*)pc = v0; *(f32x4*)(pc + 4) = v1; }
                    } } }
    }
};

__device__ __forceinline__ float bf_lo(unsigned w) { return __uint_as_float(w << 16); }
__device__ __forceinline__ float bf_hi(unsigned w) { return __uint_as_float(w & 0xffff0000u); }
struct EpiResid {
    static constexpr bool PERM = true, AFTER_DRAIN = false;
    const bf16_t* xin; bf16_t* xb; rss_t* rowss_out;
    __device__ __forceinline__ void operator()(const f32x4 (&acc)[2][2][4][2], const Unit& un, int wr, int wc, int fr, int fq) const {
        const int colb = un.pn * BM + wc * 32 + 8 * fq;
#pragma unroll
        for (int ai = 0; ai < 2; ++ai) {
            u32x4 xr[4][2];
#pragma unroll
            for (int m = 0; m < 4; ++m)
#pragma unroll
                for (int bj = 0; bj < 2; ++bj) xr[m][bj] = *(const u32x4*)(xin + (size_t)(un.pm * BM + ai * HALF + wr * 64 + m * 16 + fr) * 1024 + colb + bj * HALF);
#pragma unroll
            for (int m = 0; m < 4; ++m) { const int r = un.pm * BM + ai * HALF + wr * 64 + m * 16 + fr; float ss = 0.f;
#pragma unroll
                for (int bj = 0; bj < 2; ++bj) { const size_t off = (size_t)r * 1024 + colb + bj * HALF; const u32x4 xw = xr[m][bj];
                    const f32x4 x0 = (f32x4){bf_lo(xw.x), bf_hi(xw.x), bf_lo(xw.y), bf_hi(xw.y)} + acc[ai][bj][m][0], x1 = (f32x4){bf_lo(xw.z), bf_hi(xw.z), bf_lo(xw.w), bf_hi(xw.w)} + acc[ai][bj][m][1];
                    u32x4 w; w.x = cvt_pk_bf16(x0[0], x0[1]); w.y = cvt_pk_bf16(x0[2], x0[3]); w.z = cvt_pk_bf16(x1[0], x1[1]); w.w = cvt_pk_bf16(x1[2], x1[3]);
                    *(u32x4*)(xb + off) = w;
                    { const f32x4 sq = x0 * x0 + x1 * x1; ss += (sq[0] + sq[1]) + (sq[2] + sq[3]); } }
                ss += __shfl_xor(ss, 16); ss += __shfl_xor(ss, 32);
                if (fq == 0) atomicAdd(rowss_out + r, (rss_t)(ss * RSS_SCALE)); }
            asm volatile("" ::: "memory"); }
    }
};

struct EpiResidFinal {
    static constexpr bool PERM = true, AFTER_DRAIN = true;
    const bf16_t* xin; rss_t* rowss_out; unsigned* cnt; const float* gfin; float* y;
    __device__ __forceinline__ void fused(f32x4 (&acc)[2][2][4][2], const Unit& un, int wr, int wc, int fr, int fq, PG8_LAS unsigned char*, int, int) const {
        const int colb = un.pn * BM + wc * 32 + 8 * fq;
#pragma unroll
        for (int ai = 0; ai < 2; ++ai) {
            u32x4 xr[4][2];
#pragma unroll
            for (int m = 0; m < 4; ++m)
#pragma unroll
                for (int bj = 0; bj < 2; ++bj) xr[m][bj] = *(const u32x4*)(xin + (size_t)(un.pm * BM + ai * HALF + wr * 64 + m * 16 + fr) * 1024 + colb + bj * HALF);
#pragma unroll
            for (int m = 0; m < 4; ++m) { const int r = un.pm * BM + ai * HALF + wr * 64 + m * 16 + fr; float ss = 0.f;
#pragma unroll
                for (int bj = 0; bj < 2; ++bj) { const u32x4 xw = xr[m][bj];
                    const f32x4 x0 = (f32x4){bf_lo(xw.x), bf_hi(xw.x), bf_lo(xw.y), bf_hi(xw.y)} + acc[ai][bj][m][0], x1 = (f32x4){bf_lo(xw.z), bf_hi(xw.z), bf_lo(xw.w), bf_hi(xw.w)} + acc[ai][bj][m][1];
                    acc[ai][bj][m][0] = x0; acc[ai][bj][m][1] = x1;
                    { const f32x4 sq = x0 * x0 + x1 * x1; ss += (sq[0] + sq[1]) + (sq[2] + sq[3]); } }
                ss += __shfl_xor(ss, 16); ss += __shfl_xor(ss, 32);
                if (fq == 0) atomicAdd(rowss_out + r, (rss_t)(ss * RSS_SCALE)); }
            asm volatile("" ::: "memory"); }
        asm volatile("s_waitcnt vmcnt(0)" ::: "memory");
        __syncthreads();
        if (wr == 0 && wc == 0 && fr == 0 && fq == 0) { unsigned* c = cnt + 64 * un.pm; __hip_atomic_fetch_add(c, 1u, __ATOMIC_RELAXED, __HIP_MEMORY_SCOPE_AGENT);
            for (unsigned sp = 0; sp < (1u << 22); ++sp) { if (__hip_atomic_load(c, __ATOMIC_RELAXED, __HIP_MEMORY_SCOPE_AGENT) >= 4u) break; __builtin_amdgcn_s_sleep(2); } }
        __syncthreads();
        rss_t rsw[2][4]; float rsv[2][4];
#pragma unroll
        for (int ai = 0; ai < 2; ++ai)
#pragma unroll
            for (int m = 0; m < 4; ++m) rsw[ai][m] = __hip_atomic_load(rowss_out + (un.pm * BM + ai * HALF + wr * 64 + m * 16 + fr), __ATOMIC_RELAXED, __HIP_MEMORY_SCOPE_AGENT);
        __builtin_amdgcn_sched_barrier(0);
#pragma unroll
        for (int ai = 0; ai < 2; ++ai)
#pragma unroll
            for (int m = 0; m < 4; ++m) rsv[ai][m] = rs_of(rsw[ai][m]);
        f32x4 gv[2][2];
#pragma unroll
        for (int bj = 0; bj < 2; ++bj) { gv[bj][0] = *(const f32x4*)(gfin + colb + bj * HALF); gv[bj][1] = *(const f32x4*)(gfin + colb + bj * HALF + 4); }
#pragma unroll
        for (int ai = 0; ai < 2; ++ai)
#pragma unroll
            for (int m = 0; m < 4; ++m) { const size_t r = (size_t)(un.pm * BM + ai * HALF + wr * 64 + m * 16 + fr); const float rs = rsv[ai][m];
#pragma unroll
                for (int bj = 0; bj < 2; ++bj) { float* yp = y + r * 1024 + colb + bj * HALF; *(f32x4*)yp = acc[ai][bj][m][0] * rs * gv[bj][0]; *(f32x4*)(yp + 4) = acc[ai][bj][m][1] * rs * gv[bj][1]; } }
    }
};

template <bool HALFM> struct EpiFfnIn {
    static constexpr bool PERM = true, AFTER_DRAIN = false;
    const rss_t* rowss; bf16_t* act;
    const PG8_LAS float* rsl = nullptr; int rs_pm = -1;
    __device__ __forceinline__ void operator()(const f32x4 (&acc)[2][2][4][2], const Unit& un, int wr, int wc, int fr, int fq) const {
        const int colb = un.pn * HALF + wc * 32 + 8 * fq;
        rss_t rsw[2][4]; float rsv[2][4];
        if (un.pm == rs_pm) {
#pragma unroll
        for (int ai = 0; ai < (HALFM ? 1 : 2); ++ai)
#pragma unroll
            for (int m = 0; m < 4; ++m) rsv[ai][m] = rsl[un.rofs + ai * HALF + wr * 64 + m * 16 + fr];
        } else {
#pragma unroll
        for (int ai = 0; ai < (HALFM ? 1 : 2); ++ai)
#pragma unroll
            for (int m = 0; m < 4; ++m) rsw[ai][m] = rowss[un.pm * BM + un.rofs + ai * HALF + wr * 64 + m * 16 + fr];
#pragma unroll
        for (int ai = 0; ai < (HALFM ? 1 : 2); ++ai)
#pragma unroll
            for (int m = 0; m < 4; ++m) rsv[ai][m] = rs_of(rsw[ai][m]);
        }
#pragma unroll
        for (int ai = 0; ai < (HALFM ? 1 : 2); ++ai)
#pragma unroll
            for (int m = 0; m < 4; ++m) { const int r = un.pm * BM + un.rofs + ai * HALF + wr * 64 + m * 16 + fr; const float rs = rsv[ai][m];
                const float nrs = -1.44269504089f * rs, rs2 = rs * rs; f32x4 g0, g1;
                { const f32x4 G = acc[ai][0][m][0], U = acc[ai][1][m][0]; const f32x4 z = G * nrs; const f32x4 d = (f32x4){fast_exp2(z[0]), fast_exp2(z[1]), fast_exp2(z[2]), fast_exp2(z[3])} + 1.0f;
                  g0 = ((G * U) * rs2) * (f32x4){fast_rcp(d[0]), fast_rcp(d[1]), fast_rcp(d[2]), fast_rcp(d[3])}; }
                { const f32x4 G = acc[ai][0][m][1], U = acc[ai][1][m][1]; const f32x4 z = G * nrs; const f32x4 d = (f32x4){fast_exp2(z[0]), fast_exp2(z[1]), fast_exp2(z[2]), fast_exp2(z[3])} + 1.0f;
                  g1 = ((G * U) * rs2) * (f32x4){fast_rcp(d[0]), fast_rcp(d[1]), fast_rcp(d[2]), fast_rcp(d[3])}; }
                u32x4 w; w.x = cvt_pk_bf16(g0[0], g0[1]); w.y = cvt_pk_bf16(g0[2], g0[3]); w.z = cvt_pk_bf16(g1[0], g1[1]); w.w = cvt_pk_bf16(g1[2], g1[3]);
                *(u32x4*)(act + (size_t)r * 2816 + colb) = w; }
    }
};

constexpr float QSCALE = 0.08838834764831845f * 1.4426950408889634f;
struct EpiQkv {
    static constexpr bool PERM = false, AFTER_DRAIN = false;
    const rss_t* rowss; bf16_t* q; bf16_t* kb; bf16_t* vt; float* pk; float* pv; float* km;
    const PG8_LAS float* rsl = nullptr; int rs_pm = -1;
    __device__ __forceinline__ void operator()(const f32x4 (&acc)[2][2][4][2], const Unit& un, int wr, int wc, int fr, int fq) const {
        const int kind = un.pn < 4 ? 0 : (un.pn < 6 ? 1 : 2);
        float inv[4];
#pragma unroll
        for (int i = 0; i < 4; ++i) inv[i] = fast_exp2(-(float)(4 * fq + i) * (18.931568569324174f / 16.0f)) * 0.15915494309189535f;
        f32x4 cs[2][2];
#pragma unroll
        for (int bj = 0; bj < 2; ++bj)
#pragma unroll
            for (int n = 0; n < 2; ++n) cs[bj][n] = (f32x4){0.f, 0.f, 0.f, 0.f};
        rss_t rsw[2][4]; float rsv[2][4];
        if (un.pm == rs_pm) {
#pragma unroll
        for (int ai = 0; ai < 2; ++ai)
#pragma unroll
            for (int m = 0; m < 4; ++m) rsv[ai][m] = rsl[ai * HALF + wr * 64 + m * 16 + fr];
        } else {
#pragma unroll
        for (int ai = 0; ai < 2; ++ai)
#pragma unroll
            for (int m = 0; m < 4; ++m) rsw[ai][m] = rowss[un.pm * BM + ai * HALF + wr * 64 + m * 16 + fr];
#pragma unroll
        for (int ai = 0; ai < 2; ++ai)
#pragma unroll
            for (int m = 0; m < 4; ++m) rsv[ai][m] = rs_of(rsw[ai][m]);
        }
#pragma unroll
        for (int ai = 0; ai < 2; ++ai)
#pragma unroll
            for (int m = 0; m < 4; ++m) { const int r = un.pm * BM + ai * HALF + wr * 64 + m * 16 + fr; const float rs = rsv[ai][m]; const int t = r & 8191, b = r >> 13;
                float co[4], si[4];
                if (kind < 2 && wc == 0) {
#pragma unroll
                    for (int i = 0; i < 4; ++i) { float rev = (float)t * inv[i]; rev = rev - floorf(rev); co[i] = __builtin_amdgcn_cosf(rev); si[i] = __builtin_amdgcn_sinf(rev); } }
#pragma unroll
                for (int bj = 0; bj < 2; ++bj) { f32x4 v0 = acc[ai][bj][m][0] * rs, v1 = acc[ai][bj][m][1] * rs;
                    if (kind < 2 && wc == 0) {
#pragma unroll
                        for (int i = 0; i < 4; ++i) { const float x1 = v0[i], x2 = v1[i]; v0[i] = x1 * co[i] - x2 * si[i]; v1[i] = x2 * co[i] + x1 * si[i]; } }
                    const int d0 = wc * 32 + 4 * fq;
                    if (kind == 0) { const int h = un.pn * 2 + bj; bf16_t* qp = q + (size_t)r * 1024 + h * 128 + d0;
                        u32x2 w0, w1; w0.x = cvt_pk_bf16(v0[0] * QSCALE, v0[1] * QSCALE); w0.y = cvt_pk_bf16(v0[2] * QSCALE, v0[3] * QSCALE); w1.x = cvt_pk_bf16(v1[0] * QSCALE, v1[1] * QSCALE); w1.y = cvt_pk_bf16(v1[2] * QSCALE, v1[3] * QSCALE);
                        *(u32x2*)qp = w0; *(u32x2*)(qp + 16) = w1;
                    } else if (kind == 1) { const int g = (un.pn - 4) * 2 + bj; const size_t o = ((size_t)r * 4 + g) * 128 + d0;
                        *(f32x4*)(pk + o) = v0; *(f32x4*)(pk + o + 16) = v1;
                        u32x2 w0, w1; w0.x = cvt_pk_bf16(v0[0], v0[1]); w0.y = cvt_pk_bf16(v0[2], v0[3]); w1.x = cvt_pk_bf16(v1[0], v1[1]); w1.y = cvt_pk_bf16(v1[2], v1[3]);
                        *(u32x2*)(kb + o) = w0; *(u32x2*)(kb + o + 16) = w1;
                        cs[bj][0] += v0; cs[bj][1] += v1;
                    } else { const int g = (un.pn - 6) * 2 + bj; const size_t o = ((size_t)r * 4 + g) * 128 + d0;
                        *(f32x4*)(pv + o) = v0; *(f32x4*)(pv + o + 16) = v1;
                        bf16_t* vp = vt + ((size_t)(b * 4 + g) * 128 + d0) * 8192 + t;
#pragma unroll
                        for (int i = 0; i < 4; ++i) { vp[(size_t)i * 8192] = (bf16_t)(cvt_pk_bf16(v0[i], 0.f) & 0xffffu); vp[(size_t)(16 + i) * 8192] = (bf16_t)(cvt_pk_bf16(v1[i], 0.f) & 0xffffu); }
                    } } }
        if (kind == 1) {
            const int b = un.pm >> 5, blk = un.pm & 31;
#pragma unroll
            for (int bj = 0; bj < 2; ++bj)
#pragma unroll
                for (int n = 0; n < 2; ++n)
#pragma unroll
                    for (int i = 0; i < 4; ++i) { float s = cs[bj][n][i]; s += __shfl_xor(s, 1); s += __shfl_xor(s, 2); s += __shfl_xor(s, 4); s += __shfl_xor(s, 8);
                        if (fr == 0) unsafeAtomicAdd(km + (size_t)(b * 32 + blk) * 512 + ((un.pn - 4) * 2 + bj) * 128 + wc * 32 + 16 * n + 4 * fq + i, s * (1.0f / 256.0f)); }
        }
    }
};
struct NoHook { __device__ __forceinline__ void operator()() const {} };
template <class Epi, class Sched, bool ALIGN_EPI = false, bool SP2 = false, bool HALFM = false, class Hook = NoHook>
__device__ __forceinline__ void gemm_phase(PG8_LAS unsigned char* lds, const Gemm g, const Sched& S, const Epi& E, const Hook& hook = Hook()) {
    int tid_l = tid_of(g.wv); asm volatile("" : "+v"(tid_l));
    const int tid = tid_l, wid = __builtin_amdgcn_readfirstlane(tid >> 6), lane = tid & 63, wr = wid >> 2, wc = wid & 3, fr = lane & 15, fq = lane >> 4;
    const int K = g.K, nt = K / BK;
    unsigned voffA[2], voffB[2];
#pragma unroll
    for (int i = 0; i < 2; ++i) { int R, C; stage_rc(tid * 16 + i * 8192, R, C); const int Rb = Epi::PERM ? ((R & ~31) + perm32(R & 31)) : R;
        voffA[i] = (unsigned)(R * K + C) * 2u; voffB[i] = (unsigned)(Rb * K + C) * 2u; }
    const size_t kstep = (size_t)(BK * 2);
    const size_t hstep = (size_t)HALF * K * 2;
    const size_t tstep = 2 * hstep;
    const unsigned ldsw = (unsigned)wid * 1024u;
    const int aoff = lds_byte(wr * 64 + fr, fq * 8), boff = lds_byte(wc * 32 + fr, fq * 8);
#define PG8_SA(b, h) (((b) * 2 + (h)) * HTB)
#define PG8_SB(b, h) ((4 + (b) * 2 + (h)) * HTB)
#define PG8_STAGE(bufoff, gbase, voff) do { _Pragma("unroll") for (int _i = 0; _i < 2; ++_i) \
        __builtin_amdgcn_global_load_lds((const unsigned*)((const char*)(gbase) + (voff)[_i]), (PG8_LAS unsigned*)(lds + (bufoff) + ldsw + _i * 8192), 16, 0, 0); } while (0)
#define PG8_LDA(dst, b, h) do { _Pragma("unroll") for (int m = 0; m < 4; ++m) _Pragma("unroll") for (int k = 0; k < 2; ++k) dst[m][k] = *(const PG8_LAS bf16x8*)(lds + PG8_SA(b, h) + aoff + m * 2048 + k * 1024); } while (0)
#define PG8_LDB(dst, b, h) do { _Pragma("unroll") for (int n = 0; n < 2; ++n) _Pragma("unroll") for (int k = 0; k < 2; ++k) dst[n][k] = *(const PG8_LAS bf16x8*)(lds + PG8_SB(b, h) + boff + n * 2048 + k * 1024); } while (0)
#define PG8_MMA(ai, bj, At, Bt) do { __builtin_amdgcn_s_setprio(1); _Pragma("unroll") for (int m = 0; m < 4; ++m) _Pragma("unroll") for (int n = 0; n < 2; ++n) _Pragma("unroll") for (int k = 0; k < 2; ++k) \
        acc[ai][bj][m][n] = __builtin_amdgcn_mfma_f32_16x16x32_bf16(Bt[n][k], At[m][k], acc[ai][bj][m][n], 0, 0, 0); __builtin_amdgcn_s_setprio(0); } while (0)
#define PG8_WAIT_V(n) asm volatile("s_waitcnt vmcnt(" #n ")" ::: "memory")
#define PG8_WAIT_L(n) asm volatile("s_waitcnt lgkmcnt(" #n ")" ::: "memory")
#define PG8_BAR __builtin_amdgcn_s_barrier()
#define PG8_SCHED __builtin_amdgcn_sched_barrier(0)
    Unit cur, nxt; int ui = 0;
    if (!S.next(0, cur)) { hook(); return; }
    f32x4 acc[2][2][4][2];
#pragma unroll
    for (int a = 0; a < 2; ++a)
#pragma unroll
        for (int b = 0; b < 2; ++b)
#pragma unroll
            for (int m = 0; m < 4; ++m)
#pragma unroll
                for (int n = 0; n < 2; ++n) acc[a][b][m][n] = (f32x4){0.f, 0.f, 0.f, 0.f};
    bf16x8 At[4][2], B0[2][2], B1[2][2];
    const char* cA = (const char*)g.A + (size_t)cur.pm * tstep + (size_t)cur.rofs * K * 2; const char* cB = (const char*)g.Bt + (size_t)cur.pn * tstep;
    S.a_ready(cur);
    if constexpr (SP2) {
        PG8_STAGE(PG8_SB(0, 0), cB, voffB); PG8_STAGE(PG8_SB(0, 1), cB + hstep, voffB); PG8_STAGE(PG8_SA(0, 0), cA, voffA); PG8_STAGE(PG8_SA(0, 1), cA + hstep, voffA);
        hook();
        if (wr == 1) PG8_BAR;
        PG8_WAIT_V(2); PG8_BAR;
        PG8_STAGE(PG8_SB(1, 0), cB + kstep, voffB); PG8_STAGE(PG8_SA(1, 0), cA + kstep, voffA); PG8_STAGE(PG8_SB(1, 1), cB + hstep + kstep, voffB);
        PG8_WAIT_V(6); PG8_BAR;
    } else {
        PG8_STAGE(PG8_SB(0, 0), cB, voffB); PG8_STAGE(PG8_SA(0, 0), cA, voffA); PG8_STAGE(PG8_SB(0, 1), cB + hstep, voffB); PG8_STAGE(PG8_SA(0, 1), cA + hstep, voffA);
        hook();
        if (wr == 1) PG8_BAR;
        PG8_WAIT_V(4); PG8_BAR;
        PG8_STAGE(PG8_SB(1, 0), cB + kstep, voffB); PG8_STAGE(PG8_SA(1, 0), cA + kstep, voffA); PG8_STAGE(PG8_SB(1, 1), cB + hstep + kstep, voffB);
        PG8_WAIT_V(6); PG8_BAR;
    }
    for (;;) {
        const bool has_next = S.next(ui + 1, nxt);
        const char* nA = has_next ? (const char*)g.A + (size_t)nxt.pm * tstep + (size_t)nxt.rofs * K * 2 : cA; const char* nB = has_next ? (const char*)g.Bt + (size_t)nxt.pn * tstep : cB;
        for (int t = 0; t < nt; t += 2) {
            const bool last = (t == nt - 2);
            const char* a1 = cA + (size_t)(t + 1) * kstep;
            const char* a2 = last ? nA : cA + (size_t)(t + 2) * kstep; const char* b2 = last ? nB : cB + (size_t)(t + 2) * kstep;
            const char* a3 = a2 + kstep; const char* b3 = b2 + kstep;
            if (last && has_next) S.a_ready(nxt);
            if constexpr (SP2) {
            PG8_LDB(B0, 0, 0); PG8_LDB(B1, 0, 1); PG8_SCHED; PG8_LDA(At, 0, 0); PG8_STAGE(PG8_SA(1, 1), a1 + hstep, voffA);
            PG8_WAIT_V(8); PG8_WAIT_L(0); PG8_BAR; PG8_MMA(0, 0, At, B0); PG8_MMA(0, 1, At, B1); PG8_BAR; PG8_SCHED;
            if constexpr (!HALFM) PG8_LDA(At, 0, 1); PG8_STAGE(PG8_SB(0, 0), b2, voffB); PG8_STAGE(PG8_SB(0, 1), b2 + hstep, voffB); PG8_STAGE(PG8_SA(0, 0), a2, voffA);
            PG8_WAIT_V(8); PG8_WAIT_L(0); PG8_BAR; if constexpr (!HALFM) { PG8_MMA(1, 0, At, B0); PG8_MMA(1, 1, At, B1); } PG8_BAR; PG8_SCHED;
            PG8_LDB(B0, 1, 0); PG8_LDB(B1, 1, 1); PG8_SCHED; PG8_LDA(At, 1, 0); PG8_STAGE(PG8_SA(0, 1), a2 + hstep, voffA);
            PG8_WAIT_V(8); PG8_WAIT_L(0); PG8_BAR; PG8_MMA(0, 0, At, B0); PG8_MMA(0, 1, At, B1); PG8_BAR; PG8_SCHED;
            if constexpr (!HALFM) PG8_LDA(At, 1, 1); PG8_STAGE(PG8_SB(1, 0), b3, voffB); PG8_STAGE(PG8_SB(1, 1), b3 + hstep, voffB); PG8_STAGE(PG8_SA(1, 0), a3, voffA);
            PG8_WAIT_V(8); PG8_WAIT_L(0); PG8_BAR; if constexpr (!HALFM) { PG8_MMA(1, 0, At, B0); PG8_MMA(1, 1, At, B1); } PG8_BAR; PG8_SCHED;
            } else {
            PG8_LDB(B0, 0, 0); PG8_SCHED; PG8_LDA(At, 0, 0); PG8_STAGE(PG8_SA(1, 1), a1 + hstep, voffA);
            PG8_WAIT_L(8); PG8_BAR; PG8_WAIT_L(0); PG8_MMA(0, 0, At, B0); PG8_BAR; PG8_SCHED;
            PG8_LDB(B1, 0, 1); PG8_STAGE(PG8_SB(0, 0), b2, voffB);
            PG8_BAR; PG8_WAIT_L(0); PG8_MMA(0, 1, At, B1); PG8_BAR;
            PG8_LDA(At, 0, 1); PG8_STAGE(PG8_SA(0, 0), a2, voffA);
            PG8_BAR; PG8_WAIT_L(0); PG8_MMA(1, 0, At, B0); PG8_BAR; PG8_SCHED;
            PG8_STAGE(PG8_SB(0, 1), b2 + hstep, voffB);
            PG8_WAIT_V(6); PG8_BAR; PG8_MMA(1, 1, At, B1); PG8_BAR;
            PG8_LDB(B0, 1, 0); PG8_SCHED; PG8_LDA(At, 1, 0); PG8_STAGE(PG8_SA(0, 1), a2 + hstep, voffA);
            PG8_WAIT_L(8); PG8_BAR; PG8_WAIT_L(0); PG8_MMA(0, 0, At, B0); PG8_BAR; PG8_SCHED;
            PG8_LDB(B1, 1, 1); PG8_STAGE(PG8_SB(1, 0), b3, voffB);
            PG8_BAR; PG8_WAIT_L(0); PG8_MMA(0, 1, At, B1); PG8_BAR;
            PG8_LDA(At, 1, 1); PG8_STAGE(PG8_SA(1, 0), a3, voffA);
            PG8_BAR; PG8_WAIT_L(0); PG8_MMA(1, 0, At, B0); PG8_BAR; PG8_SCHED;
            PG8_STAGE(PG8_SB(1, 1), b3 + hstep, voffB);
            PG8_WAIT_V(6); PG8_BAR; PG8_MMA(1, 1, At, B1); PG8_BAR;
            }
        }
        if constexpr (ALIGN_EPI) { if (wr == 0) PG8_BAR; }
        if constexpr (!Epi::AFTER_DRAIN) { E(acc, cur, wr, wc, fr, fq); S.done(cur); }
        if (!has_next) break;
#pragma unroll
        for (int a = 0; a < 2; ++a)
#pragma unroll
            for (int b = 0; b < 2; ++b)
#pragma unroll
                for (int m = 0; m < 4; ++m)
#pragma unroll
                    for (int n = 0; n < 2; ++n) acc[a][b][m][n] = (f32x4){0.f, 0.f, 0.f, 0.f};
        cur = nxt; cA = nA; cB = nB; ++ui;
        if constexpr (ALIGN_EPI) { if (wr == 1) PG8_BAR; }
    }
    PG8_WAIT_V(0);
    if constexpr (!ALIGN_EPI) { if (wr == 0) PG8_BAR; }
    PG8_BAR;
    if constexpr (Epi::AFTER_DRAIN) { E.fused(acc, cur, wr, wc, fr, fq, lds, wid, lane); S.done(cur); }
#undef PG8_SA
#undef PG8_SB
#undef PG8_STAGE
#undef PG8_LDA
#undef PG8_LDB
#undef PG8_MMA
#undef PG8_WAIT_V
#undef PG8_WAIT_L
#undef PG8_BAR
#undef PG8_SCHED
}
}
#define GAS __attribute__((address_space(1)))
#define LAS __attribute__((address_space(3)))
typedef unsigned short bf16;
typedef unsigned v4u __attribute__((ext_vector_type(4)));
typedef float f32x4 __attribute__((ext_vector_type(4)));
typedef short bf16x8 __attribute__((ext_vector_type(8)));
typedef GAS unsigned gu32;
typedef GAS unsigned long long gu64;
#define RLX_AGENT __ATOMIC_RELAXED, __HIP_MEMORY_SCOPE_AGENT
#define LDS_WAIT() asm volatile("s_waitcnt lgkmcnt(0)" ::: "memory")
#define VM_WAIT() asm volatile("s_waitcnt vmcnt(0)" ::: "memory")
__device__ __forceinline__ unsigned long long rt() { return __builtin_amdgcn_s_memrealtime(); }
__device__ __forceinline__ unsigned f2bf(float f) { unsigned u = __builtin_bit_cast(unsigned, f); return (u + 0x7fffu + ((u >> 16) & 1u)) >> 16; }
__device__ __forceinline__ unsigned pk2(float lo, float hi) { return f2bf(lo) | (f2bf(hi) << 16); }

#define XB_TMO      128
#define XB_XCNT(j)  (256  + 64 * (j))
#define XB_XSUB(j)  (1280 + 64 * (j))
#define XB_XGEN(j)  (2304 + 64 * (j))
#define XB_TOP      3328
#define XB_TOPGEN   3392
#define XCD_BAR_WORDS 3456
#define XB_SPIN_CAP (1u << 18)

__device__ __forceinline__ unsigned xb_ld(unsigned* p)              { return __hip_atomic_load(p, __ATOMIC_RELAXED, __HIP_MEMORY_SCOPE_AGENT); }
__device__ __forceinline__ unsigned xb_add(unsigned* p, unsigned v) { return __hip_atomic_fetch_add(p, v, __ATOMIC_RELAXED, __HIP_MEMORY_SCOPE_AGENT); }
__device__ __forceinline__ unsigned xb_xcc_id() { return (unsigned)__builtin_amdgcn_s_getreg((3 << 11) | 20) & 0xFu; }
#define XB_SPIN(cond, bar) do { unsigned _sp = 0; while (cond) { __builtin_amdgcn_s_sleep(1); \
    if ((++_sp & 255u) == 0u) { if (xb_ld(&(bar)[XB_TMO])) break; if (_sp > XB_SPIN_CAP) { atomicAdd(&(bar)[XB_TMO], 1u); break; } } } } while (0)

__device__ __forceinline__ void xb_spin_while_eq(unsigned* p, unsigned old, unsigned* bar) {
    unsigned v0 = xb_ld(p); __builtin_amdgcn_s_sleep(8); unsigned v1 = xb_ld(p); __builtin_amdgcn_s_sleep(8); unsigned v2 = xb_ld(p); __builtin_amdgcn_s_sleep(8); unsigned v3 = xb_ld(p);
    for (unsigned sp = 0;;) {
        if (v0 != old) return; v0 = xb_ld(p); __builtin_amdgcn_s_sleep(8);
        if (v1 != old) return; v1 = xb_ld(p); __builtin_amdgcn_s_sleep(8);
        if (v2 != old) return; v2 = xb_ld(p); __builtin_amdgcn_s_sleep(8);
        if (v3 != old) return; v3 = xb_ld(p); __builtin_amdgcn_s_sleep(8);
        if ((++sp & 63u) == 0u) { if (xb_ld(&bar[XB_TMO])) return; if (sp > (XB_SPIN_CAP >> 2)) { atomicAdd(&bar[XB_TMO], 1u); return; } }
    }
}

struct XcdBarrier {
    unsigned* bar; unsigned x;
    volatile LAS unsigned* st;
};

__device__ __forceinline__ XcdBarrier xcd_barrier_post(unsigned* bar, volatile LAS unsigned* st) {
    XcdBarrier b; b.bar = bar; b.x = xb_xcc_id(); b.st = st;
    if (threadIdx.x == 0) (void)xb_add(&bar[XB_XCNT(b.x)], 1u);
    return b;
}
__device__ __forceinline__ void xcd_barrier_complete(unsigned* bar, unsigned x, unsigned& nloc, unsigned& nx) {
    const unsigned G = gridDim.x * gridDim.y * gridDim.z;
    unsigned sum, cnt, mine, sp = 0u;
    for (;;) {
        sum = 0u; cnt = 0u; mine = 0u;
        unsigned cv[16];
#pragma unroll
        for (unsigned j = 0; j < 16; ++j) cv[j] = xb_ld(&bar[XB_XCNT(j)]);
        __builtin_amdgcn_sched_barrier(0);
#pragma unroll
        for (unsigned j = 0; j < 16; ++j) { const unsigned c = cv[j]; sum += c; cnt += (c > 0u) ? 1u : 0u; mine = (j == x) ? c : mine; }
        if (sum == G) break;
        __builtin_amdgcn_s_sleep(1);
        if ((++sp & 255u) == 0u) { if (xb_ld(&bar[XB_TMO])) break; if (sp > XB_SPIN_CAP) { atomicAdd(&bar[XB_TMO], 1u); break; } }
    }
    nloc = mine > 0u ? mine : 1u; nx = cnt > 0u ? cnt : 1u;
}

__device__ __forceinline__ void xcd_barrier(const XcdBarrier& b, const bool thread0) {
    asm volatile("s_waitcnt vmcnt(0)" ::: "memory");
    __syncthreads();
    if (thread0) {
        unsigned* bar = b.bar;
        __builtin_amdgcn_s_waitcnt(0);
        unsigned nloc = b.st[0], nx = b.st[1];
        if (nloc == 0u) { xcd_barrier_complete(bar, b.x, nloc, nx); b.st[0] = nloc; b.st[1] = nx; }
        const unsigned old = xb_add(&bar[XB_XSUB(b.x)], 1u);
        const unsigned gen = old / nloc;
        if (old + 1u == (gen + 1u) * nloc) {
            __builtin_amdgcn_fence(__ATOMIC_RELEASE, "agent");
            asm volatile("s_waitcnt vmcnt(0)" ::: "memory");
            const unsigned og = xb_add(&bar[XB_TOP], 1u);
            const unsigned tg = og / nx;
            if (og + 1u == (tg + 1u) * nx) xb_add(&bar[XB_TOPGEN], 1u);
            else xb_spin_while_eq(&bar[XB_TOPGEN], tg, bar);
            __builtin_amdgcn_fence(__ATOMIC_ACQUIRE, "agent");
            xb_add(&bar[XB_XGEN(b.x)], 1u);
            asm volatile("s_waitcnt vmcnt(0)" ::: "memory");
        } else {
            xb_spin_while_eq(&bar[XB_XGEN(b.x)], gen, bar);
            __builtin_amdgcn_fence(__ATOMIC_ACQUIRE, "agent");
            asm volatile("s_waitcnt vmcnt(0)" ::: "memory");
        }
    }
    __syncthreads();
}

constexpr int NWAVES = 8, NTHR = 512;
constexpr int D = 1024, T = 8192, NB = 2, M = NB * T, SB = 32, FF = 2816, NF2 = 5632, NH = 8, HD = 128, KVH = 4, KVD = 512;
constexpr int NPG = 64, PAGE = 128;
constexpr int NBLK = 32;
constexpr float EPS = 1e-6f;
constexpr size_t O_YP = 0, O_YS = 16777216, O_PCONV = 16809984, O_PH = 16822272, O_PK = 16826368, O_PV = 25214976, O_SCONV = 33603584, O_SH = 33800192, O_SK = 33865728, O_SV = 33882112, O_END = 33898496;
constexpr size_t MiB = 1u << 20;
constexpr size_t WS_CTL = 0;
constexpr size_t WS_RSS = 1 * MiB;
constexpr size_t WS_RSSS = 2 * MiB + 256 * 1024;
constexpr size_t WS_KM = 2 * MiB + 512 * 1024;
constexpr size_t WS_CNT = 2 * MiB + 768 * 1024;
constexpr size_t WS_SUMG = 3 * MiB;
constexpr size_t ZERO_BYTES = 4 * MiB;
constexpr size_t WS_WRGIN = 4 * MiB;
constexpr size_t WS_WG = WS_WRGIN + 8 * MiB;
constexpr size_t WS_WRGOUT = WS_WG + 1 * MiB;
constexpr size_t WS_WFIN = WS_WRGOUT + 4 * MiB;
constexpr size_t WS_WFOUT = WS_WFIN + 44 * MiB;
constexpr size_t WS_WQKV = WS_WFOUT + 22 * MiB;
constexpr size_t WS_WO = WS_WQKV + 6 * MiB;
constexpr size_t WS_X = WS_WO + 4 * MiB;
constexpr size_t WS_XB = WS_X + 64 * MiB;
constexpr size_t WS_GATE = WS_XB + 32 * MiB;
constexpr size_t WS_U = WS_GATE + 32 * MiB;
constexpr size_t WS_HG = WS_U + 32 * MiB;
constexpr size_t WS_ACT = WS_HG + 32 * MiB;
constexpr size_t WS_Q = WS_ACT + 88 * MiB;
constexpr size_t WS_KB = WS_Q + 32 * MiB;
constexpr size_t WS_VT = WS_KB + 16 * MiB;
constexpr size_t WS_OB = WS_VT + 16 * MiB;
constexpr size_t WS_PARTO = WS_OB + 32 * MiB;
constexpr size_t WS_PARTML = WS_PARTO + 96 * MiB;
constexpr size_t WS_LIST = WS_PARTML + 3 * MiB;
constexpr size_t WS_SUMM = WS_LIST + 16 * MiB;
constexpr size_t WS_KMC = WS_SUMM + 1 * MiB;
constexpr size_t WS_S = WS_KMC + 2 * MiB;
constexpr size_t WS_XS = WS_S, WS_XSB = WS_S + 128 * 1024, WS_PROJS = WS_S + 192 * 1024, WS_HGS = WS_S + 448 * 1024, WS_ACTS = WS_S + 512 * 1024, WS_QS = WS_S + 704 * 1024, WS_OSB = WS_S + 832 * 1024;
constexpr size_t WS_END = WS_S + 1 * MiB;
constexpr size_t WS_DX = WS_END + 16 * MiB, WS_DXB = WS_DX + 64 * MiB, WS_DRSS = WS_DXB + 32 * MiB, WS_DKM = WS_DRSS + 1 * MiB, WS_NEED = WS_DKM + 1 * MiB;
constexpr int RING_OFF = 0, RING_BYTES = 131072;
constexpr int LDS_MISC_OFF = 144384;
constexpr int LDS_BYTES = 147456;
constexpr int CW_BAR = 4096;
constexpr int CW_FINP = 8192, CW_FINS = 8192 + 64 * 64;

typedef unsigned short bf16;
typedef pg8::bf16x8 bf16x8;
typedef float f32x16 __attribute__((ext_vector_type(16)));
typedef unsigned u32x2 __attribute__((ext_vector_type(2)));
using pg8::rss_t; using pg8::RSS_SCALE; using pg8::RSS_INV; using pg8::cvt_pk_bf16; using pg8::fast_exp2; using pg8::fast_rcp; using pg8::sigmoidf_; using pg8::gelu_tanh; using pg8::silu_;

struct Args { const void* in[25]; float* out; unsigned char* ws; int ph_lo, ph_hi; };
struct Frame { LAS unsigned char* lds; int tid, lane, wave, bid, G; unsigned char* ws; float* out; };
__device__ __forceinline__ Frame make_frame(const Args& args, LAS unsigned char* lds, int wave_s) {
    Frame F; int t = pg8::tid_of(wave_s); asm volatile("" : "+v"(t)); F.tid = t; F.lane = t & 63; F.wave = __builtin_amdgcn_readfirstlane(t >> 6);
    F.bid = blockIdx.x; F.G = gridDim.x; F.lds = lds;
    GAS unsigned char* w = (GAS unsigned char*)args.ws; asm volatile("" : "+s"(w)); F.ws = (unsigned char*)w; GAS float* o = (GAS float*)args.out; asm volatile("" : "+s"(o)); F.out = (float*)o; return F;
}

__device__ __forceinline__ float wave_sum(float v) {
#pragma unroll
    for (int o = 1; o < 64; o <<= 1) v += __shfl_xor(v, o);
    return v;
}
__device__ __forceinline__ float wave_max(float v) {
#pragma unroll
    for (int o = 1; o < 64; o <<= 1) v = fmaxf(v, __shfl_xor(v, o));
    return v;
}
__device__ __forceinline__ unsigned short f2bf1(float f) { return (unsigned short)(cvt_pk_bf16(f, 0.f) & 0xffffu); }
__device__ __forceinline__ float bf2f(unsigned short b) { return __uint_as_float(((unsigned)b) << 16); }
__device__ __forceinline__ float bflo(unsigned w) { return __uint_as_float(w << 16); }
__device__ __forceinline__ float bfhi(unsigned w) { return __uint_as_float(w & 0xffff0000u); }

struct P0Item { const float* W; const float* g; bf16* WT; int K, N, k0, n0, drow0; };
__device__ __forceinline__ void p0_item_make(P0Item& d, const float* W, const float* g, int K, int N, bf16* WT, int mode, int row_off, int item) {
    const int nblk = N / 32, kb = item / nblk, nb = item % nblk; d.W = W; d.g = g; d.WT = WT; d.K = K; d.N = N; d.k0 = 64 * kb; d.n0 = 32 * nb;
    int drow0 = row_off + d.n0;
    if (mode == 1) { const int c = d.n0 < FF ? d.n0 : d.n0 - FF; drow0 = 256 * (c >> 7) + (c & 127) + (d.n0 < FF ? 0 : 128); }
    d.drow0 = drow0;
}
__device__ __forceinline__ void p0_item_load(const P0Item& d, f32x4 (&wv)[8], int lane) {
#pragma unroll
    for (int i = 0; i < 8; ++i) wv[i] = *(const f32x4*)(d.W + (size_t)(d.k0 + 8 * i + (lane >> 3)) * d.N + d.n0 + 4 * (lane & 7));
}
__device__ __forceinline__ void p0_item_finish(const P0Item& d, const f32x4 (&wv)[8], LAS float* scr, int lane) {
#pragma unroll
    for (int i = 0; i < 8; ++i) { const int kk = 8 * i + (lane >> 3); f32x4 v = wv[i]; if (d.g) v = v * d.g[d.k0 + kk]; LAS float* sp = scr + kk * 33 + 4 * (lane & 7); sp[0] = v[0]; sp[1] = v[1]; sp[2] = v[2]; sp[3] = v[3]; }
    LDS_WAIT(); asm volatile("" ::: "memory");
    const int c = lane & 7;
#pragma unroll
    for (int j = 0; j < 4; ++j) { const int n = (lane >> 3) + 8 * j; const LAS float* s = scr + (8 * c) * 33 + n;
        v4u o; o.x = cvt_pk_bf16(s[0 * 33], s[1 * 33]); o.y = cvt_pk_bf16(s[2 * 33], s[3 * 33]); o.z = cvt_pk_bf16(s[4 * 33], s[5 * 33]); o.w = cvt_pk_bf16(s[6 * 33], s[7 * 33]);
        *(v4u*)(d.WT + (size_t)(d.drow0 + n) * d.K + d.k0 + 8 * c) = o; }
    LDS_WAIT(); asm volatile("" ::: "memory");
}
__device__ __forceinline__ void p0_row(const float* xrow, bf16* orow, rss_t* ss_out, int lane) {
    const f32x4* xr = (const f32x4*)xrow + lane; f32x4 v[4]; float s = 0.f;
#pragma unroll
    for (int j = 0; j < 4; ++j) { v[j] = xr[64 * j]; s += (v[j].x * v[j].x + v[j].y * v[j].y) + (v[j].z * v[j].z + v[j].w * v[j].w); }
    s = wave_sum(s);
    u32x2* o8 = (u32x2*)orow + lane;
#pragma unroll
    for (int j = 0; j < 4; ++j) { u32x2 w; w.x = cvt_pk_bf16(v[j].x, v[j].y); w.y = cvt_pk_bf16(v[j].z, v[j].w); o8[64 * j] = w; }
    if (lane == 0) *ss_out = (rss_t)(s * RSS_SCALE);
}
constexpr int I_RGIN = 16 * 64, I_G = 2 * 4, I_RGOUT = 16 * 32, I_FIN = 16 * 176, I_FOUT = 44 * 32, I_SQ = 16 * 32;
constexpr int WL_RG = I_RGIN + 16 * I_G + I_RGOUT + I_FIN + I_FOUT, WL_A0 = 3 * I_SQ + I_FIN + I_FOUT, WL_A1 = 2 * I_SQ + I_FIN + I_FOUT;
__host__ __device__ constexpr int WL_BASE(int l) { return l == 0 ? 0 : l == 1 ? WL_RG : l == 2 ? 2 * WL_RG : l == 3 ? 2 * WL_RG + WL_A0 : 2 * WL_RG + WL_A0 + WL_A1; }
#define P0_DECODE(D, it_) do { int r = (it_); const float* g_mix = (const float*)A.in[7]; const float* g_ffn = (const float*)A.in[8]; \
        const int l = r < WL_BASE(1) ? 0 : r < WL_BASE(2) ? 1 : r < WL_BASE(3) ? 2 : 3; r -= WL_BASE(l); \
        if (l < 2) { \
            if (r < I_RGIN) { p0_item_make(D, (const float*)A.in[9] + (size_t)l * 1024 * 2048, g_mix + l * 1024, 1024, 2048, (bf16*)(ws + WS_WRGIN) + (size_t)l * 2048 * 1024, 0, 0, r); break; } r -= I_RGIN; \
            if (r < 16 * I_G) { const int q = r / I_G, nb = q >> 1, sel = q & 1;   \
                p0_item_make(D, (const float*)A.in[sel ? 14 : 12] + (size_t)(l * 8 + nb) * 128 * 128, nullptr, 128, 128, (bf16*)(ws + WS_WG) + (size_t)(l * 8 + nb) * 256 * 128, 0, sel * 128, r % I_G); break; } r -= 16 * I_G; \
            if (r < I_RGOUT) { p0_item_make(D, (const float*)A.in[17] + (size_t)l * 1024 * 1024, nullptr, 1024, 1024, (bf16*)(ws + WS_WRGOUT) + (size_t)l * 1024 * 1024, 0, 0, r); break; } r -= I_RGOUT; \
        } else if (l == 2) { \
            if (r < I_SQ) { p0_item_make(D, (const float*)A.in[20], g_mix + 2 * 1024, 1024, 1024, (bf16*)(ws + WS_WQKV), 0, 0, r); break; } r -= I_SQ; \
            if (r < I_SQ) { p0_item_make(D, (const float*)A.in[19], (const float*)A.in[18], 1024, 1024, (bf16*)(ws + WS_WQKV), 0, 1024, r); break; } r -= I_SQ; \
            if (r < I_SQ) { p0_item_make(D, (const float*)A.in[21], nullptr, 1024, 1024, (bf16*)(ws + WS_WO), 0, 0, r); break; } r -= I_SQ; \
        } else { \
            if (r < I_SQ) { p0_item_make(D, (const float*)A.in[20] + (size_t)1024 * 1024, g_mix + 3 * 1024, 1024, 1024, (bf16*)(ws + WS_WQKV) + (size_t)2048 * 1024, 0, 0, r); break; } r -= I_SQ; \
            if (r < I_SQ) { p0_item_make(D, (const float*)A.in[21] + (size_t)1024 * 1024, nullptr, 1024, 1024, (bf16*)(ws + WS_WO) + (size_t)1024 * 1024, 0, 0, r); break; } r -= I_SQ; \
        } \
        if (r < I_FIN) { p0_item_make(D, (const float*)A.in[22] + (size_t)l * 1024 * NF2, g_ffn + l * 1024, 1024, NF2, (bf16*)(ws + WS_WFIN) + (size_t)l * NF2 * 1024, 1, 0, r); break; } r -= I_FIN; \
        p0_item_make(D, (const float*)A.in[23] + (size_t)l * FF * 1024, nullptr, FF, 1024, (bf16*)(ws + WS_WFOUT) + (size_t)l * 1024 * FF, 0, 0, r); } while (0)
__device__ __forceinline__ void conv_shadow(Frame& F, const Args& A, int lcur, int slot, int shift, int nunits) {
    if (lcur >= 3) return;
    unsigned char* ws = F.ws;
    const int nidle = F.G - nunits, rank = (F.bid - (shift % F.G) - nunits + 2 * F.G) % F.G;
    if (rank >= nidle) return;
    const int cap0 = (F.G - 64) * 8, cap1 = (F.G - 32) * 8, cap2 = (F.G - 88) * 8;
    const int off = slot == 0 ? 0 : slot == 1 ? cap0 : slot == 2 ? cap0 + cap1 : cap0 + cap1 + cap2;
    const int nl = WL_BASE(lcur + 2) - WL_BASE(lcur + 1);
    const int end = slot == 3 ? nl : (off + (slot == 0 ? cap0 : slot == 1 ? cap1 : cap2) < nl ? off + (slot == 0 ? cap0 : slot == 1 ? cap1 : cap2) : nl);
    LAS float* scr = (LAS float*)(F.lds + (F.wave < 3 ? 32768 + F.wave * 8448 : 98304 + (F.wave - 3) * 8448));
    for (int it = off + rank * 8 + F.wave; it < end; it += nidle * 8) { P0Item d; f32x4 wv[8]; P0_DECODE(d, WL_BASE(lcur + 1) + it); p0_item_load(d, wv, F.lane); p0_item_finish(d, wv, scr, F.lane); }
}
__device__ __forceinline__ void p0_prologue(Frame& F, const Args& A) {
    LAS float* scr = (LAS float*)(F.lds + F.wave * 16384);
    const int gw = F.bid * NWAVES + F.wave, NGW = F.G * NWAVES;
    unsigned char* ws = F.ws;
    constexpr int NITEMS = WL_BASE(1);
    { P0Item dc, dn; f32x4 wa[8], wb[8];
      if (gw < NITEMS) { P0_DECODE(dc, gw); p0_item_load(dc, wa, F.lane);
#pragma unroll 1
        for (int it = gw; it < NITEMS; it += 2 * NGW) {
            { const int itn = it + NGW < NITEMS ? it + NGW : it; P0_DECODE(dn, itn); p0_item_load(dn, wb, F.lane); }
            p0_item_finish(dc, wa, scr, F.lane);
            if (it + NGW >= NITEMS) break;
            { const int itn = it + 2 * NGW < NITEMS ? it + 2 * NGW : it + NGW; P0_DECODE(dc, itn); p0_item_load(dc, wa, F.lane); }
            p0_item_finish(dn, wb, scr, F.lane);
        } } }
#define P0_ROWPTRS(m_, xp, op, sp) do { if ((m_) < M) { xp = (const float*)A.in[0] + (size_t)(m_) * D; op = (bf16*)(ws + WS_XB) + (size_t)(m_) * D; sp = (rss_t*)(ws + WS_RSS) + (m_); } \
        else { xp = (const float*)A.in[1] + (size_t)((m_) - M) * D; op = (bf16*)(ws + WS_XSB) + (size_t)((m_) - M) * D; sp = (rss_t*)(ws + WS_RSSS) + ((m_) - M); } } while (0)
#pragma unroll 1
    for (int m = gw; m < M + SB; m += 2 * NGW) {
        const int m2 = m + NGW < M + SB ? m + NGW : m;
        const float* x0; bf16* o0; rss_t* s0; const float* x1; bf16* o1; rss_t* s1;
        P0_ROWPTRS(m, x0, o0, s0); P0_ROWPTRS(m2, x1, o1, s1);
        f32x4 v0[4], v1[4];
#pragma unroll
        for (int j = 0; j < 4; ++j) { v0[j] = *((const f32x4*)x0 + F.lane + 64 * j); v1[j] = *((const f32x4*)x1 + F.lane + 64 * j); }
        float q0 = 0.f, q1 = 0.f;
#pragma unroll
        for (int j = 0; j < 4; ++j) { q0 += (v0[j].x * v0[j].x + v0[j].y * v0[j].y) + (v0[j].z * v0[j].z + v0[j].w * v0[j].w); q1 += (v1[j].x * v1[j].x + v1[j].y * v1[j].y) + (v1[j].z * v1[j].z + v1[j].w * v1[j].w); }
        q0 = wave_sum(q0); q1 = wave_sum(q1);
#pragma unroll
        for (int j = 0; j < 4; ++j) { u32x2 w; w.x = cvt_pk_bf16(v0[j].x, v0[j].y); w.y = cvt_pk_bf16(v0[j].z, v0[j].w); *((u32x2*)o0 + F.lane + 64 * j) = w;
            u32x2 w2; w2.x = cvt_pk_bf16(v1[j].x, v1[j].y); w2.y = cvt_pk_bf16(v1[j].z, v1[j].w); *((u32x2*)o1 + F.lane + 64 * j) = w2; }
        if (F.lane == 0) { *s0 = (rss_t)(q0 * RSS_SCALE); *s1 = (rss_t)(q1 * RSS_SCALE); }
    }
#undef P0_ROWPTRS
}

template <int NG, int NSTEP, int BATCH>
__device__ __forceinline__ void sgemm_tile(Frame& F, const bf16* A, int lda, const bf16* Bt, int ldb, int n0a, int n0b, LAS float* part, LAS float* fin) {
    static_assert(NSTEP % BATCH == 0, "batches");
    constexpr int ksl = NSTEP * 16; const int r = F.lane & 31, h = F.lane >> 5;
    f32x16 acc[NG];
#pragma unroll
    for (int g = 0; g < NG; ++g)
#pragma unroll
        for (int i = 0; i < 16; ++i) acc[g][i] = 0.f;
    const bf16* ap = A + (size_t)r * lda + F.wave * ksl + 8 * h;
    const bf16* bp0 = Bt + (size_t)(n0a + r) * ldb + F.wave * ksl + 8 * h;
    const bf16* bp1 = Bt + (size_t)(n0b + r) * ldb + F.wave * ksl + 8 * h;
#pragma unroll
    for (int k0 = 0; k0 < NSTEP; k0 += BATCH) {
        bf16x8 av[BATCH], b0v[BATCH], b1v[BATCH];
#pragma unroll
        for (int k = 0; k < BATCH; ++k) { av[k] = *(const bf16x8*)(ap + 16 * (k0 + k)); b0v[k] = *(const bf16x8*)(bp0 + 16 * (k0 + k)); if (NG == 2) b1v[k] = *(const bf16x8*)(bp1 + 16 * (k0 + k)); }
#pragma unroll
        for (int k = 0; k < BATCH; ++k) { acc[0] = __builtin_amdgcn_mfma_f32_32x32x16_bf16(av[k], b0v[k], acc[0], 0, 0, 0);
            if (NG == 2) acc[NG - 1] = __builtin_amdgcn_mfma_f32_32x32x16_bf16(av[k], b1v[k], acc[NG - 1], 0, 0, 0); }
    }
#pragma unroll
    for (int g = 0; g < NG; ++g)
#pragma unroll
        for (int i = 0; i < 16; ++i) { const int row = (i & 3) + 8 * (i >> 2) + 4 * h; part[g * 16384 + (F.wave * 32 + row) * 32 + r] = acc[g][i]; }
    __syncthreads();
    for (int e = F.tid; e < NG * 1024; e += NTHR) { const int g = e >> 10, idx = e & 1023; float s = 0.f;
#pragma unroll
        for (int w = 0; w < 8; ++w) s += part[g * 16384 + w * 1024 + idx];
        fin[g * 32 * 33 + (idx >> 5) * 33 + (idx & 31)] = s; }
    __syncthreads();
}
enum { SG_RGIN = 0, SG_RESID = 1, SG_FFNIN = 2, SG_QKV = 3, SG_RESFIN = 4 };
struct SgArgs { const bf16* A; int lda; const bf16* Bt; int K; int nunits; const rss_t* rss_in; rss_t* rss_out; const float* xin; float* xout; bf16* xbout; float* fout; bf16* bout; float* sk; float* sv; unsigned* fcnt; const float* gfin; };
template <int KIND, int KDIM>
__device__ __forceinline__ void sgemm_units(Frame& F, const SgArgs& S, int shift) {
    LAS float* part = (LAS float*)(F.lds + 32768); LAS float* fin = (LAS float*)(F.lds + 131072);
    for (int su = (F.bid + F.G - (shift % F.G)) % F.G; su < S.nunits; su += F.G) {
        rss_t pre_r[2]; float pre_x[2];
#pragma unroll
        for (int k = 0; k < 2; ++k) { const int e = F.tid + NTHR * k, m = e >> 5, n = e & 31; pre_r[k] = (KIND != SG_RESID && KIND != SG_RESFIN) ? S.rss_in[m] : (rss_t)0; pre_x[k] = (KIND == SG_RESID || KIND == SG_RESFIN) ? S.xin[m * 1024 + 32 * su + n] : 0.f; }
        if (KIND == SG_FFNIN) { const int n0 = 256 * (su >> 2) + 32 * (su & 3); sgemm_tile<2, 8, 8>(F, S.A, S.lda, S.Bt, KDIM, n0, n0 + 128, part, fin); }
        else sgemm_tile<1, KDIM / 128, (KDIM == 1024 ? 8 : 11)>(F, S.A, S.lda, S.Bt, KDIM, 32 * su, 32 * su, part, fin);
#pragma unroll
        for (int k = 0; k < 2; ++k) { const int e = F.tid + NTHR * k, m = e >> 5, n = e & 31; const float v = fin[m * 33 + n];
            const float rs = __builtin_amdgcn_rsqf((float)pre_r[k] * RSS_INV + EPS);
            if (KIND == SG_RGIN) { S.fout[m * 2048 + 32 * su + n] = v * rs; }
            if (KIND == SG_RESID) { const int c = 32 * su + n; const float x = pre_x[k] + v; S.xout[m * 1024 + c] = x; S.xbout[m * 1024 + c] = f2bf1(x);
                float ss = x * x;
#pragma unroll
                for (int o = 1; o < 32; o <<= 1) ss += __shfl_xor(ss, o);
                if (n == 0) atomicAdd(S.rss_out + m, (rss_t)(ss * RSS_SCALE)); }
            if (KIND == SG_RESFIN) { const int c = 32 * su + n; const float x = pre_x[k] + v; pre_x[k] = x;
                float ss = x * x;
#pragma unroll
                for (int o = 1; o < 32; o <<= 1) ss += __shfl_xor(ss, o);
                if (n == 0) atomicAdd(S.rss_out + m, (rss_t)(ss * RSS_SCALE)); (void)c; }
            if (KIND == SG_FFNIN) { const float g = v * rs, u = fin[32 * 33 + m * 33 + n] * rs; S.bout[m * FF + 32 * su + n] = f2bf1(silu_(g) * u); }
            if (KIND == SG_QKV) { const int c = 32 * su + n; float x = v * rs;
                if (c < 1536 && (su & 3) == 0) {
                    const int d = n & 15; float rev = 8192.0f * fast_exp2(-(float)d * (18.931568569324174f / 16.0f)) * 0.15915494309189535f; rev = rev - floorf(rev);
                    const float co = __builtin_amdgcn_cosf(rev), si = __builtin_amdgcn_sinf(rev); const float other = fin[m * 33 + (n ^ 16)] * rs;
                    x = n < 16 ? x * co - other * si : x * co + other * si; }
                if (c < 1024) S.fout[m * 1024 + c] = x * pg8::QSCALE; else if (c < 1536) S.sk[m * 512 + (c - 1024)] = x; else S.sv[m * 512 + (c - 1536)] = x; }
        }
        if (KIND == SG_RESFIN) {
            asm volatile("s_waitcnt vmcnt(0)" ::: "memory"); __syncthreads();
            if (F.tid == 0) { __hip_atomic_fetch_add(S.fcnt, 1u, __ATOMIC_RELAXED, __HIP_MEMORY_SCOPE_AGENT);
                for (unsigned sp = 0; sp < (1u << 22); ++sp) { if (__hip_atomic_load(S.fcnt, __ATOMIC_RELAXED, __HIP_MEMORY_SCOPE_AGENT) >= (unsigned)S.nunits) break; __builtin_amdgcn_s_sleep(2); } }
            __syncthreads();
#pragma unroll
            for (int k = 0; k < 2; ++k) { const int e = F.tid + NTHR * k, m = e >> 5, n = e & 31, c = 32 * su + n;
                const float rs = __builtin_amdgcn_rsqf((float)__hip_atomic_load(S.rss_out + m, __ATOMIC_RELAXED, __HIP_MEMORY_SCOPE_AGENT) * RSS_INV + EPS);
                S.fout[m * 1024 + c] = pre_x[k] * rs * S.gfin[c]; }
        }
        __syncthreads();
    }
}

__device__ __forceinline__ bf16x8 ld_bf16x8_g(const bf16* p) { return *(const bf16x8*)p; }
__device__ __forceinline__ f32x4 mfma16(const bf16x8 a, const bf16x8 b, const f32x4 c) { return __builtin_amdgcn_mfma_f32_16x16x32_bf16(a, b, c, 0, 0, 0); }
__device__ __forceinline__ float one_minus_exp(float x) {
    if (x > -0.3f) { const float p = x * (1.0f + x * (0.5f + x * (1.0f / 6.0f + x * (1.0f / 24.0f + x * (1.0f / 120.0f + x * (1.0f / 720.0f + x * (1.0f / 5040.0f))))))); return -p; }
    return 1.0f - fast_exp2(1.44269504089f * x);
}
__device__ __forceinline__ float softplus_neg(float lam) { return (lam > 15.f) ? __expf(-lam) : ((lam < -15.f) ? -lam : __logf(1.0f + __expf(-lam))); }
__device__ __forceinline__ void lru_ab(float ga, float gi, float nba, float nbi, float cch2, float uc, float& a, float& bb) {
    const float r = fast_rcp(1.0f + fast_exp2(fmaf(ga, -1.44269504089f, nba))), ig = fast_rcp(1.0f + fast_exp2(fmaf(gi, -1.44269504089f, nbi)));
    a = fast_exp2(cch2 * r); bb = __builtin_amdgcn_sqrtf(fmaxf(fmaf(-a, a, 1.0f), 0.f)) * (ig * uc);
}
typedef float f32x2s __attribute__((ext_vector_type(2)));
__device__ __forceinline__ void lru_ab2(f32x2s ga, f32x2s gi, float nba, float nbi, float cch2, f32x2s uc, f32x2s& a, f32x2s& bb) {
    const f32x2s k = (f32x2s){-1.44269504089f, -1.44269504089f}, one = (f32x2s){1.0f, 1.0f};
    const f32x2s za = ga * k + (f32x2s){nba, nba}, zi = gi * k + (f32x2s){nbi, nbi};
    const f32x2s da = (f32x2s){fast_exp2(za.x), fast_exp2(za.y)} + one, di = (f32x2s){fast_exp2(zi.x), fast_exp2(zi.y)} + one;
    const f32x2s r = (f32x2s){fast_rcp(da.x), fast_rcp(da.y)}, ig = (f32x2s){fast_rcp(di.x), fast_rcp(di.y)};
    const f32x2s ex = r * (f32x2s){cch2, cch2};
    a = (f32x2s){fast_exp2(ex.x), fast_exp2(ex.y)};
    const f32x2s t = one - a * a;
    float t0, t1; asm("v_max_f32 %0, %1, 0" : "=v"(t0) : "v"(t.x)); asm("v_max_f32 %0, %1, 0" : "=v"(t1) : "v"(t.y));
    bb = (f32x2s){__builtin_amdgcn_sqrtf(t0), __builtin_amdgcn_sqrtf(t1)} * (ig * uc);
}
constexpr int SC_RAWU = 0, SC_RAWG = 17408, SC_AT = 33792, SC_UCF = 51200, SC_KRED = 90112, SC_CW = 98304, SC_OUT = 102400, SC_AT_PITCH = 272, SC_UCF_PITCH = 132;
#define SC_BARRIER() do { asm volatile("s_waitcnt lgkmcnt(0)" ::: "memory"); __builtin_amdgcn_s_barrier(); asm volatile("" ::: "memory"); } while (0)
template <int PASS>
__device__ __forceinline__ void scan_phase(Frame& F, const Args& A, int l) {
    unsigned char* ws = F.ws;
    const bf16* U = (const bf16*)(ws + WS_U); const bf16* GT = (const bf16*)(ws + WS_GATE); bf16* HG = (bf16*)(ws + WS_HG);
    typedef __attribute__((address_space(1))) unsigned long long gu64_t;
    gu64_t* SUMG = (gu64_t*)(ws + WS_SUMG) + (size_t)l * 256 * 256; const unsigned epoch = (unsigned)l + 1u;
    const int lane = F.lane, fr = lane & 15, fq = lane >> 4, w = F.wave, tid = F.tid;
    LAS unsigned char* lds = F.lds;
    for (int unit = F.bid; unit < 256; unit += F.G) {
        const int b = unit >> 7, cb = (unit >> 4) & 7, c = unit & 15, ch0 = cb * 128, chl = 16 * w + fr, ch = ch0 + chl;
        const float ba = ((const float*)A.in[13])[l * 1024 + ch], bi = ((const float*)A.in[15])[l * 1024 + ch];
        const float lam = ((const float*)A.in[16])[l * 1024 + ch];
        const float sp = softplus_neg(lam);
        const float cch2 = -8.0f * sp * 1.44269504089f, nba = -1.44269504089f * ba, nbi = -1.44269504089f * bi;
        bf16x8 Ba[4], Bi[4];
        { const bf16* wg = (const bf16*)(ws + WS_WG) + ((size_t)(l * 8 + cb) * 256 + chl) * 128 + 8 * fq;
#pragma unroll
          for (int ks = 0; ks < 4; ++ks) { Ba[ks] = ld_bf16x8_g(wg + 32 * ks); Bi[ks] = ld_bf16x8_g(wg + 128 * 128 + 32 * ks); } }
        const int cg = tid & 15;
        float hin = 0.f, Arun = 1.f, Brun = 0.f;
        const int tc0 = c * 512;
        const int ku = ((l * 2 + (PASS - 1)) * 256 + unit) & 1023, kb_ = ku >> 5, kj_ = ku & 31;
        const GAS float* ckp[2];
#pragma unroll
        for (int pg = 0; pg < 2; ++pg) ckp[pg] = (const GAS float*)A.in[2] + (size_t)((const int*)A.in[6])[kb_ * NPG + 2 * kj_ + pg] * PAGE * KVD + (size_t)(tid >> 7) * KVD + 4 * (tid & 127);
        f32x4 kreg[8], ksum = (f32x4){0.f, 0.f, 0.f, 0.f};
#define SC_KLOAD(st_) do { const GAS float* kp_ = ckp[(st_) >> 2] + (size_t)(32 * ((st_) & 3)) * KVD; _Pragma("unroll") for (int k = 0; k < 8; ++k) kreg[k] = *(const GAS f32x4*)(kp_ + (size_t)(4 * k) * KVD); } while (0)
#define SC_KACC() do { _Pragma("unroll") for (int k = 0; k < 8; ++k) ksum += kreg[k]; } while (0)
        v4u pu[3], pgt[2];
#define SC_PREFETCH(st_) do { const int t0_ = tc0 + (st_) * 64; \
            _Pragma("unroll") for (int k = 0; k < 3; ++k) { const int p = tid + 512 * k, pc = p < 67 * 16 ? p : 67 * 16 - 1;     \
                const int t = t0_ - 3 + (pc >> 4); pu[k] = *(const v4u*)(U + ((size_t)(b * T + (t > 0 ? t : 0))) * 1024 + ch0 + 8 * (pc & 15));     \
                if (t0_ == 0) { if (t < 0) pu[k] = (v4u){0u, 0u, 0u, 0u}; } }     \
            if (PASS == 2) { _Pragma("unroll") for (int k = 0; k < 2; ++k) { const int p = tid + 512 * k; pgt[k] = *(const v4u*)(GT + ((size_t)(b * T + t0_ + (p >> 4))) * 1024 + ch0 + 8 * (p & 15)); } } } while (0)
#define SC_STORE_OUT(tbase_) do { _Pragma("unroll") for (int k = 0; k < 2; ++k) { const int p = tid + 512 * k; const v4u ov = *(const LAS v4u*)(lds + SC_OUT + p * 16); \
            *(v4u*)(HG + ((size_t)(b * T + (tbase_) + (p >> 4))) * 1024 + ch0 + 8 * (p & 15)) = ov; } } while (0)
        float cwv[5] = {0.f, 0.f, 0.f, 0.f, 0.f};
        if (tid < 128) {
#pragma unroll
            for (int q = 0; q < 4; ++q) cwv[q] = ((const float*)A.in[10])[(l * 4 + q) * 1024 + ch0 + tid];
            cwv[4] = ((const float*)A.in[11])[l * 1024 + ch0 + tid]; }
        SC_PREFETCH(0); SC_KLOAD(0);
        if (PASS == 2 && c > 0) {
            unsigned long long ga[15], gb[15]; gu64_t* g0 = SUMG + (size_t)((b * 8 + cb) * 16) * 256 + chl;
            for (unsigned sp = 0; sp < (1u << 20); ++sp) { bool ok = true;
#pragma unroll
                for (int j = 0; j < 15; ++j) { gu64_t* g = g0 + (size_t)(j < c ? j : 0) * 256; ga[j] = __hip_atomic_load(g, __ATOMIC_RELAXED, __HIP_MEMORY_SCOPE_AGENT); gb[j] = __hip_atomic_load(g + 128, __ATOMIC_RELAXED, __HIP_MEMORY_SCOPE_AGENT); }
#pragma unroll
                for (int j = 0; j < 15; ++j) ok = ok && (j >= c || ((unsigned)(ga[j] >> 32) == epoch && (unsigned)(gb[j] >> 32) == epoch));
                if (__all(ok)) break; __builtin_amdgcn_s_sleep(2); }
#pragma unroll
            for (int j = 0; j < 15; ++j) if (j < c) hin = __uint_as_float((unsigned)ga[j]) * hin + __uint_as_float((unsigned)gb[j]); }
        __syncthreads();
        if (tid < 128) { LAS float* cwl = (LAS float*)(lds + SC_CW);
#pragma unroll
            for (int q = 0; q < 5; ++q) cwl[q * 128 + tid] = cwv[q]; }
        __syncthreads();
        for (int st = 0; st < 8; ++st) {
            const int t0 = tc0 + st * 64;
            SC_BARRIER();
            if (PASS == 2 && st > 0) { SC_STORE_OUT(t0 - 64); }
#pragma unroll
            for (int k = 0; k < 3; ++k) { const int p = tid + 512 * k; if (p < 67 * 16) *(LAS v4u*)(lds + SC_RAWU + p * 16) = pu[k]; }
            if (PASS == 2) {
#pragma unroll
                for (int k = 0; k < 2; ++k) { const int p = tid + 512 * k, t = p >> 4; *(LAS v4u*)(lds + SC_RAWG + ((16 * ((t >> 2) & 3) + 4 * (t >> 4) + (t & 3)) * 16 + (p & 15)) * 16) = pgt[k]; } }
            SC_BARRIER();
            { const int stn = st + 1 < 8 ? st + 1 : 7; SC_PREFETCH(stn); SC_KACC(); SC_KLOAD(stn); }
#pragma unroll 1
            for (int k = 0; k < 2; ++k) { const int t = (tid >> 4) + 32 * k; float uc[8];
                f32x2s u2[4];
                { const LAS f32x4* cb4 = (const LAS f32x4*)(lds + SC_CW + (4 * 128 + 8 * cg) * 4); const f32x4 b0 = cb4[0], b1 = cb4[1];
                  u2[0] = (f32x2s){b0[0], b0[1]}; u2[1] = (f32x2s){b0[2], b0[3]}; u2[2] = (f32x2s){b1[0], b1[1]}; u2[3] = (f32x2s){b1[2], b1[3]}; }
#pragma unroll
                for (int q = 0; q < 4; ++q) { const v4u rw = *(const LAS v4u*)(lds + SC_RAWU + ((t + q) * 16 + cg) * 16);
                    const LAS f32x4* cw4 = (const LAS f32x4*)(lds + SC_CW + (q * 128 + 8 * cg) * 4); const f32x4 w0 = cw4[0], w1 = cw4[1];
                    u2[0] += (f32x2s){w0[0], w0[1]} * (f32x2s){bflo(rw.x), bfhi(rw.x)}; u2[1] += (f32x2s){w0[2], w0[3]} * (f32x2s){bflo(rw.y), bfhi(rw.y)};
                    u2[2] += (f32x2s){w1[0], w1[1]} * (f32x2s){bflo(rw.z), bfhi(rw.z)}; u2[3] += (f32x2s){w1[2], w1[3]} * (f32x2s){bflo(rw.w), bfhi(rw.w)}; }
                uc[0] = u2[0].x; uc[1] = u2[0].y; uc[2] = u2[1].x; uc[3] = u2[1].y; uc[4] = u2[2].x; uc[5] = u2[2].y; uc[6] = u2[3].x; uc[7] = u2[3].y;
                v4u o; o.x = cvt_pk_bf16(uc[0], uc[1]); o.y = cvt_pk_bf16(uc[2], uc[3]); o.z = cvt_pk_bf16(uc[4], uc[5]); o.w = cvt_pk_bf16(uc[6], uc[7]);
                const int tr = 16 * ((t >> 2) & 3) + 4 * (t >> 4) + (t & 3);
                *(LAS v4u*)(lds + SC_AT + tr * SC_AT_PITCH + cg * 16) = o;
                LAS float* uf = (LAS float*)(lds + SC_UCF) + tr * SC_UCF_PITCH + 8 * cg;
                *(LAS f32x4*)uf = (f32x4){uc[0], uc[1], uc[2], uc[3]}; *(LAS f32x4*)(uf + 4) = (f32x4){uc[4], uc[5], uc[6], uc[7]}; }
            SC_BARRIER();
            float av[16], bv[16];
#pragma unroll
            for (int s = 0; s < 4; ++s) {
                f32x4 aa = (f32x4){0.f, 0.f, 0.f, 0.f}, ai = (f32x4){0.f, 0.f, 0.f, 0.f};
#pragma unroll
                for (int ks = 0; ks < 4; ++ks) { const bf16x8 af = *(const LAS bf16x8*)(lds + SC_AT + (16 * s + fr) * SC_AT_PITCH + ks * 64 + fq * 16); aa = mfma16(af, Ba[ks], aa); ai = mfma16(af, Bi[ks], ai); }
#pragma unroll
                for (int i = 0; i < 4; i += 2) { const LAS float* up = (const LAS float*)(lds + SC_UCF) + (16 * s + 4 * fq + i) * SC_UCF_PITCH + chl; const f32x2s ucv = (f32x2s){up[0], up[SC_UCF_PITCH]};
                    f32x2s a2, b2; lru_ab2((f32x2s){aa[i], aa[i + 1]}, (f32x2s){ai[i], ai[i + 1]}, nba, nbi, cch2, ucv, a2, b2);
                    av[4 * s + i] = a2.x; av[4 * s + i + 1] = a2.y; bv[4 * s + i] = b2.x; bv[4 * s + i + 1] = b2.y; }
            }
            float Ac = 1.f, Bc = 0.f;
#pragma unroll
            for (int i = 0; i < 16; ++i) { Bc = av[i] * Bc + bv[i]; Ac = av[i] * Ac; }
            { const float Ap = __shfl_up(Ac, 16), Bp = __shfl_up(Bc, 16); if (fq >= 1) { Bc = Ac * Bp + Bc; Ac = Ac * Ap; } }
            { const float Ap = __shfl_up(Ac, 32), Bp = __shfl_up(Bc, 32); if (fq >= 2) { Bc = Ac * Bp + Bc; Ac = Ac * Ap; } }
            const float Atot = __shfl(Ac, 48 + fr), Btot = __shfl(Bc, 48 + fr);
            if (PASS == 1) { Brun = Atot * Brun + Btot; Arun = Atot * Arun; }
            else {
                float Ae = __shfl_up(Ac, 16), Be = __shfl_up(Bc, 16); if (fq == 0) { Ae = 1.f; Be = 0.f; }
                float h = Ae * hin + Be;
#pragma unroll
                for (int i = 0; i < 16; i += 2) { const int tl = 16 * fq + i;
                    const float h0 = av[i] * h + bv[i]; h = av[i + 1] * h0 + bv[i + 1];
                    const float g0 = bf2f(((const LAS unsigned short*)(lds + SC_RAWG))[(16 * (i >> 2) + 4 * fq + (i & 3)) * 128 + chl]);
                    const float g1 = bf2f(((const LAS unsigned short*)(lds + SC_RAWG))[(16 * (i >> 2) + 4 * fq + ((i + 1) & 3)) * 128 + chl]);
                    const f32x2s hg = (f32x2s){h0, h} * (f32x2s){g0, g1}; const unsigned w = cvt_pk_bf16(hg.x, hg.y);
                    ((LAS unsigned short*)(lds + SC_OUT))[tl * 128 + chl] = (unsigned short)w; ((LAS unsigned short*)(lds + SC_OUT))[(tl + 1) * 128 + chl] = (unsigned short)(w >> 16);
                    if (c == 15 && st == 7 && fq == 3 && i == 14) F.out[O_PH + (size_t)(l * 2 + b) * 1024 + ch] = h; }
                hin = Atot * hin + Btot;
            }
        }
        if (PASS == 2) { SC_BARRIER(); SC_STORE_OUT(tc0 + 448); }
        if (PASS == 1 && fq == 0) { gu64_t* g = SUMG + (size_t)((b * 8 + cb) * 16 + c) * 256 + chl;
            __hip_atomic_store(g, ((unsigned long long)epoch << 32) | __float_as_uint(Arun), __ATOMIC_RELAXED, __HIP_MEMORY_SCOPE_AGENT);
            __hip_atomic_store(g + 128, ((unsigned long long)epoch << 32) | __float_as_uint(Brun), __ATOMIC_RELAXED, __HIP_MEMORY_SCOPE_AGENT); }
        { LAS f32x4* red = (LAS f32x4*)(lds + SC_KRED); red[(tid >> 7) * 128 + (tid & 127)] = ksum; __syncthreads();
          if (tid < 128) { const f32x4 t = (red[tid] + red[128 + tid]) + (red[256 + tid] + red[384 + tid]); *((f32x4*)((float*)(ws + WS_KMC) + (size_t)ku * 512) + tid) = t * (1.0f / 256.0f); } }
        __syncthreads();
    }
}
__device__ __forceinline__ void srg_step(Frame& F, const Args& A, int l) {
    unsigned char* ws = F.ws; LAS unsigned char* lds = F.lds;
    const float* PROJ = (const float*)(ws + WS_PROJS); bf16* HGS = (bf16*)(ws + WS_HGS);
    const int lane = F.lane, fr = lane & 15, fq = lane >> 4, w = F.wave, tid = F.tid;
    for (int cb = F.bid; cb < 8; cb += F.G) {
        const int ch0 = cb * 128, chl = 16 * w + fr, ch = ch0 + chl;
        __syncthreads();
        { const int b = tid >> 4, cg = tid & 15; const int c0 = ch0 + 8 * cg;
          const float* sc = (const float*)A.in[4] + (size_t)((l * SB + b) * 3) * 1024 + c0;
          float* sco = F.out + O_SCONV + (size_t)((l * SB + b) * 3) * 1024 + c0;
          const float* cwp = (const float*)A.in[10] + (size_t)l * 4 * 1024 + c0;
          f32x4 sv[3][2], un[2], wv[4][2], bv[2];
#pragma unroll
          for (int q = 0; q < 3; ++q) { sv[q][0] = *(const f32x4*)(sc + q * 1024); sv[q][1] = *(const f32x4*)(sc + q * 1024 + 4); }
          un[0] = *(const f32x4*)(PROJ + b * 2048 + 1024 + c0); un[1] = *(const f32x4*)(PROJ + b * 2048 + 1024 + c0 + 4);
#pragma unroll
          for (int q = 0; q < 4; ++q) { wv[q][0] = *(const f32x4*)(cwp + q * 1024); wv[q][1] = *(const f32x4*)(cwp + q * 1024 + 4); }
          bv[0] = *(const f32x4*)((const float*)A.in[11] + l * 1024 + c0); bv[1] = *(const f32x4*)((const float*)A.in[11] + l * 1024 + c0 + 4);
          f32x4 u0 = bv[0] + wv[0][0] * sv[0][0] + wv[1][0] * sv[1][0] + wv[2][0] * sv[2][0] + wv[3][0] * un[0];
          f32x4 u1 = bv[1] + wv[0][1] * sv[0][1] + wv[1][1] * sv[1][1] + wv[2][1] * sv[2][1] + wv[3][1] * un[1];
          *(f32x4*)sco = sv[1][0]; *(f32x4*)(sco + 4) = sv[1][1]; *(f32x4*)(sco + 1024) = sv[2][0]; *(f32x4*)(sco + 1024 + 4) = sv[2][1]; *(f32x4*)(sco + 2048) = un[0]; *(f32x4*)(sco + 2048 + 4) = un[1];
          v4u o; o.x = cvt_pk_bf16(u0[0], u0[1]); o.y = cvt_pk_bf16(u0[2], u0[3]); o.z = cvt_pk_bf16(u1[0], u1[1]); o.w = cvt_pk_bf16(u1[2], u1[3]);
          *(LAS v4u*)(lds + SC_AT + b * SC_AT_PITCH + cg * 16) = o;
          LAS float* uf = (LAS float*)(lds + SC_UCF) + b * SC_UCF_PITCH + 8 * cg;
          *(LAS f32x4*)uf = u0; *(LAS f32x4*)(uf + 4) = u1; }
        __syncthreads();
        const float ba = ((const float*)A.in[13])[l * 1024 + ch], bi = ((const float*)A.in[15])[l * 1024 + ch];
        const float lam = ((const float*)A.in[16])[l * 1024 + ch];
        const float sp = softplus_neg(lam); const float cch = -8.0f * sp;
        const bf16* wg = (const bf16*)(ws + WS_WG) + ((size_t)(l * 8 + cb) * 256 + chl) * 128 + 8 * fq;
        bf16x8 Ba[4], Bi[4]; float h0v[2][4], gtv[2][4];
#pragma unroll
        for (int ks = 0; ks < 4; ++ks) { Ba[ks] = ld_bf16x8_g(wg + 32 * ks); Bi[ks] = ld_bf16x8_g(wg + 128 * 128 + 32 * ks); }
#pragma unroll
        for (int s = 0; s < 2; ++s)
#pragma unroll
            for (int i = 0; i < 4; ++i) { const int b = 16 * s + 4 * fq + i; h0v[s][i] = ((const float*)A.in[5])[(size_t)(l * SB + b) * 1024 + ch]; gtv[s][i] = PROJ[b * 2048 + ch]; }
#pragma unroll
        for (int s = 0; s < 2; ++s) {
            f32x4 aa = (f32x4){0.f, 0.f, 0.f, 0.f}, ai = (f32x4){0.f, 0.f, 0.f, 0.f};
#pragma unroll
            for (int ks = 0; ks < 4; ++ks) { const bf16x8 af = *(const LAS bf16x8*)(lds + SC_AT + (16 * s + fr) * SC_AT_PITCH + ks * 64 + fq * 16); aa = mfma16(af, Ba[ks], aa); ai = mfma16(af, Bi[ks], ai); }
#pragma unroll
            for (int i = 0; i < 4; ++i) { const int b = 16 * s + 4 * fq + i; const float ucv = ((const LAS float*)(lds + SC_UCF))[b * SC_UCF_PITCH + chl]; float a, bb; lru_ab(aa[i], ai[i], -1.44269504089f * ba, -1.44269504089f * bi, 1.44269504089f * cch, ucv, a, bb);
                const float h = a * h0v[s][i] + bb;
                F.out[O_SH + (size_t)(l * SB + b) * 1024 + ch] = h;
                HGS[b * 1024 + ch] = f2bf1(h * gelu_tanh(gtv[s][i])); }
        }
    }
}

constexpr int AT_K = 0, AT_KP = 256, AT_V = 65536, AT_VP = 544, AT_MISC = 135168;
__device__ __forceinline__ void sel_phase(Frame& F, int a, bool dry) {
    unsigned char* ws = F.ws; LAS unsigned char* lds = F.lds;
    const bf16* Q = (const bf16*)(ws + WS_Q); const float* KM = (const float*)(ws + WS_KM);
    unsigned* CNT = (unsigned*)(ws + WS_CNT) + a * 256 + (dry ? 1024 : 0); unsigned* LIST = (unsigned*)(ws + (dry ? WS_END : WS_LIST));
    LAS unsigned* cnt = (LAS unsigned*)(lds + AT_MISC); LAS unsigned* base = cnt + 32;
    const int lane = F.lane, r32 = lane & 31, hh5 = lane >> 5, tid = F.tid;
    for (int u = F.bid; u < 248; u += F.G) {
        const int bg = u / 31, qt = u % 31 + 1, b = bg >> 2, g = bg & 3;
        __syncthreads();
        if (tid < 32) cnt[tid] = 0u;
        __syncthreads();
        bf16x8 kmh[8], kml[8];
        { const float* kp = KM + (size_t)(b * 32 + r32) * 512 + g * 128 + 8 * hh5; f32x4 kx[8][2];
#pragma unroll
          for (int ks = 0; ks < 8; ++ks) { kx[ks][0] = *(const f32x4*)(kp + 16 * ks); kx[ks][1] = *(const f32x4*)(kp + 16 * ks + 4); }
#pragma unroll
          for (int ks = 0; ks < 8; ++ks) { const f32x4 x0 = kx[ks][0], x1 = kx[ks][1]; float x[8] = {x0[0], x0[1], x0[2], x0[3], x1[0], x1[1], x1[2], x1[3]};
              unsigned hw[4], lw[4];
#pragma unroll
              for (int j = 0; j < 4; ++j) { hw[j] = cvt_pk_bf16(x[2 * j], x[2 * j + 1]); lw[j] = cvt_pk_bf16(x[2 * j] - bflo(hw[j]), x[2 * j + 1] - bfhi(hw[j])); }
              v4u hv = (v4u){hw[0], hw[1], hw[2], hw[3]}, lv = (v4u){lw[0], lw[1], lw[2], lw[3]};
              kmh[ks] = __builtin_bit_cast(bf16x8, hv); kml[ks] = __builtin_bit_cast(bf16x8, lv); } }
        int selj[2][3]; unsigned rank[2][3];
        const int nsel = qt < 3 ? qt : 3;
        bf16x8 qf8[2][8];
#pragma unroll
        for (int tk = 0; tk < 2; ++tk) { const int task = F.wave + 8 * tk, hh = task >> 3, s32 = task & 7, h = 2 * g + hh;
            const bf16* qp = Q + ((size_t)(b * T + 256 * qt + 32 * s32 + r32)) * 1024 + h * 128 + 8 * hh5;
#pragma unroll
            for (int ks = 0; ks < 8; ++ks) qf8[tk][ks] = ld_bf16x8_g(qp + 16 * ks); }
        __builtin_amdgcn_sched_barrier(0);
#pragma unroll
        for (int tk = 0; tk < 2; ++tk) {
            const int task = F.wave + 8 * tk, hh = task >> 3, s32 = task & 7;
            f32x16 acc;
#pragma unroll
            for (int i = 0; i < 16; ++i) acc[i] = 0.f;
#pragma unroll
            for (int ks = 0; ks < 8; ++ks) { acc = __builtin_amdgcn_mfma_f32_32x32x16_bf16(kmh[ks], qf8[tk][ks], acc, 0, 0, 0); acc = __builtin_amdgcn_mfma_f32_32x32x16_bf16(kml[ks], qf8[tk][ks], acc, 0, 0, 0); }
            float sc[16];
#pragma unroll
            for (int i = 0; i < 16; ++i) { const int blk = (i & 3) + 8 * (i >> 2) + 4 * hh5; sc[i] = blk < qt ? acc[i] : -3.0e38f; }
#pragma unroll
            for (int rd = 0; rd < 3; ++rd) {
                float bv = -3.4e38f; int bi = 64;
#pragma unroll
                for (int i = 0; i < 16; ++i) { const int blk = (i & 3) + 8 * (i >> 2) + 4 * hh5; if (sc[i] > bv) { bv = sc[i]; bi = blk; } }
                const float ov = __shfl_xor(bv, 32); const int oi = __shfl_xor(bi, 32);
                if (ov > bv || (ov == bv && oi < bi)) { bv = ov; bi = oi; }
                selj[tk][rd] = bi;
#pragma unroll
                for (int i = 0; i < 16; ++i) { const int blk = (i & 3) + 8 * (i >> 2) + 4 * hh5; if (blk == bi) sc[i] = -3.4e38f; }
            }
            if (lane < 32) {
#pragma unroll
                for (int sl = 0; sl < 3; ++sl) if (sl < nsel) rank[tk][sl] = atomicAdd((unsigned*)(cnt + selj[tk][sl]), 1u);
            }
        }
        __syncthreads();
        if (tid < 32) { const unsigned n = cnt[tid]; base[tid] = n ? atomicAdd(CNT + (b * 4 + g) * 32 + tid, n) : 0u; }
        __syncthreads();
        if (lane < 32) {
#pragma unroll
            for (int tk = 0; tk < 2; ++tk) { const int task = F.wave + 8 * tk, hh = task >> 3, s32 = task & 7; const unsigned t = (unsigned)(256 * qt + 32 * s32 + r32);
#pragma unroll
                for (int sl = 0; sl < 3; ++sl) if (sl < nsel) { const int j = selj[tk][sl]; LIST[((size_t)((b * 4 + g) * 32 + j)) * 16384 + base[j] + rank[tk][sl]] = t | ((unsigned)hh << 13) | ((unsigned)sl << 14); } }
        }
    }
}
__device__ __forceinline__ void load_kv_block(Frame& F, int b, int g, int j) {
    const bf16* KB = (const bf16*)(F.ws + WS_KB) + ((size_t)(b * T + 256 * j)) * 512 + g * 128;
    const bf16* VT = (const bf16*)(F.ws + WS_VT) + ((size_t)(b * 4 + g) * 128) * 8192 + 256 * j;
    v4u kr[8], vr[8];
#pragma unroll
    for (int k = 0; k < 8; ++k) { const int p = F.tid + 512 * k; kr[k] = *(const v4u*)(KB + (size_t)(p >> 4) * 512 + 8 * (p & 15)); }
#pragma unroll
    for (int k = 0; k < 8; ++k) { const int p = F.tid + 512 * k; vr[k] = *(const v4u*)(VT + (size_t)(p >> 5) * 8192 + 8 * (p & 31)); }
#pragma unroll
    for (int k = 0; k < 8; ++k) { const int p = F.tid + 512 * k, key = p >> 4; *(LAS v4u*)(F.lds + AT_K + key * AT_KP + (((p & 15) ^ ((key & 3) + 4 * ((key >> 3) & 3))) * 16)) = kr[k]; }
#pragma unroll
    for (int k = 0; k < 8; ++k) { const int p = F.tid + 512 * k; *(LAS v4u*)(F.lds + AT_V + (p >> 5) * AT_VP + (p & 31) * 16) = vr[k]; }
}
__device__ __forceinline__ void kv_block_fetch(Frame& F, int b, int g, int j, v4u (&kr)[8], v4u (&vr)[8]) {
    const bf16* KB = (const bf16*)(F.ws + WS_KB) + ((size_t)(b * T + 256 * j)) * 512 + g * 128;
    const bf16* VT = (const bf16*)(F.ws + WS_VT) + ((size_t)(b * 4 + g) * 128) * 8192 + 256 * j;
#pragma unroll
    for (int k = 0; k < 8; ++k) { const int p = F.tid + 512 * k; kr[k] = *(const v4u*)(KB + (size_t)(p >> 4) * 512 + 8 * (p & 15)); }
#pragma unroll
    for (int k = 0; k < 8; ++k) { const int p = F.tid + 512 * k; vr[k] = *(const v4u*)(VT + (size_t)(p >> 5) * 8192 + 8 * (p & 31)); }
}
__device__ __forceinline__ void kv_block_store(Frame& F, const v4u (&kr)[8], const v4u (&vr)[8]) {
#pragma unroll
    for (int k = 0; k < 8; ++k) { const int p = F.tid + 512 * k, key = p >> 4; *(LAS v4u*)(F.lds + AT_K + key * AT_KP + (((p & 15) ^ ((key & 3) + 4 * ((key >> 3) & 3))) * 16)) = kr[k]; }
#pragma unroll
    for (int k = 0; k < 8; ++k) { const int p = F.tid + 512 * k; *(LAS v4u*)(F.lds + AT_V + (p >> 5) * AT_VP + (p & 31) * 16) = vr[k]; }
}
#define AT_SCHED __builtin_amdgcn_sched_barrier(0)
typedef float f32x2_t __attribute__((ext_vector_type(2)));
__device__ __forceinline__ float vmax3(float a, float b, float c_) { float r; asm("v_max3_f32 %0, %1, %2, %3" : "=v"(r) : "v"(a), "v"(b), "v"(c_)); return r; }
__device__ __forceinline__ f32x2_t vpk_sub(f32x2_t a, f32x2_t b) { f32x2_t r; asm("v_pk_add_f32 %0, %1, %2 neg_lo:[0,1] neg_hi:[0,1]" : "=v"(r) : "v"(a), "v"(b)); return r; }
__device__ __forceinline__ float vmax2(float a, float b) { float r; asm("v_max_f32 %0, %1, %2" : "=v"(r) : "v"(a), "v"(b)); return r; }
template <bool CAUSAL, bool DB = true>
__device__ __forceinline__ void attn_scores(LAS const unsigned char* lds, const bf16x8 (&qf)[4], int qidx, int fr, int fq, float mfloor, float& m_out, float& l_out, bf16x8 (&pf)[8], bf16x8 (&fb)[2][8]) {
    f32x4 s[16];
    LAS const unsigned char* kb4[4];
#pragma unroll
    for (int ks = 0; ks < 4; ++ks) kb4[ks] = lds + AT_K + (8 * (fr >> 2) + (fr & 3)) * AT_KP + (((4 * ks + fq) ^ fr) * 16);
#define AT_LOADK(buf, p) do { _Pragma("unroll") for (int odd = 0; odd < 2; ++odd) _Pragma("unroll") for (int ks = 0; ks < 4; ++ks) \
        fb[buf][odd * 4 + ks] = *(const LAS bf16x8*)(kb4[ks] + (32 * (p) + 4 * odd) * AT_KP); } while (0)
    AT_LOADK(0, 0);
#pragma unroll
    for (int p = 0; p < 8; ++p) {
        if (DB && p + 1 < 8) AT_LOADK((p + 1) & 1, p + 1);
        AT_SCHED;
#pragma unroll
        for (int odd = 0; odd < 2; ++odd) { f32x4 acc = (f32x4){0.f, 0.f, 0.f, 0.f};
#pragma unroll
            for (int ks = 0; ks < 4; ++ks) acc = mfma16(fb[DB ? (p & 1) : 0][odd * 4 + ks], qf[ks], acc);
            if (CAUSAL) {
#pragma unroll
                for (int i = 0; i < 4; ++i) if (32 * p + 8 * fq + 4 * odd + i > qidx) acc[i] = -1.0e30f; }
            s[2 * p + odd] = acc; }
        AT_SCHED;
        if (!DB && p + 1 < 8) AT_LOADK(0, p + 1);
    }
#undef AT_LOADK
    LAS const unsigned char* vbase = lds + AT_V + fr * AT_VP + fq * 16;
#pragma unroll
    for (int dt = 0; dt < 8; ++dt) fb[0][dt] = *(const LAS bf16x8*)(vbase + 16 * dt * AT_VP);
    float m0 = mfloor, m1 = -3.0e38f;
#pragma unroll
    for (int t = 0; t < 16; ++t) { m0 = vmax3(m0, s[t][0], s[t][1]); m1 = vmax3(m1, s[t][2], s[t][3]); }
    float m = vmax2(m0, m1);
    m = vmax2(m, __shfl_xor(m, 16)); m = vmax2(m, __shfl_xor(m, 32));
    f32x4 l4 = (f32x4){0.f, 0.f, 0.f, 0.f}; const f32x2_t m2 = (f32x2_t){m, m};
#pragma unroll
    for (int t = 0; t < 16; ++t) { const f32x2_t d0 = vpk_sub((f32x2_t){s[t][0], s[t][1]}, m2), d1 = vpk_sub((f32x2_t){s[t][2], s[t][3]}, m2);
        const f32x4 e = (f32x4){fast_exp2(d0.x), fast_exp2(d0.y), fast_exp2(d1.x), fast_exp2(d1.y)}; s[t] = e; l4 += e; }
    float l = (l4[0] + l4[1]) + (l4[2] + l4[3]);
    l += __shfl_xor(l, 16); l += __shfl_xor(l, 32);
#pragma unroll
    for (int p = 0; p < 8; ++p) { v4u pw; pw.x = cvt_pk_bf16(s[2 * p][0], s[2 * p][1]); pw.y = cvt_pk_bf16(s[2 * p][2], s[2 * p][3]); pw.z = cvt_pk_bf16(s[2 * p + 1][0], s[2 * p + 1][1]); pw.w = cvt_pk_bf16(s[2 * p + 1][2], s[2 * p + 1][3]);
        pf[p] = __builtin_bit_cast(bf16x8, pw); }
    m_out = m; l_out = l;
}
template <bool DB, bool ZERO>
__device__ __forceinline__ void attn_pv(LAS const unsigned char* lds, const bf16x8 (&pf)[8], int fr, int fq, f32x4 (&o)[8], bf16x8 (&fb)[2][8]) {
    LAS const unsigned char* vbase = lds + AT_V + fr * AT_VP + fq * 16;
    if (ZERO) {
#pragma unroll
        for (int dt = 0; dt < 8; ++dt) o[dt] = (f32x4){0.f, 0.f, 0.f, 0.f}; }
#pragma unroll
    for (int p = 0; p < 8; ++p) {
        if (DB && p + 1 < 8) {
#pragma unroll
            for (int dt = 0; dt < 8; ++dt) fb[(p + 1) & 1][dt] = *(const LAS bf16x8*)(vbase + 16 * dt * AT_VP + (p + 1) * 64); }
        AT_SCHED;
#pragma unroll
        for (int dt = 0; dt < 8; ++dt) o[dt] = mfma16(fb[DB ? (p & 1) : 0][dt], pf[p], o[dt]);
        AT_SCHED;
        if (!DB && p + 1 < 8) {
#pragma unroll
            for (int dt = 0; dt < 8; ++dt) fb[0][dt] = *(const LAS bf16x8*)(vbase + 16 * dt * AT_VP + (p + 1) * 64); }
    }
}
template <bool CAUSAL>
__device__ __forceinline__ void attn_tile(LAS const unsigned char* lds, const bf16x8 (&qf)[4], int npair, int qidx, int fr, int fq, float& m_out, float& l_out, f32x4 (&o)[8]) {
    bf16x8 pf[8], fb[2][8]; (void)npair;
    attn_scores<CAUSAL>(lds, qf, qidx, fr, fq, -1.0e30f, m_out, l_out, pf, fb);
    attn_pv<true, true>(lds, pf, fr, fq, o, fb);
}
__device__ __forceinline__ void att1_phase(Frame& F, const Args& A, int a, bool stage_next, bool with_satt) {
    unsigned char* ws = F.ws; LAS unsigned char* lds = F.lds;
    const bf16* Q = (const bf16*)(ws + WS_Q); const unsigned* CNT = (const unsigned*)(ws + WS_CNT) + a * 256; const unsigned* LIST = (const unsigned*)(ws + WS_LIST);
    unsigned char* PARTO = (unsigned char*)(ws + WS_PARTO); float* PARTML = (float*)(ws + WS_PARTML);
    LAS int* pre = (LAS int*)(lds + AT_MISC);
    const int lane = F.lane, fr = lane & 15, fq = lane >> 4, tid = F.tid;
    const bool sa_on = with_satt && F.bid < SB * NH;
    const int sb_ = F.bid >> 3, sh_ = F.bid & 7, sg_ = sh_ >> 1, r32 = lane & 31, hw = tid >> 5;
    const GAS float* sck = (const GAS float*)A.in[2]; const GAS float* scv = (const GAS float*)A.in[3];
    LAS float* q_s = (LAS float*)(lds + AT_MISC + 2048); LAS float* sc_s = q_s + 128; LAS int* sel_s = (LAS int*)(sc_s + 32); LAS int* pg_s = sel_s + 4;
    LAS int* cnt_s = (LAS int*)(lds + AT_MISC + 3072);
    int craw = 0; if (tid < 256) craw = (int)CNT[tid];
    const int cchunks = (craw + 127) >> 7;
    float qv_ = 0.f; f32x4 kg0 = (f32x4){0.f, 0.f, 0.f, 0.f}, kg1 = kg0;
    if (sa_on) { const float* QS = (const float*)(ws + WS_QS); const float* KMC = (const float*)(ws + WS_KMC);
        if (tid < 128) qv_ = QS[sb_ * 1024 + sh_ * 128 + tid];
        const float* kp = KMC + (size_t)(sb_ * 32 + (tid >> 4)) * 512 + sg_ * 128 + 8 * (tid & 15); kg0 = *(const f32x4*)kp; kg1 = *(const f32x4*)(kp + 4); }
    __builtin_amdgcn_sched_barrier(0);
    __syncthreads();
    if (tid < 8) pg_s[tid] = 0;
    int cscan = cchunks;
#pragma unroll
    for (int o = 1; o < 64; o <<= 1) { const int y = __shfl_up(cscan, o); if (lane >= o) cscan += y; }
    if (tid < 256 && lane == 63) pre[260 + F.wave] = cscan;
    if (tid < 256) cnt_s[tid] = craw;
    if (sa_on && tid < 128) q_s[tid] = qv_;
    __syncthreads();
    if (tid < 256) { int base = 0;
#pragma unroll
        for (int w = 0; w < 3; ++w) if (w < F.wave) base += pre[260 + w];
        pre[tid + 1] = base + cscan; }
    if (tid == 0) pre[0] = 0;
    if (sa_on) {
        const int* pt = (const int*)A.in[6];
        { const int j = tid >> 4, dg = tid & 15; float s = 0.f;
#pragma unroll
          for (int i = 0; i < 4; ++i) s += q_s[8 * dg + i] * kg0[i];
#pragma unroll
          for (int i = 0; i < 4; ++i) s += q_s[8 * dg + 4 + i] * kg1[i];
          s += __shfl_xor(s, 1); s += __shfl_xor(s, 2); s += __shfl_xor(s, 4); s += __shfl_xor(s, 8);
          if (dg == 0) sc_s[j] = s; }
        __syncthreads();
        if (tid < 32) { const float mine = sc_s[tid]; int rk = 0;
#pragma unroll
            for (int i = 0; i < 32; ++i) { const float ov = sc_s[i]; rk += (ov > mine || (ov == mine && i < tid)) ? 1 : 0; }
            if (rk < 3) sel_s[rk] = tid; }
        __syncthreads();
        if (tid < 6) pg_s[tid] = pt[sb_ * NPG + 2 * sel_s[tid >> 1] + (tid & 1)];
    }
    __syncthreads();
    f32x4 sq4 = (f32x4){0.f, 0.f, 0.f, 0.f}, sacc = (f32x4){0.f, 0.f, 0.f, 0.f}; float sm = -1.0e30f, sl_ = 0.f; int ski = sa_on ? 0 : 48;
    if (sa_on) sq4 = *(const LAS f32x4*)(q_s + 4 * r32);
    f32x4 skb[2], svb[2];
#define SA_LOADN(KB_, VB_, N_, BASE_) do { _Pragma("unroll") for (int j_ = 0; j_ < (N_); ++j_) { const int i_ = (BASE_) + j_ < 48 ? (BASE_) + j_ : 47; \
        const size_t o_ = ((size_t)(pg_s[i_ >> 3] * PAGE + hw + 16 * (i_ & 7)) * 4 + sg_) * 128 + 4 * r32; KB_[j_] = *(const GAS f32x4*)(sck + o_); VB_[j_] = *(const GAS f32x4*)(scv + o_); } } while (0)
#define SA_FOLDN(KB_, VB_, N_) do { _Pragma("unroll") for (int j_ = 0; j_ < (N_); ++j_) { float s_ = sq4[0] * KB_[j_][0] + sq4[1] * KB_[j_][1] + sq4[2] * KB_[j_][2] + sq4[3] * KB_[j_][3]; \
        s_ += __shfl_xor(s_, 1); s_ += __shfl_xor(s_, 2); s_ += __shfl_xor(s_, 4); s_ += __shfl_xor(s_, 8); s_ += __shfl_xor(s_, 16); \
        if (ski + j_ < 48) { const float mn_ = fmaxf(sm, s_), cs_ = fast_exp2(sm - mn_), p_ = fast_exp2(s_ - mn_); sl_ = sl_ * cs_ + p_; sacc = sacc * cs_ + VB_[j_] * p_; sm = mn_; } } ski += (N_); } while (0)
#define SA_ISSUE() SA_LOADN(skb, svb, 2, ski)
#define SA_CONSUME() SA_FOLDN(skb, svb, 2)
    const int NI = pre[256];
    const int vb = (F.G & 7) == 0 ? (F.bid & 7) * (F.G >> 3) + (F.bid >> 3) : F.bid;
    const int i0 = (int)(((long)vb * NI) / F.G), i1 = (int)(((long)(vb + 1) * NI) / F.G);
    int li = 0;
    for (int it = i0; it < i1;) {
        while (pre[li + 1] <= it) ++li;
        const int seg_end = pre[li + 1] < i1 ? pre[li + 1] : i1;
        const int b = li >> 7, g = (li >> 5) & 3, j = li & 31, n = cnt_s[li];
        const int r0 = (it - pre[li]) * 128, r1t = (seg_end - pre[li]) * 128, r1 = r1t < n ? r1t : n, ng = (r1 - r0 + 15) >> 4;
        const unsigned* LL = LIST + (size_t)li * 16384;
#define A1_ENTRY(gi_) LL[(r0 + 16 * (gi_) + fr) < r1 ? (r0 + 16 * (gi_) + fr) : (r0 + 16 * (gi_))]
#define A1_LOADQ(dst, ent_) do { const bf16* qp_ = Q + ((size_t)(b * T + (int)((ent_) & 8191u))) * 1024 + (2 * g + (int)(((ent_) >> 13) & 1u)) * 128 + 8 * fq; \
        _Pragma("unroll") for (int ks = 0; ks < 4; ++ks) dst[ks] = ld_bf16x8_g(qp_ + 32 * ks); } while (0)
        int gi = F.wave; bf16x8 qf[4];
        unsigned ent_c, ent_n;
        { v4u kr[8], vr[8]; f32x4 pka[4], pva[4];
          { const int g0 = gi < ng ? gi : 0, g1 = gi + 8 < ng ? gi + 8 : g0; ent_c = A1_ENTRY(g0); ent_n = A1_ENTRY(g1); }
          AT_SCHED;
          kv_block_fetch(F, b, g, j, kr, vr);
          AT_SCHED;
          A1_LOADQ(qf, ent_c);
          SA_LOADN(pka, pva, 4, ski);
          __syncthreads();
          kv_block_store(F, kr, vr); __syncthreads();
          SA_FOLDN(pka, pva, 4); }
        if (F.wave & 4) __builtin_amdgcn_s_sleep(32);
        if (F.wave < ng) {
#pragma unroll 1
            for (; gi < ng; gi += 8) {
                const int g2 = gi + 16 < ng ? gi + 16 : gi; const unsigned ent_nn = A1_ENTRY(g2);
                SA_ISSUE();
                const bool valid = (r0 + 16 * gi + fr) < r1;
                const int t = ent_c & 8191, hh = (ent_c >> 13) & 1, sl = ent_c >> 14, h = 2 * g + hh; const size_t row = (size_t)(b * T + t);
                float m, l; f32x4 o[8];
                { bf16x8 pf[8], fb[2][8]; attn_scores<false, false>(lds, qf, 0, fr, fq, -1.0e30f, m, l, pf, fb);
                  AT_SCHED;
                  A1_LOADQ(qf, ent_n);
                  attn_pv<false, true>(lds, pf, fr, fq, o, fb); }
                const float inv = __builtin_amdgcn_rcpf(l); const size_t pb = (row * 8 + h) * 3 + sl;
                unsigned char* po = valid ? PARTO + pb * 128 + 32 * fq : (unsigned char*)(ws + WS_END) + 32 * lane; float* pm = valid ? PARTML + pb * 2 : (float*)(ws + WS_END + 65536) + 2 * lane;
                unsigned w8[8];
#pragma unroll
                for (int dt = 0; dt < 8; ++dt) { const f32x4 on = o[dt] * inv; int w_ = __builtin_amdgcn_cvt_pk_fp8_f32(on[0], on[1], 0, false); w_ = __builtin_amdgcn_cvt_pk_fp8_f32(on[2], on[3], w_, true); w8[dt] = (unsigned)w_; }
                *(v4u*)po = (v4u){w8[0], w8[1], w8[2], w8[3]}; *(v4u*)(po + 16) = (v4u){w8[4], w8[5], w8[6], w8[7]};
                if (fq == 0) { f32x2_t ml; ml.x = m; ml.y = l; *(f32x2_t*)pm = ml; }
                SA_CONSUME();
                ent_c = ent_n; ent_n = ent_nn;
            }
        }
#undef A1_ENTRY
#undef A1_LOADQ
        it = seg_end;
    }
    if (ski < 48) { f32x4 tka[8], tva[8], tkb[8], tvb[8];
        SA_LOADN(tka, tva, 8, ski);
#pragma unroll 1
        for (;;) { SA_LOADN(tkb, tvb, 8, ski + 8); SA_FOLDN(tka, tva, 8); if (ski >= 48) break;
                   SA_LOADN(tka, tva, 8, ski + 8); SA_FOLDN(tkb, tvb, 8); if (ski >= 48) break; } }
#undef SA_ISSUE
#undef SA_CONSUME
#undef SA_LOADN
#undef SA_FOLDN
    if (sa_on) {
        LAS float* comb = (LAS float*)lds;
        const float* sk = F.out + O_SK; const float* sv = F.out + O_SV; bf16* OSB = (bf16*)(ws + WS_OSB);
        __syncthreads();
        *(LAS f32x4*)(comb + hw * 132 + 4 + 4 * r32) = sacc; if (r32 == 0) { comb[hw * 132] = sm; comb[hw * 132 + 1] = sl_; }
        if (hw == 0) { const f32x4 k4 = *((const f32x4*)(sk + (size_t)(sb_ * 4 + sg_) * 128) + r32); float s = sq4[0] * k4[0] + sq4[1] * k4[1] + sq4[2] * k4[2] + sq4[3] * k4[3];
            s += __shfl_xor(s, 1); s += __shfl_xor(s, 2); s += __shfl_xor(s, 4); s += __shfl_xor(s, 8); s += __shfl_xor(s, 16);
            if (r32 == 0) comb[16 * 132] = s; }
        __syncthreads();
        if (tid < 128) { const float ss = comb[16 * 132]; float M_ = ss;
#pragma unroll
            for (int i = 0; i < 16; ++i) M_ = fmaxf(M_, comb[i * 132]);
            const float es = fast_exp2(ss - M_); float den = es, num = es * sv[(size_t)(sb_ * 4 + sg_) * 128 + tid];
#pragma unroll
            for (int i = 0; i < 16; ++i) { const float e = fast_exp2(comb[i * 132] - M_); den += e * comb[i * 132 + 1]; num += e * comb[i * 132 + 4 + tid]; }
            OSB[sb_ * 1024 + sh_ * 128 + tid] = f2bf1(num * __builtin_amdgcn_rcpf(den)); }
    }
    if (stage_next && F.bid < 256) {
        __syncthreads(); load_kv_block(F, F.bid >> 7, (F.bid >> 5) & 3, F.bid & 31); }
}
__device__ __forceinline__ void att2_phase(Frame& F, bool staged) {
    unsigned char* ws = F.ws; LAS unsigned char* lds = F.lds;
    const bf16* Q = (const bf16*)(ws + WS_Q); const unsigned char* PARTO = (const unsigned char*)(ws + WS_PARTO); const float* PARTML = (const float*)(ws + WS_PARTML); bf16* OB = (bf16*)(ws + WS_OB);
    const int lane = F.lane, fr = lane & 15, fq = lane >> 4;
    for (int u = F.bid; u < 256; u += F.G) {
        const int b = u >> 7, g = (u >> 5) & 3, qb = u & 31;
        const int nsl = qb < 3 ? qb : 3;
        bf16x8 qf[4]; f32x2_t ml[3], mln[3];
#define A2_ROW(k_) ((size_t)(b * T + 256 * qb + 16 * ((F.wave + 8 * (k_)) & 15) + fr))
#define A2_HEAD(k_) (2 * g + ((F.wave + 8 * (k_)) >> 4))
#define A2_LOAD(QD, MLD, k_) do { const size_t row_ = A2_ROW(k_); const int h_ = A2_HEAD(k_); const bf16* qp_ = Q + row_ * 1024 + h_ * 128 + 8 * fq; \
        _Pragma("unroll") for (int ks = 0; ks < 4; ++ks) QD[ks] = ld_bf16x8_g(qp_ + 32 * ks); \
        _Pragma("unroll") for (int sl = 0; sl < 3; ++sl) { MLD[sl].x = -1.0e30f; MLD[sl].y = 0.f; if (sl < nsl) MLD[sl] = *(const f32x2_t*)(PARTML + ((row_ * 8 + h_) * 3 + sl) * 2); } } while (0)
        A2_LOAD(qf, ml, 0);
        if (!(staged && u == F.bid)) { __syncthreads(); load_kv_block(F, b, g, qb); }
        __syncthreads();
        if (F.wave & 4) __builtin_amdgcn_s_sleep(32);
#pragma unroll 1
        for (int k = 0; k < 4; ++k) {
            const size_t row = A2_ROW(k); const int h = A2_HEAD(k), qidx = 16 * ((F.wave + 8 * k) & 15) + fr;
            v4u pw[3][2]; const unsigned char* po = PARTO + ((row * 8 + h) * 3) * 128 + 32 * fq;
#pragma unroll
            for (int sl = 0; sl < 3; ++sl) if (sl < nsl) { pw[sl][0] = *(const v4u*)(po + sl * 128); pw[sl][1] = *(const v4u*)(po + sl * 128 + 16); }
            float m, l; f32x4 o[8]; bf16x8 pf[8], fb[2][8];
            const float mfl = fmaxf(fmaxf(ml[0].x, ml[1].x), ml[2].x);
            attn_scores<true, false>(lds, qf, qidx, fr, fq, mfl, m, l, pf, fb);
            AT_SCHED;
            { const int k1 = k + 1 < 4 ? k + 1 : k; A2_LOAD(qf, mln, k1); }
            float den = l, wsl[3];
#pragma unroll
            for (int sl = 0; sl < 3; ++sl) { wsl[sl] = (sl < nsl) ? ml[sl].y * fast_exp2(ml[sl].x - m) : 0.f; den += wsl[sl]; }
#pragma unroll
            for (int dt = 0; dt < 8; ++dt) { f32x4 r = (f32x4){0.f, 0.f, 0.f, 0.f};
#pragma unroll
                for (int sl = 0; sl < 3; ++sl) if (sl < nsl) { const int w_ = (int)pw[sl][dt >> 2][dt & 3]; const f32x2_t lo = __builtin_amdgcn_cvt_pk_f32_fp8(w_, false), hi = __builtin_amdgcn_cvt_pk_f32_fp8(w_, true);
                    r += (f32x4){lo.x, lo.y, hi.x, hi.y} * wsl[sl]; }
                o[dt] = r; }
            attn_pv<false, false>(lds, pf, fr, fq, o, fb);
            const float inv = __builtin_amdgcn_rcpf(den);
#pragma unroll
            for (int dt = 0; dt < 8; ++dt) { const f32x4 on = o[dt] * inv; u32x2 w; w.x = cvt_pk_bf16(on[0], on[1]); w.y = cvt_pk_bf16(on[2], on[3]);
                *(u32x2*)(OB + row * 1024 + h * 128 + 16 * dt + 4 * fq) = w; }
#pragma unroll
            for (int sl = 0; sl < 3; ++sl) ml[sl] = mln[sl];
        }
#undef A2_LOAD
#undef A2_ROW
#undef A2_HEAD
    }
}
constexpr int SA_Q = 0, SA_SC = 512, SA_SEL = 640, SA_PG = 672, SA_LG = 1024, SA_RED = 4352, SA_OP = 4608;
#define SA_BARRIER() do { asm volatile("s_waitcnt lgkmcnt(0)" ::: "memory"); __builtin_amdgcn_s_barrier(); asm volatile("" ::: "memory"); } while (0)
__device__ __forceinline__ void satt_phase(Frame& F, const Args& A) {
    unsigned char* ws = F.ws; LAS unsigned char* lds = F.lds;
    const float* QS = (const float*)(ws + WS_QS); const float* KMC = (const float*)(ws + WS_KMC); bf16* OSB = (bf16*)(ws + WS_OSB);
    const float* ck = (const float*)A.in[2]; const float* cv = (const float*)A.in[3]; const int* pt = (const int*)A.in[6];
    const float* sk = F.out + O_SK; const float* sv = F.out + O_SV;
    LAS float* q_s = (LAS float*)(lds + SA_Q); LAS float* sc_s = (LAS float*)(lds + SA_SC); LAS int* sel_s = (LAS int*)(lds + SA_SEL); LAS int* pg_s = (LAS int*)(lds + SA_PG); LAS float* lg = (LAS float*)(lds + SA_LG);
    LAS float* red = (LAS float*)(lds + SA_RED); LAS f32x4* op = (LAS f32x4*)(lds + SA_OP);
    const int tid = F.tid, lane = F.lane;
    for (int u = F.bid; u < SB * NH; u += F.G) {
        const int b = u >> 3, h = u & 7, g = h >> 1;
        __syncthreads();
        if (tid < 128) q_s[tid] = QS[b * 1024 + h * 128 + tid];
        __syncthreads();
        { const int j = tid >> 4, dg = tid & 15; const float* kp = KMC + (size_t)(b * 32 + j) * 512 + g * 128 + 8 * dg; float s = 0.f;
#pragma unroll
          for (int i = 0; i < 8; ++i) s += q_s[8 * dg + i] * kp[i];
          s += __shfl_xor(s, 1); s += __shfl_xor(s, 2); s += __shfl_xor(s, 4); s += __shfl_xor(s, 8);
          if (dg == 0) sc_s[j] = s; }
        __syncthreads();
        if (tid == 0) { float v[32];
#pragma unroll
            for (int i = 0; i < 32; ++i) v[i] = sc_s[i];
#pragma unroll
            for (int rd = 0; rd < 3; ++rd) { float bv = -3.4e38f; int bi = 0;
#pragma unroll
                for (int i = 0; i < 32; ++i) if (v[i] > bv) { bv = v[i]; bi = i; }
                sel_s[rd] = bi;
#pragma unroll
                for (int i = 0; i < 32; ++i) if (i == bi) v[i] = -3.4e38f; } }
        __syncthreads();
        if (tid < 6) pg_s[tid] = pt[b * NPG + 2 * sel_s[tid >> 1] + (tid & 1)];
        __syncthreads();
        const int r32 = lane & 31, hw = tid >> 5;
        const f32x4 q4 = *(const LAS f32x4*)(q_s + 4 * r32);
        f32x4 ka[8], kb[8];
#define SA_LOAD(dst, base_, bt_) do { const f32x4* p_ = (const f32x4*)((base_) + ((size_t)(pg_s[bt_] * PAGE + hw) * 4 + g) * 128) + r32; _Pragma("unroll") for (int i = 0; i < 8; ++i) dst[i] = p_[(size_t)i * 2048]; } while (0)
#define SA_DOT(src, bt_) do { _Pragma("unroll") for (int i = 0; i < 8; ++i) { float s = q4[0] * src[i][0] + q4[1] * src[i][1] + q4[2] * src[i][2] + q4[3] * src[i][3]; \
            s += __shfl_xor(s, 1); s += __shfl_xor(s, 2); s += __shfl_xor(s, 4); s += __shfl_xor(s, 8); s += __shfl_xor(s, 16); if (r32 == 0) lg[(bt_) * 128 + hw + 16 * i] = s; } } while (0)
        SA_LOAD(ka, ck, 0);
#pragma unroll
        for (int bt = 0; bt < 6; bt += 2) {
            SA_LOAD(kb, ck, bt + 1); SA_DOT(ka, bt);
            if (bt + 2 < 6) SA_LOAD(ka, ck, bt + 2); else SA_LOAD(ka, cv, 0);
            SA_DOT(kb, bt + 1);
        }
        if (hw == 0) { const f32x4 k4 = *((const f32x4*)(sk + (size_t)(b * 4 + g) * 128) + r32); float s = q4[0] * k4[0] + q4[1] * k4[1] + q4[2] * k4[2] + q4[3] * k4[3];
            s += __shfl_xor(s, 1); s += __shfl_xor(s, 2); s += __shfl_xor(s, 4); s += __shfl_xor(s, 8); s += __shfl_xor(s, 16);
            if (r32 == 0) lg[768] = s; }
        SA_BARRIER();
        float mx = -3.4e38f;
        for (int i = tid; i < 769; i += NTHR) mx = fmaxf(mx, lg[i]);
        mx = wave_max(mx); if (lane == 0) red[F.wave] = mx;
        SA_BARRIER();
        mx = red[0];
#pragma unroll
        for (int i = 1; i < 8; ++i) mx = fmaxf(mx, red[i]);
        SA_BARRIER();
        float sm = 0.f;
        for (int i = tid; i < 769; i += NTHR) { const float e = fast_exp2(lg[i] - mx); lg[i] = e; sm += e; }
        sm = wave_sum(sm); if (lane == 0) red[F.wave] = sm;
        SA_BARRIER();
        sm = 0.f;
#pragma unroll
        for (int i = 0; i < 8; ++i) sm += red[i];
        f32x4 acc = (f32x4){0.f, 0.f, 0.f, 0.f};
#define SA_ACC(src, bt_) do { _Pragma("unroll") for (int i = 0; i < 8; ++i) acc += src[i] * lg[(bt_) * 128 + hw + 16 * i]; } while (0)
#pragma unroll
        for (int bt = 0; bt < 6; bt += 2) {
            SA_LOAD(kb, cv, bt + 1); SA_ACC(ka, bt);
            if (bt + 2 < 6) SA_LOAD(ka, cv, bt + 2);
            SA_ACC(kb, bt + 1);
        }
#undef SA_ACC
#undef SA_DOT
#undef SA_LOAD
        if (hw == 0) { const f32x4 v4 = *((const f32x4*)(sv + (size_t)(b * 4 + g) * 128) + r32); acc += v4 * lg[768]; }
        op[hw * 32 + r32] = acc;
        __syncthreads();
        if (tid < 32) { f32x4 t = op[tid];
#pragma unroll
            for (int i = 1; i < 16; ++i) t += op[i * 32 + tid];
            t = t * (1.0f / sm);
            u32x2 w; w.x = cvt_pk_bf16(t[0], t[1]); w.y = cvt_pk_bf16(t[2], t[3]); *(u32x2*)(OSB + b * 1024 + h * 128 + 4 * tid) = w; }
    }
}
__device__ __forceinline__ void final_phase(Frame& F, const Args& A) {
    unsigned char* ws = F.ws; const float* gf = (const float*)A.in[24];
    const int gw = F.bid * NWAVES + F.wave, NGW = F.G * NWAVES;
    f32x4 gv[4];
#pragma unroll
    for (int j = 0; j < 4; ++j) gv[j] = *((const f32x4*)gf + F.lane + 64 * j);
#pragma unroll 1
    for (int m0 = gw; m0 < M + SB; m0 += 2 * NGW) {
        f32x4 xv[2][4]; rss_t sv[2]; float* yp[2]; bool live[2];
#pragma unroll
        for (int k = 0; k < 2; ++k) { const int m = m0 + k * NGW < M + SB ? m0 + k * NGW : m0; live[k] = (k == 0) || (m0 + NGW < M + SB); const bool P = m < M; const int r = P ? m : m - M;
            sv[k] = P ? ((const rss_t*)(ws + WS_RSS))[8 * M + r] : ((const rss_t*)(ws + WS_RSSS))[8 * SB + r];
            yp[k] = P ? F.out + O_YP + (size_t)r * D : F.out + O_YS + (size_t)r * D;
            if (P) { const u32x2* xbr = (const u32x2*)((const bf16*)(ws + WS_XB) + (size_t)r * D);
#pragma unroll
                for (int j = 0; j < 4; ++j) { const u32x2 w = xbr[F.lane + 64 * j]; xv[k][j] = (f32x4){bflo(w.x), bfhi(w.x), bflo(w.y), bfhi(w.y)}; }
            } else { const float* x = (const float*)(ws + WS_XS) + (size_t)r * D;
#pragma unroll
                for (int j = 0; j < 4; ++j) xv[k][j] = *((const f32x4*)x + F.lane + 64 * j); } }
#pragma unroll
        for (int k = 0; k < 2; ++k) { const float rs = 1.0f / sqrtf((float)sv[k] * (1.0f / 16777216.0f) * (1.0f / 1024.0f) + EPS);
            if (live[k]) {
#pragma unroll
                for (int j = 0; j < 4; ++j) *((f32x4*)yp[k] + F.lane + 64 * j) = xv[k][j] * rs * gv[j]; } }
    }
}

constexpr int NPH = 30;
#ifndef MK_MULTI
#define MK_MULTI 0
#endif
__global__ void __launch_bounds__(NTHR, 2) yoco_fwd(Args args) {
    extern __shared__ __attribute__((aligned(16))) unsigned char lds_raw[];
    LAS unsigned char* const lds_base = (LAS unsigned char*)lds_raw;
    volatile LAS unsigned* MISC = (volatile LAS unsigned*)(lds_base + LDS_MISC_OFF);
    if (threadIdx.x < 32) MISC[threadIdx.x] = 0u;
    const int wave_s = __builtin_amdgcn_readfirstlane((int)threadIdx.x >> 6);
    __syncthreads();
#ifndef REPMASK
#define REPMASK 0u
#endif
#define REPMASK_IS_ZERO (REPMASK == 0u)
#define lo (args.ph_lo)
#define hi (args.ph_hi)
#define hi_bar ((gridDim.x == 256 && lo <= 28 && hi > 29 && REPMASK_IS_ZERO) ? 29 : hi)
    unsigned* ctl = (unsigned*)(args.ws + WS_CTL);
    XcdBarrier bar; bar.bar = ctl + CW_BAR; bar.x = 0; bar.st = MISC + 8;
    if (hi - lo > 1) bar = xcd_barrier_post(ctl + CW_BAR, MISC + 8);
#ifndef PHMASK
#define PHMASK 0xFFFFFFFFu
#endif
#define PH_BEGIN(id, bit) if (((PHMASK >> (bit)) & 1u) && lo <= (id) && (id) < hi) { Frame F = make_frame(args, lds_base, wave_s); unsigned char* ws = F.ws; \
    rss_t* RSS = (rss_t*)(ws + WS_RSS); rss_t* RSSS = (rss_t*)(ws + WS_RSSS); bf16* XB = (bf16*)(ws + WS_XB); float* X = (float*)(ws + WS_X); float* XS = (float*)(ws + WS_XS); bf16* XSB = (bf16*)(ws + WS_XSB); \
    LAS unsigned char* ring = F.lds + RING_OFF; (void)RSS; (void)RSSS; (void)XB; (void)X; (void)XS; (void)XSB; (void)ring; \
    const rss_t* rss_in = RSS + (size_t)(2 * l) * M; rss_t* rss_mid = RSS + (size_t)(2 * l + 1) * M; rss_t* rss_out = RSS + (size_t)(2 * l + 2) * M; \
    const rss_t* rsss_in = RSSS + (2 * l) * SB; rss_t* rsss_mid = RSSS + (2 * l + 1) * SB; rss_t* rsss_out = RSSS + (2 * l + 2) * SB; (void)rss_in; (void)rss_mid; (void)rss_out; (void)rsss_in; (void)rsss_mid; (void)rsss_out; \
    for (int rep = (int)((REPMASK >> (bit)) & 1u); rep >= 0; --rep) { const bool dry = rep > 0; (void)dry;
#ifndef PROBE_SCAN1_EXTRA
#define PROBE_SCAN1_EXTRA
#endif
#ifndef PROBE_SCAN2_EXTRA
#define PROBE_SCAN2_EXTRA
#endif
#define RS_TAB ((LAS float*)(F.lds + 140544))
#define RS_LOAD(rssp) rss_t rs_raw_ = (hasu && F.tid < 256) ? (rssp)[u0.pm * 256 + F.tid] : (rss_t)0
#define RS_STORE() do { if (hasu && F.tid < 256) RS_TAB[F.tid] = pg8::rs_of(rs_raw_); } while (0)
#ifndef PROBE_BAR_EXTRA
#define PROBE_BAR_EXTRA
#endif
#define PH_END(id) } if ((id) + 1 < hi_bar) { xcd_barrier(bar, pg8::tid_of(wave_s) == 0); PROBE_BAR_EXTRA } }

    { const int l = 0; PH_BEGIN(0, 0) p0_prologue(F, args); PH_END(0) }

    for (int l = 0; l < 4; ++l) {
        const int pb = 1 + 7 * l;
        if (l < 2) {
            PH_BEGIN(pb + 0, 1)
                pg8::StaticOrder SO; SO.init(M, 2048, F.G, F.bid); pg8::Unit u0{}; const bool hasu = SO.next(0, u0);
                auto hook = [&]() { RS_LOAD(rss_in); { SgArgs S{}; S.A = XSB; S.lda = 1024; S.Bt = (const bf16*)(ws + WS_WRGIN) + (size_t)l * 2048 * 1024; S.K = 1024; S.nunits = 64; S.rss_in = rsss_in; S.fout = (float*)(ws + WS_PROJS);
                  sgemm_units<SG_RGIN, 1024>(F, S, 0); }
                  if (!dry) { conv_shadow(F, args, l, 0, 0, 64); } RS_STORE(); __syncthreads(); };
                { pg8::Gemm g{XB, (const bf16*)(ws + WS_WRGIN) + (size_t)l * 2048 * 1024, M, 2048, 1024}; g.wv = F.wave; pg8::StaticOrder S = SO;
                  pg8::EpiRgIn E{rss_in, (bf16*)(ws + WS_GATE), (bf16*)(ws + WS_U), F.out + O_PCONV + (size_t)l * 2 * 3 * 1024}; E.rsl = RS_TAB; E.rs_pm = hasu ? u0.pm : -1;
                  pg8::gemm_phase<pg8::EpiRgIn, pg8::StaticOrder, true, true, false>(ring, g, S, E, hook); }
            PH_END(pb + 0)
            PH_BEGIN(pb + 1, 2) scan_phase<1>(F, args, l); PROBE_SCAN1_EXTRA srg_step(F, args, l); scan_phase<2>(F, args, l); PROBE_SCAN2_EXTRA PH_END(pb + 1)
            PH_BEGIN(pb + 4, 4)
                auto hook = [&]() { { SgArgs S{}; S.A = (const bf16*)(ws + WS_HGS); S.lda = 1024; S.Bt = (const bf16*)(ws + WS_WRGOUT) + (size_t)l * 1024 * 1024; S.K = 1024; S.nunits = 32;
                  S.xin = l == 0 ? (const float*)args.in[1] : XS; S.xout = XS; S.xbout = XSB; S.rss_out = rsss_mid; if (!dry) sgemm_units<SG_RESID, 1024>(F, S, 0); }
                  if (!dry) { conv_shadow(F, args, l, 1, 0, 32); } __syncthreads(); };
                { pg8::Gemm g{(const bf16*)(ws + WS_HG), (const bf16*)(ws + WS_WRGOUT) + (size_t)l * 1024 * 1024, M, 1024, 1024}; g.wv = F.wave; pg8::StaticOrder S; S.init(M, 1024, F.G, F.bid);
                  pg8::EpiResid E{XB, dry ? (bf16*)(ws + WS_DXB) : XB, dry ? (rss_t*)(ws + WS_DRSS) : rss_mid};
                  pg8::gemm_phase<pg8::EpiResid, pg8::StaticOrder, true, true, false>(ring, g, S, E, hook); }
            PH_END(pb + 4)
        } else {
            const int a = l - 2;
            PH_BEGIN(pb + 0, 5)
                pg8::StaticOrder SO; SO.init(M, a ? 1024 : 2048, F.G, F.bid); pg8::Unit u0{}; const bool hasu = SO.next(0, u0);
                auto hook = [&]() { RS_LOAD(rss_in); { SgArgs S{}; S.A = XSB; S.lda = 1024; S.Bt = (const bf16*)(ws + WS_WQKV) + (size_t)(a ? 2048 : 0) * 1024; S.K = 1024; S.nunits = a ? 32 : 64; S.rss_in = rsss_in;
                  S.fout = (float*)(ws + WS_QS); S.sk = F.out + O_SK; S.sv = F.out + O_SV; if (!dry) sgemm_units<SG_QKV, 1024>(F, S, 0); }
                  if (!dry && a == 0) { conv_shadow(F, args, l, 0, 0, 64); } RS_STORE(); __syncthreads(); };
                { const int N = a ? 1024 : 2048; pg8::Gemm g{XB, (const bf16*)(ws + WS_WQKV) + (size_t)(a ? 2048 : 0) * 1024, M, N, 1024}; g.wv = F.wave; pg8::StaticOrder S = SO;
                  pg8::EpiQkv E{rss_in, (bf16*)(ws + WS_Q), (bf16*)(ws + WS_KB), (bf16*)(ws + WS_VT), F.out + O_PK, F.out + O_PV, (float*)(ws + (dry ? WS_DKM : WS_KM))}; E.rsl = RS_TAB; E.rs_pm = hasu ? u0.pm : -1;
                  pg8::gemm_phase<pg8::EpiQkv, pg8::StaticOrder, true, true, false>(ring, g, S, E, hook); }
            PH_END(pb + 0)
            PH_BEGIN(pb + 1, 6) sel_phase(F, a, dry); if (lo > pb + 1 || hi <= pb + 2) satt_phase(F, args); PH_END(pb + 1)
            PH_BEGIN(pb + 2, 7) att1_phase(F, args, a, REPMASK == 0u && pb + 3 < hi, lo <= pb + 1); PH_END(pb + 2)
            PH_BEGIN(pb + 3, 8) att2_phase(F, REPMASK == 0u && lo <= pb + 2); PH_END(pb + 3)
            PH_BEGIN(pb + 4, 9)
                auto hook = [&]() { { SgArgs S{}; S.A = (const bf16*)(ws + WS_OSB); S.lda = 1024; S.Bt = (const bf16*)(ws + WS_WO) + (size_t)a * 1024 * 1024; S.K = 1024; S.nunits = 32;
                  S.xin = XS; S.xout = XS; S.xbout = XSB; S.rss_out = rsss_mid; if (!dry) sgemm_units<SG_RESID, 1024>(F, S, 0); }
                  if (!dry && a == 0) { conv_shadow(F, args, l, 1, 0, 32); } __syncthreads(); };
                { pg8::Gemm g{(const bf16*)(ws + WS_OB), (const bf16*)(ws + WS_WO) + (size_t)a * 1024 * 1024, M, 1024, 1024}; g.wv = F.wave; pg8::StaticOrder S; S.init(M, 1024, F.G, F.bid);
                  pg8::EpiResid E{XB, dry ? (bf16*)(ws + WS_DXB) : XB, dry ? (rss_t*)(ws + WS_DRSS) : rss_mid};
                  pg8::gemm_phase<pg8::EpiResid, pg8::StaticOrder, true, true, false>(ring, g, S, E, hook); }
            PH_END(pb + 4)
        }
        PH_BEGIN(pb + 5, 10)
            pg8::StaticOrder SO; SO.init(M, NF2, F.G, F.bid); pg8::Unit u0{}; const bool hasu = SO.next(0, u0);
            auto hook = [&]() { RS_LOAD(rss_mid); { SgArgs S{}; S.A = XSB; S.lda = 1024; S.Bt = (const bf16*)(ws + WS_WFIN) + (size_t)l * NF2 * 1024; S.K = 1024; S.nunits = 88; S.rss_in = rsss_mid; S.bout = (bf16*)(ws + WS_ACTS);
              sgemm_units<SG_FFNIN, 1024>(F, S, 128); }
              if (!dry) { conv_shadow(F, args, l, 2, 128, 88); } RS_STORE(); __syncthreads(); };
            { pg8::Gemm g{XB, (const bf16*)(ws + WS_WFIN) + (size_t)l * NF2 * 1024, M, NF2, 1024}; g.wv = F.wave;
              const int nfull = (64 * 22) / F.G;
              { pg8::RoundsOrder S; S.init(M, NF2, F.G, F.bid); S.maxr = nfull; pg8::EpiFfnIn<false> E{rss_mid, (bf16*)(ws + WS_ACT)}; E.rsl = RS_TAB; E.rs_pm = hasu ? u0.pm : -1;
                pg8::gemm_phase<pg8::EpiFfnIn<false>, pg8::RoundsOrder, true, true, false>(ring, g, S, E, hook); }
              if (2 * (64 * 22 - nfull * F.G) <= F.G) { pg8::HalfOrder S; S.init(M, NF2, F.G, F.bid); S.maxr = nfull; pg8::EpiFfnIn<true> E{rss_mid, (bf16*)(ws + WS_ACT)};
                pg8::gemm_phase<pg8::EpiFfnIn<true>, pg8::HalfOrder, true, true, true>(ring, g, S, E); }
              else { pg8::HalfOrder S0; (void)S0; struct Rest : pg8::StaticOrder { int r0; __device__ bool next(int i, pg8::Unit& u) const { return pg8::StaticOrder::next(i + r0, u); } } S; S.init(M, NF2, F.G, F.bid); S.r0 = nfull; pg8::EpiFfnIn<false> E{rss_mid, (bf16*)(ws + WS_ACT)};
                pg8::gemm_phase<pg8::EpiFfnIn<false>, Rest, true, true>(ring, g, S, E); } }
        PH_END(pb + 5)
        PH_BEGIN(pb + 6, 11)
            const bool fuse_fin = (l == 3) && F.G == 256 && hi > 29 && !dry && REPMASK == 0u;
            unsigned* fctl = (unsigned*)(ws + WS_CTL);
            auto hook = [&]() { { SgArgs S{}; S.A = (const bf16*)(ws + WS_ACTS); S.lda = FF; S.Bt = (const bf16*)(ws + WS_WFOUT) + (size_t)l * 1024 * FF; S.K = FF; S.nunits = 32;
              S.xin = XS; S.xout = XS; S.xbout = XSB; S.rss_out = rsss_out;
              if (fuse_fin) { S.fcnt = fctl + CW_FINS; S.gfin = (const float*)args.in[24]; S.fout = F.out + O_YS; sgemm_units<SG_RESFIN, FF>(F, S, 0); }
              else if (!dry) sgemm_units<SG_RESID, FF>(F, S, 0); }
              if (!dry) { conv_shadow(F, args, l, 3, 0, 32); } __syncthreads(); };
            { pg8::Gemm g{(const bf16*)(ws + WS_ACT), (const bf16*)(ws + WS_WFOUT) + (size_t)l * 1024 * FF, M, 1024, FF}; g.wv = F.wave; pg8::StaticOrder S; S.init(M, 1024, F.G, F.bid);
              if (fuse_fin) { pg8::EpiResidFinal E{XB, rss_out, fctl + CW_FINP, (const float*)args.in[24], F.out + O_YP};
                pg8::gemm_phase<pg8::EpiResidFinal, pg8::StaticOrder, false, true, false>(ring, g, S, E, hook); }
              else { pg8::EpiResid E{XB, dry ? (bf16*)(ws + WS_DXB) : XB, dry ? (rss_t*)(ws + WS_DRSS) : rss_out};
                pg8::gemm_phase<pg8::EpiResid, pg8::StaticOrder, true, true, false>(ring, g, S, E, hook); } }
        PH_END(pb + 6)
    }
    if (!(gridDim.x == 256 && lo <= 28 && hi > 29 && REPMASK == 0u)) { const int l = 0; PH_BEGIN(29, 12) final_phase(F, args); PH_END(29) }
#undef PH_BEGIN
#undef PH_END
#undef lo
#undef hi
#undef hi_bar
}

extern "C" void kernel_launch(void* const* d_in, const int* in_sizes, int n_in, void* d_out, int out_size, void* d_ws, size_t ws_size, hipStream_t stream) {
    static int grid = 0;
    if (grid == 0) {
        if (n_in != 25 || out_size != (int)O_END || ws_size < WS_NEED) { fprintf(stderr, "kernel_launch: unexpected shapes (n_in %d, out %d, ws %zu); nothing launched\n", n_in, out_size, ws_size); grid = -1; return; }
        int dev = 0, cus = 0, per_cu = 0;
        if (hipGetDevice(&dev) != hipSuccess || hipDeviceGetAttribute(&cus, hipDeviceAttributeMultiprocessorCount, dev) != hipSuccess) { fprintf(stderr, "kernel_launch: device query failed\n"); grid = -1; return; }
        if (hipFuncSetAttribute((const void*)yoco_fwd, hipFuncAttributeMaxDynamicSharedMemorySize, LDS_BYTES) != hipSuccess) { fprintf(stderr, "kernel_launch: hipFuncSetAttribute failed\n"); grid = -1; return; }
        if (hipOccupancyMaxActiveBlocksPerMultiprocessor(&per_cu, (const void*)yoco_fwd, NTHR, LDS_BYTES) != hipSuccess || per_cu < 1) { fprintf(stderr, "kernel_launch: occupancy query says %d blocks per CU\n", per_cu); per_cu = 1; }
        (void)hipGetLastError();
        grid = cus;
    }
    if (grid < 0) return;
    (void)in_sizes;
    if (hipMemsetAsync(d_ws, 0, ZERO_BYTES, stream) != hipSuccess) { fprintf(stderr, "kernel_launch: memset failed\n"); return; }
    Args a; memset(&a, 0, sizeof(a));
    for (int i = 0; i < 25; ++i) a.in[i] = d_in[i];
    a.out = (float*)d_out; a.ws = (unsigned char*)d_ws;
#if MK_MULTI
    for (int p = 0; p < NPH; ++p) {
        if (p >= 1 && p <= 28) { const int l = (p - 1) / 7, k = (p - 1) % 7; if (l < 2 && (k == 2 || k == 3)) continue; }
        a.ph_lo = p; a.ph_hi = p + 1;
        hipLaunchKernelGGL(yoco_fwd, dim3(grid), dim3(NTHR), LDS_BYTES, stream, a);
    }
#else
    a.ph_lo = 0; a.ph_hi = NPH;
    hipLaunchKernelGGL(yoco_fwd, dim3(grid), dim3(NTHR), LDS_BYTES, stream, a);
#endif
    const hipError_t le = hipPeekAtLastError();
    if (le != hipSuccess) fprintf(stderr, "kernel_launch: launch failed: %s\n", hipGetErrorName(le));
}
```

```cpp
#include <hip/hip_runtime.h>
#include <cstdio>
#include <cstdint>
#include <cstring>
#define MK_MULTI 0
namespace pg8 {
#define PG8_LAS __attribute__((address_space(3)))
typedef unsigned short bf16_t;
typedef short bf16x8 __attribute__((ext_vector_type(8)));
typedef float f32x4 __attribute__((ext_vector_type(4)));
typedef unsigned u32x4 __attribute__((ext_vector_type(4)));
constexpr int BM = 256, BK = 64, HALF = 128, HTB = HALF * BK * 2  , STAGE_BYTES = 8 * HTB, NXCD = 8, WGM = 8;

__host__ __device__ __forceinline__ int lds_byte(int r, int c) { const int st = (r >> 4) * 2 + (c >> 5), rr = r & 15, cc = c & 31, ob = rr * 64 + cc * 2; return st * 1024 + (ob ^ (((ob >> 9) & 1) << 5)); }
__host__ __device__ __forceinline__ void stage_rc(int b, int& R, int& C) { const int st = b / 1024, sb = b % 1024, swz = sb ^ (((sb >> 9) & 1) << 5); R = (st >> 1) * 16 + swz / 64; C = (st & 1) * 32 + (swz % 64) / 2; }
__host__ __device__ __forceinline__ int perm32(int rho) { const int n = rho >> 4, i = rho & 15; return 8 * (i >> 2) + 4 * n + (i & 3); }

struct Unit { int pm, pn, rofs; };
struct Gemm { const bf16_t* A; const bf16_t* Bt; int M, N, K; int wv = 0; };
__device__ __forceinline__ int tid_of(int wave) { int l_; asm volatile("v_mbcnt_lo_u32_b32 %0, -1, 0\n\tv_mbcnt_hi_u32_b32 %0, -1, %0" : "=&v"(l_));
    return l_ + 64 * wave; }

struct StaticOrder {
    int nM, nN, nwg, G, c;
    __host__ __device__ void init(int M, int N, int G_, int c_) { nM = M / BM; nN = N / BM; nwg = nM * nN; G = G_; c = c_; }
    __host__ __device__ __forceinline__ bool next(int i, Unit& u) const {
        const long L = (long)i * G + c; if (L >= nwg) return false;
        int wgid = (int)L; { const int q = nwg / NXCD, r = nwg % NXCD, xcd = wgid % NXCD, off = wgid / NXCD; wgid = (xcd < r ? xcd * (q + 1) : r * (q + 1) + (xcd - r) * q) + off; }
        const int nig = WGM * nN, gid = wgid / nig, fm = gid * WGM, gsz = (nM - fm) < WGM ? (nM - fm) : WGM;
        u.pm = fm + ((wgid % nig) % gsz); u.pn = (wgid % nig) / gsz; u.rofs = 0; return true;
    }
    __device__ __forceinline__ void a_ready(const Unit&) const {}
    __device__ __forceinline__ void done(const Unit&) const {}
};
struct RoundsOrder : StaticOrder { int maxr; __host__ __device__ bool next(int i, Unit& u) const { return i < maxr && StaticOrder::next(i, u); } };
struct HalfOrder : StaticOrder { int maxr; __host__ __device__ bool next(int i, Unit& u) const { if (i != 0) return false; StaticOrder t = *this; t.c = c >> 1; if (!t.next(maxr, u)) return false; u.rofs = (c & 1) * HALF; return true; } };


__device__ __forceinline__ unsigned cvt_pk_bf16(float lo, float hi) { unsigned r; asm volatile("v_cvt_pk_bf16_f32 %0, %1, %2" : "=v"(r) : "v"(lo), "v"(hi)); return r; }
typedef float f32x2 __attribute__((ext_vector_type(2)));
typedef unsigned u32x2 __attribute__((ext_vector_type(2)));
constexpr float RMS_EPS = 1e-6f;
__device__ __forceinline__ float fast_rcp(float x) { return __builtin_amdgcn_rcpf(x); }
__device__ __forceinline__ float fast_exp2(float x) { return __builtin_amdgcn_exp2f(x); }
__device__ __forceinline__ float sigmoidf_(float z) { return fast_rcp(1.0f + fast_exp2(-1.44269504089f * z)); }
__device__ __forceinline__ float gelu_tanh(float x) { const float z = 1.5957691216057308f * (x + 0.044715f * x * x * x); return x * sigmoidf_(z); }
__device__ __forceinline__ float silu_(float x) { return x * sigmoidf_(x); }
typedef unsigned long long rss_t;
constexpr float RSS_SCALE = 16777216.0f, RSS_INV = 1.0f / (16777216.0f * 1024.0f);
__device__ __forceinline__ float row_rs(const rss_t* rowss, int r) { return __builtin_amdgcn_rsqf((float)rowss[r] * RSS_INV + RMS_EPS); }
__device__ __forceinline__ float rs_of(rss_t raw) { return __builtin_amdgcn_rsqf((float)raw * RSS_INV + RMS_EPS); }

struct EpiRgIn {
    static constexpr bool PERM = true, AFTER_DRAIN = false;
    const rss_t* rowss; bf16_t* gate; bf16_t* u; float* pconv;
    const PG8_LAS float* rsl = nullptr; int rs_pm = -1;
    __device__ __forceinline__ void operator()(const f32x4 (&acc)[2][2][4][2], const Unit& un, int wr, int wc, int fr, int fq) const {
        const bool isU = un.pn >= 4; const int colb = (un.pn & 3) * BM + wc * 32 + 8 * fq;
        rss_t rsw[2][4]; float rsv[2][4];
        if (un.pm == rs_pm) {
#pragma unroll
        for (int ai = 0; ai < 2; ++ai)
#pragma unroll
            for (int m = 0; m < 4; ++m) rsv[ai][m] = rsl[ai * HALF + wr * 64 + m * 16 + fr];
        } else {
#pragma unroll
        for (int ai = 0; ai < 2; ++ai)
#pragma unroll
            for (int m = 0; m < 4; ++m) rsw[ai][m] = rowss[un.pm * BM + ai * HALF + wr * 64 + m * 16 + fr];
#pragma unroll
        for (int ai = 0; ai < 2; ++ai)
#pragma unroll
            for (int m = 0; m < 4; ++m) rsv[ai][m] = rs_of(rsw[ai][m]);
        }
#pragma unroll
        for (int ai = 0; ai < 2; ++ai)
#pragma unroll
            for (int m = 0; m < 4; ++m) { const int r = un.pm * BM + ai * HALF + wr * 64 + m * 16 + fr; const float rs = rsv[ai][m];
#pragma unroll
                for (int bj = 0; bj < 2; ++bj) { f32x4 v0 = acc[ai][bj][m][0] * rs, v1 = acc[ai][bj][m][1] * rs; const int c = colb + bj * HALF;
                    if (!isU) {
#pragma unroll
                        for (int hv = 0; hv < 2; ++hv) { f32x4& x = hv ? v1 : v0;
                            const f32x4 z = (x * (x * x * 0.044715f + 1.0f)) * (-1.44269504089f * 1.5957691216057308f);
                            const f32x4 d = (f32x4){fast_exp2(z[0]), fast_exp2(z[1]), fast_exp2(z[2]), fast_exp2(z[3])} + 1.0f;
                            x = x * (f32x4){fast_rcp(d[0]), fast_rcp(d[1]), fast_rcp(d[2]), fast_rcp(d[3])}; }
                        u32x4 w; w.x = cvt_pk_bf16(v0[0], v0[1]); w.y = cvt_pk_bf16(v0[2], v0[3]); w.z = cvt_pk_bf16(v1[0], v1[1]); w.w = cvt_pk_bf16(v1[2], v1[3]);
                        *(u32x4*)(gate + (size_t)r * 1024 + c) = w;
                    } else {
                        u32x4 w; w.x = cvt_pk_bf16(v0[0], v0[1]); w.y = cvt_pk_bf16(v0[2], v0[3]); w.z = cvt_pk_bf16(v1[0], v1[1]); w.w = cvt_pk_bf16(v1[2], v1[3]);
                        *(u32x4*)(u + (size_t)r * 1024 + c) = w;
                        const int t = r & 8191;
                        if (t >= 8189) { float* pc = pconv + (size_t)((r >> 13) * 3 + (t - 8189)) * 1024 + c; *(f32x4*)pc = v0; *(f32x4*)(pc + 4) = v1; }
                    } } }
    }
};

__device__ __forceinline__ float bf_lo(unsigned w) { return __uint_as_float(w << 16); }
__device__ __forceinline__ float bf_hi(unsigned w) { return __uint_as_float(w & 0xffff0000u); }
struct EpiResid {
    static constexpr bool PERM = true, AFTER_DRAIN = false;
    const bf16_t* xin; bf16_t* xb; rss_t* rowss_out;
    __device__ __forceinline__ void operator()(const f32x4 (&acc)[2][2][4][2], const Unit& un, int wr, int wc, int fr, int fq) const {
        const int colb = un.pn * BM + wc * 32 + 8 * fq;
#pragma unroll
        for (int ai = 0; ai < 2; ++ai) {
            u32x4 xr[4][2];
#pragma unroll
            for (int m = 0; m < 4; ++m)
#pragma unroll
                for (int bj = 0; bj < 2; ++bj) xr[m][bj] = *(const u32x4*)(xin + (size_t)(un.pm * BM + ai * HALF + wr * 64 + m * 16 + fr) * 1024 + colb + bj * HALF);
#pragma unroll
            for (int m = 0; m < 4; ++m) { const int r = un.pm * BM + ai * HALF + wr * 64 + m * 16 + fr; float ss = 0.f;
#pragma unroll
                for (int bj = 0; bj < 2; ++bj) { const size_t off = (size_t)r * 1024 + colb + bj * HALF; const u32x4 xw = xr[m][bj];
                    const f32x4 x0 = (f32x4){bf_lo(xw.x), bf_hi(xw.x), bf_lo(xw.y), bf_hi(xw.y)} + acc[ai][bj][m][0], x1 = (f32x4){bf_lo(xw.z), bf_hi(xw.z), bf_lo(xw.w), bf_hi(xw.w)} + acc[ai][bj][m][1];
                    u32x4 w; w.x = cvt_pk_bf16(x0[0], x0[1]); w.y = cvt_pk_bf16(x0[2], x0[3]); w.z = cvt_pk_bf16(x1[0], x1[1]); w.w = cvt_pk_bf16(x1[2], x1[3]);
                    *(u32x4*)(xb + off) = w;
                    { const f32x4 sq = x0 * x0 + x1 * x1; ss += (sq[0] + sq[1]) + (sq[2] + sq[3]); } }
                ss += __shfl_xor(ss, 16); ss += __shfl_xor(ss, 32);
                if (fq == 0) atomicAdd(rowss_out + r, (rss_t)(ss * RSS_SCALE)); }
            asm volatile("" ::: "memory"); }
    }
};

struct EpiResidFinal {
    static constexpr bool PERM = true, AFTER_DRAIN = true;
    const bf16_t* xin; rss_t* rowss_out; unsigned* cnt; const float* gfin; float* y;
    __device__ __forceinline__ void fused(f32x4 (&acc)[2][2][4][2], const Unit& un, int wr, int wc, int fr, int fq, PG8_LAS unsigned char*, int, int) const {
        const int colb = un.pn * BM + wc * 32 + 8 * fq;
#pragma unroll
        for (int ai = 0; ai < 2; ++ai) {
            u32x4 xr[4][2];
#pragma unroll
            for (int m = 0; m < 4; ++m)
#pragma unroll
                for (int bj = 0; bj < 2; ++bj) xr[m][bj] = *(const u32x4*)(xin + (size_t)(un.pm * BM + ai * HALF + wr * 64 + m * 16 + fr) * 1024 + colb + bj * HALF);
#pragma unroll
            for (int m = 0; m < 4; ++m) { const int r = un.pm * BM + ai * HALF + wr * 64 + m * 16 + fr; float ss = 0.f;
#pragma unroll
                for (int bj = 0; bj < 2; ++bj) { const u32x4 xw = xr[m][bj];
                    const f32x4 x0 = (f32x4){bf_lo(xw.x), bf_hi(xw.x), bf_lo(xw.y), bf_hi(xw.y)} + acc[ai][bj][m][0], x1 = (f32x4){bf_lo(xw.z), bf_hi(xw.z), bf_lo(xw.w), bf_hi(xw.w)} + acc[ai][bj][m][1];
                    acc[ai][bj][m][0] = x0; acc[ai][bj][m][1] = x1;
                    { const f32x4 sq = x0 * x0 + x1 * x1; ss += (sq[0] + sq[1]) + (sq[2] + sq[3]); } }
                ss += __shfl_xor(ss, 16); ss += __shfl_xor(ss, 32);
                if (fq == 0) atomicAdd(rowss_out + r, (rss_t)(ss * RSS_SCALE)); }
            asm volatile("" ::: "memory"); }
        asm volatile("s_waitcnt vmcnt(0)" ::: "memory");
        __syncthreads();
        if (wr == 0 && wc == 0 && fr == 0 && fq == 0) { unsigned* c = cnt + 64 * un.pm; __hip_atomic_fetch_add(c, 1u, __ATOMIC_RELAXED, __HIP_MEMORY_SCOPE_AGENT);
            for (unsigned sp = 0; sp < (1u << 22); ++sp) { if (__hip_atomic_load(c, __ATOMIC_RELAXED, __HIP_MEMORY_SCOPE_AGENT) >= 4u) break; __builtin_amdgcn_s_sleep(2); } }
        __syncthreads();
        rss_t rsw[2][4]; float rsv[2][4];
#pragma unroll
        for (int ai = 0; ai < 2; ++ai)
#pragma unroll
            for (int m = 0; m < 4; ++m) rsw[ai][m] = __hip_atomic_load(rowss_out + (un.pm * BM + ai * HALF + wr * 64 + m * 16 + fr), __ATOMIC_RELAXED, __HIP_MEMORY_SCOPE_AGENT);
        __builtin_amdgcn_sched_barrier(0);
#pragma unroll
        for (int ai = 0; ai < 2; ++ai)
#pragma unroll
            for (int m = 0; m < 4; ++m) rsv[ai][m] = rs_of(rsw[ai][m]);
        f32x4 gv[2][2];
#pragma unroll
        for (int bj = 0; bj < 2; ++bj) { gv[bj][0] = *(const f32x4*)(gfin + colb + bj * HALF); gv[bj][1] = *(const f32x4*)(gfin + colb + bj * HALF + 4); }
#pragma unroll
        for (int ai = 0; ai < 2; ++ai)
#pragma unroll
            for (int m = 0; m < 4; ++m) { const size_t r = (size_t)(un.pm * BM + ai * HALF + wr * 64 + m * 16 + fr); const float rs = rsv[ai][m];
#pragma unroll
                for (int bj = 0; bj < 2; ++bj) { float* yp = y + r * 1024 + colb + bj * HALF; *(f32x4*)yp = acc[ai][bj][m][0] * rs * gv[bj][0]; *(f32x4*)(yp + 4) = acc[ai][bj][m][1] * rs * gv[bj][1]; } }
    }
};

template <bool HALFM> struct EpiFfnIn {
    static constexpr bool PERM = true, AFTER_DRAIN = false;
    const rss_t* rowss; bf16_t* act;
    const PG8_LAS float* rsl = nullptr; int rs_pm = -1;
    __device__ __forceinline__ void operator()(const f32x4 (&acc)[2][2][4][2], const Unit& un, int wr, int wc, int fr, int fq) const {
        const int colb = un.pn * HALF + wc * 32 + 8 * fq;
        rss_t rsw[2][4]; float rsv[2][4];
        if (un.pm == rs_pm) {
#pragma unroll
        for (int ai = 0; ai < (HALFM ? 1 : 2); ++ai)
#pragma unroll
            for (int m = 0; m < 4; ++m) rsv[ai][m] = rsl[un.rofs + ai * HALF + wr * 64 + m * 16 + fr];
        } else {
#pragma unroll
        for (int ai = 0; ai < (HALFM ? 1 : 2); ++ai)
#pragma unroll
            for (int m = 0; m < 4; ++m) rsw[ai][m] = rowss[un.pm * BM + un.rofs + ai * HALF + wr * 64 + m * 16 + fr];
#pragma unroll
        for (int ai = 0; ai < (HALFM ? 1 : 2); ++ai)
#pragma unroll
            for (int m = 0; m < 4; ++m) rsv[ai][m] = rs_of(rsw[ai][m]);
        }
#pragma unroll
        for (int ai = 0; ai < (HALFM ? 1 : 2); ++ai)
#pragma unroll
            for (int m = 0; m < 4; ++m) { const int r = un.pm * BM + un.rofs + ai * HALF + wr * 64 + m * 16 + fr; const float rs = rsv[ai][m];
                const float nrs = -1.44269504089f * rs, rs2 = rs * rs; f32x4 g0, g1;
                { const f32x4 G = acc[ai][0][m][0], U = acc[ai][1][m][0]; const f32x4 z = G * nrs; const f32x4 d = (f32x4){fast_exp2(z[0]), fast_exp2(z[1]), fast_exp2(z[2]), fast_exp2(z[3])} + 1.0f;
                  g0 = ((G * U) * rs2) * (f32x4){fast_rcp(d[0]), fast_rcp(d[1]), fast_rcp(d[2]), fast_rcp(d[3])}; }
                { const f32x4 G = acc[ai][0][m][1], U = acc[ai][1][m][1]; const f32x4 z = G * nrs; const f32x4 d = (f32x4){fast_exp2(z[0]), fast_exp2(z[1]), fast_exp2(z[2]), fast_exp2(z[3])} + 1.0f;
                  g1 = ((G * U) * rs2) * (f32x4){fast_rcp(d[0]), fast_rcp(d[1]), fast_rcp(d[2]), fast_rcp(d[3])}; }
                u32x4 w; w.x = cvt_pk_bf16(g0[0], g0[1]); w.y = cvt_pk_bf16(g0[2], g0[3]); w.z = cvt_pk_bf16(g1[0], g1[1]); w.w = cvt_pk_bf16(g1[2], g1[3]);
                *(u32x4*)(act + (size_t)r * 2816 + colb) = w; }
    }
};

constexpr float QSCALE = 0.08838834764831845f * 1.4426950408889634f;
struct EpiQkv {
    static constexpr bool PERM = false, AFTER_DRAIN = false;
    const rss_t* rowss; bf16_t* q; bf16_t* kb; bf16_t* vt; float* pk; float* pv; float* km;
    const PG8_LAS float* rsl = nullptr; int rs_pm = -1;
    __device__ __forceinline__ void operator()(const f32x4 (&acc)[2][2][4][2], const Unit& un, int wr, int wc, int fr, int fq) const {
        const int kind = un.pn < 4 ? 0 : (un.pn < 6 ? 1 : 2);
        float inv[4];
#pragma unroll
        for (int i = 0; i < 4; ++i) inv[i] = fast_exp2(-(float)(4 * fq + i) * (18.931568569324174f / 16.0f)) * 0.15915494309189535f;
        f32x4 cs[2][2];
#pragma unroll
        for (int bj = 0; bj < 2; ++bj)
#pragma unroll
            for (int n = 0; n < 2; ++n) cs[bj][n] = (f32x4){0.f, 0.f, 0.f, 0.f};
        rss_t rsw[2][4]; float rsv[2][4];
        if (un.pm == rs_pm) {
#pragma unroll
        for (int ai = 0; ai < 2; ++ai)
#pragma unroll
            for (int m = 0; m < 4; ++m) rsv[ai][m] = rsl[ai * HALF + wr * 64 + m * 16 + fr];
        } else {
#pragma unroll
        for (int ai = 0; ai < 2; ++ai)
#pragma unroll
            for (int m = 0; m < 4; ++m) rsw[ai][m] = rowss[un.pm * BM + ai * HALF + wr * 64 + m * 16 + fr];
#pragma unroll
        for (int ai = 0; ai < 2; ++ai)
#pragma unroll
            for (int m = 0; m < 4; ++m) rsv[ai][m] = rs_of(rsw[ai][m]);
        }
#pragma unroll
        for (int ai = 0; ai < 2; ++ai)
#pragma unroll
            for (int m = 0; m < 4; ++m) { const int r = un.pm * BM + ai * HALF + wr * 64 + m * 16 + fr; const float rs = rsv[ai][m]; const int t = r & 8191, b = r >> 13;
                float co[4], si[4];
                if (kind < 2 && wc == 0) {
#pragma unroll
                    for (int i = 0; i < 4; ++i) { float rev = (float)t * inv[i]; rev = rev - floorf(rev); co[i] = __builtin_amdgcn_cosf(rev); si[i] = __builtin_amdgcn_sinf(rev); } }
#pragma unroll
                for (int bj = 0; bj < 2; ++bj) { f32x4 v0 = acc[ai][bj][m][0] * rs, v1 = acc[ai][bj][m][1] * rs;
                    if (kind < 2 && wc == 0) {
#pragma unroll
                        for (int i = 0; i < 4; ++i) { const float x1 = v0[i], x2 = v1[i]; v0[i] = x1 * co[i] - x2 * si[i]; v1[i] = x2 * co[i] + x1 * si[i]; } }
                    const int d0 = wc * 32 + 4 * fq;
                    if (kind == 0) { const int h = un.pn * 2 + bj; bf16_t* qp = q + (size_t)r * 1024 + h * 128 + d0;
                        u32x2 w0, w1; w0.x = cvt_pk_bf16(v0[0] * QSCALE, v0[1] * QSCALE); w0.y = cvt_pk_bf16(v0[2] * QSCALE, v0[3] * QSCALE); w1.x = cvt_pk_bf16(v1[0] * QSCALE, v1[1] * QSCALE); w1.y = cvt_pk_bf16(v1[2] * QSCALE, v1[3] * QSCALE);
                        *(u32x2*)qp = w0; *(u32x2*)(qp + 16) = w1;
                    } else if (kind == 1) { const int g = (un.pn - 4) * 2 + bj; const size_t o = ((size_t)r * 4 + g) * 128 + d0;
                        *(f32x4*)(pk + o) = v0; *(f32x4*)(pk + o + 16) = v1;
                        u32x2 w0, w1; w0.x = cvt_pk_bf16(v0[0], v0[1]); w0.y = cvt_pk_bf16(v0[2], v0[3]); w1.x = cvt_pk_bf16(v1[0], v1[1]); w1.y = cvt_pk_bf16(v1[2], v1[3]);
                        *(u32x2*)(kb + o) = w0; *(u32x2*)(kb + o + 16) = w1;
                        cs[bj][0] += v0; cs[bj][1] += v1;
                    } else { const int g = (un.pn - 6) * 2 + bj; const size_t o = ((size_t)r * 4 + g) * 128 + d0;
                        *(f32x4*)(pv + o) = v0; *(f32x4*)(pv + o + 16) = v1;
                        bf16_t* vp = vt + ((size_t)(b * 4 + g) * 128 + d0) * 8192 + t;
#pragma unroll
                        for (int i = 0; i < 4; ++i) { vp[(size_t)i * 8192] = (bf16_t)(cvt_pk_bf16(v0[i], 0.f) & 0xffffu); vp[(size_t)(16 + i) * 8192] = (bf16_t)(cvt_pk_bf16(v1[i], 0.f) & 0xffffu); }
                    } } }
        if (kind == 1) {
            const int b = un.pm >> 5, blk = un.pm & 31;
#pragma unroll
            for (int bj = 0; bj < 2; ++bj)
#pragma unroll
                for (int n = 0; n < 2; ++n)
#pragma unroll
                    for (int i = 0; i < 4; ++i) { float s = cs[bj][n][i]; s += __shfl_xor(s, 1); s += __shfl_xor(s, 2); s += __shfl_xor(s, 4); s += __shfl_xor(s, 8);
                        if (fr == 0) unsafeAtomicAdd(km + (size_t)(b * 32 + blk) * 512 + ((un.pn - 4) * 2 + bj) * 128 + wc * 32 + 16 * n + 4 * fq + i, s * (1.0f / 256.0f)); }
        }
    }
};
struct NoHook { __device__ __forceinline__ void operator()() const {} };
template <class Epi, class Sched, bool ALIGN_EPI = false, bool SP2 = false, bool HALFM = false, class Hook = NoHook>
__device__ __forceinline__ void gemm_phase(PG8_LAS unsigned char* lds, const Gemm g, const Sched& S, const Epi& E, const Hook& hook = Hook()) {
    int tid_l = tid_of(g.wv); asm volatile("" : "+v"(tid_l));
    const int tid = tid_l, wid = __builtin_amdgcn_readfirstlane(tid >> 6), lane = tid & 63, wr = wid >> 2, wc = wid & 3, fr = lane & 15, fq = lane >> 4;
    const int K = g.K, nt = K / BK;
    unsigned voffA[2], voffB[2];
#pragma unroll
    for (int i = 0; i < 2; ++i) { int R, C; stage_rc(tid * 16 + i * 8192, R, C); const int Rb = Epi::PERM ? ((R & ~31) + perm32(R & 31)) : R;
        voffA[i] = (unsigned)(R * K + C) * 2u; voffB[i] = (unsigned)(Rb * K + C) * 2u; }
    const size_t kstep = (size_t)(BK * 2);
    const size_t hstep = (size_t)HALF * K * 2;
    const size_t tstep = 2 * hstep;
    const unsigned ldsw = (unsigned)wid * 1024u;
    const int aoff = lds_byte(wr * 64 + fr, fq * 8), boff = lds_byte(wc * 32 + fr, fq * 8);
#define PG8_SA(b, h) (((b) * 2 + (h)) * HTB)
#define PG8_SB(b, h) ((4 + (b) * 2 + (h)) * HTB)
#define PG8_STAGE(bufoff, gbase, voff) do { _Pragma("unroll") for (int _i = 0; _i < 2; ++_i) \
        __builtin_amdgcn_global_load_lds((const unsigned*)((const char*)(gbase) + (voff)[_i]), (PG8_LAS unsigned*)(lds + (bufoff) + ldsw + _i * 8192), 16, 0, 0); } while (0)
#define PG8_LDA(dst, b, h) do { _Pragma("unroll") for (int m = 0; m < 4; ++m) _Pragma("unroll") for (int k = 0; k < 2; ++k) dst[m][k] = *(const PG8_LAS bf16x8*)(lds + PG8_SA(b, h) + aoff + m * 2048 + k * 1024); } while (0)
#define PG8_LDB(dst, b, h) do { _Pragma("unroll") for (int n = 0; n < 2; ++n) _Pragma("unroll") for (int k = 0; k < 2; ++k) dst[n][k] = *(const PG8_LAS bf16x8*)(lds + PG8_SB(b, h) + boff + n * 2048 + k * 1024); } while (0)
#define PG8_MMA(ai, bj, At, Bt) do { __builtin_amdgcn_s_setprio(1); _Pragma("unroll") for (int m = 0; m < 4; ++m) _Pragma("unroll") for (int n = 0; n < 2; ++n) _Pragma("unroll") for (int k = 0; k < 2; ++k) \
        acc[ai][bj][m][n] = __builtin_amdgcn_mfma_f32_16x16x32_bf16(Bt[n][k], At[m][k], acc[ai][bj][m][n], 0, 0, 0); __builtin_amdgcn_s_setprio(0); } while (0)
#define PG8_WAIT_V(n) asm volatile("s_waitcnt vmcnt(" #n ")" ::: "memory")
#define PG8_WAIT_L(n) asm volatile("s_waitcnt lgkmcnt(" #n ")" ::: "memory")
#define PG8_BAR __builtin_amdgcn_s_barrier()
#define PG8_SCHED __builtin_amdgcn_sched_barrier(0)
    Unit cur, nxt; int ui = 0;
    if (!S.next(0, cur)) { hook(); return; }
    f32x4 acc[2][2][4][2];
#pragma unroll
    for (int a = 0; a < 2; ++a)
#pragma unroll
        for (int b = 0; b < 2; ++b)
#pragma unroll
            for (int m = 0; m < 4; ++m)
#pragma unroll
                for (int n = 0; n < 2; ++n) acc[a][b][m][n] = (f32x4){0.f, 0.f, 0.f, 0.f};
    bf16x8 At[4][2], B0[2][2], B1[2][2];
    const char* cA = (const char*)g.A + (size_t)cur.pm * tstep + (size_t)cur.rofs * K * 2; const char* cB = (const char*)g.Bt + (size_t)cur.pn * tstep;
    S.a_ready(cur);
    if constexpr (SP2) {
        PG8_STAGE(PG8_SB(0, 0), cB, voffB); PG8_STAGE(PG8_SB(0, 1), cB + hstep, voffB); PG8_STAGE(PG8_SA(0, 0), cA, voffA); PG8_STAGE(PG8_SA(0, 1), cA + hstep, voffA);
        hook();
        if (wr == 1) PG8_BAR;
        PG8_WAIT_V(2); PG8_BAR;
        PG8_STAGE(PG8_SB(1, 0), cB + kstep, voffB); PG8_STAGE(PG8_SA(1, 0), cA + kstep, voffA); PG8_STAGE(PG8_SB(1, 1), cB + hstep + kstep, voffB);
        PG8_WAIT_V(6); PG8_BAR;
    } else {
        PG8_STAGE(PG8_SB(0, 0), cB, voffB); PG8_STAGE(PG8_SA(0, 0), cA, voffA); PG8_STAGE(PG8_SB(0, 1), cB + hstep, voffB); PG8_STAGE(PG8_SA(0, 1), cA + hstep, voffA);
        hook();
        if (wr == 1) PG8_BAR;
        PG8_WAIT_V(4); PG8_BAR;
        PG8_STAGE(PG8_SB(1, 0), cB + kstep, voffB); PG8_STAGE(PG8_SA(1, 0), cA + kstep, voffA); PG8_STAGE(PG8_SB(1, 1), cB + hstep + kstep, voffB);
        PG8_WAIT_V(6); PG8_BAR;
    }
    for (;;) {
        const bool has_next = S.next(ui + 1, nxt);
        const char* nA = has_next ? (const char*)g.A + (size_t)nxt.pm * tstep + (size_t)nxt.rofs * K * 2 : cA; const char* nB = has_next ? (const char*)g.Bt + (size_t)nxt.pn * tstep : cB;
        for (int t = 0; t < nt; t += 2) {
            const bool last = (t == nt - 2);
            const char* a1 = cA + (size_t)(t + 1) * kstep;
            const char* a2 = last ? nA : cA + (size_t)(t + 2) * kstep; const char* b2 = last ? nB : cB + (size_t)(t + 2) * kstep;
            const char* a3 = a2 + kstep; const char* b3 = b2 + kstep;
            if (last && has_next) S.a_ready(nxt);
            if constexpr (SP2) {
            PG8_LDB(B0, 0, 0); PG8_LDB(B1, 0, 1); PG8_SCHED; PG8_LDA(At, 0, 0); PG8_STAGE(PG8_SA(1, 1), a1 + hstep, voffA);
            PG8_WAIT_V(8); PG8_WAIT_L(0); PG8_BAR; PG8_MMA(0, 0, At, B0); PG8_MMA(0, 1, At, B1); PG8_BAR; PG8_SCHED;
            if constexpr (!HALFM) PG8_LDA(At, 0, 1); PG8_STAGE(PG8_SB(0, 0), b2, voffB); PG8_STAGE(PG8_SB(0, 1), b2 + hstep, voffB); PG8_STAGE(PG8_SA(0, 0), a2, voffA);
            PG8_WAIT_V(8); PG8_WAIT_L(0); PG8_BAR; if constexpr (!HALFM) { PG8_MMA(1, 0, At, B0); PG8_MMA(1, 1, At, B1); } PG8_BAR; PG8_SCHED;
            PG8_LDB(B0, 1, 0); PG8_LDB(B1, 1, 1); PG8_SCHED; PG8_LDA(At, 1, 0); PG8_STAGE(PG8_SA(0, 1), a2 + hstep, voffA);
            PG8_WAIT_V(8); PG8_WAIT_L(0); PG8_BAR; PG8_MMA(0, 0, At, B0); PG8_MMA(0, 1, At, B1); PG8_BAR; PG8_SCHED;
            if constexpr (!HALFM) PG8_LDA(At, 1, 1); PG8_STAGE(PG8_SB(1, 0), b3, voffB); PG8_STAGE(PG8_SB(1, 1), b3 + hstep, voffB); PG8_STAGE(PG8_SA(1, 0), a3, voffA);
            PG8_WAIT_V(8); PG8_WAIT_L(0); PG8_BAR; if constexpr (!HALFM) { PG8_MMA(1, 0, At, B0); PG8_MMA(1, 1, At, B1); } PG8_BAR; PG8_SCHED;
            } else {
            PG8_LDB(B0, 0, 0); PG8_SCHED; PG8_LDA(At, 0, 0); PG8_STAGE(PG8_SA(1, 1), a1 + hstep, voffA);
            PG8_WAIT_L(8); PG8_BAR; PG8_WAIT_L(0); PG8_MMA(0, 0, At, B0); PG8_BAR; PG8_SCHED;
            PG8_LDB(B1, 0, 1); PG8_STAGE(PG8_SB(0, 0), b2, voffB);
            PG8_BAR; PG8_WAIT_L(0); PG8_MMA(0, 1, At, B1); PG8_BAR;
            PG8_LDA(At, 0, 1); PG8_STAGE(PG8_SA(0, 0), a2, voffA);
            PG8_BAR; PG8_WAIT_L(0); PG8_MMA(1, 0, At, B0); PG8_BAR; PG8_SCHED;
            PG8_STAGE(PG8_SB(0, 1), b2 + hstep, voffB);
            PG8_WAIT_V(6); PG8_BAR; PG8_MMA(1, 1, At, B1); PG8_BAR;
            PG8_LDB(B0, 1, 0); PG8_SCHED; PG8_LDA(At, 1, 0); PG8_STAGE(PG8_SA(0, 1), a2 + hstep, voffA);
            PG8_WAIT_L(8); PG8_BAR; PG8_WAIT_L(0); PG8_MMA(0, 0, At, B0); PG8_BAR; PG8_SCHED;
            PG8_LDB(B1, 1, 1); PG8_STAGE(PG8_SB(1, 0), b3, voffB);
            PG8_BAR; PG8_WAIT_L(0); PG8_MMA(0, 1, At, B1); PG8_BAR;
            PG8_LDA(At, 1, 1); PG8_STAGE(PG8_SA(1, 0), a3, voffA);
            PG8_BAR; PG8_WAIT_L(0); PG8_MMA(1, 0, At, B0); PG8_BAR; PG8_SCHED;
            PG8_STAGE(PG8_SB(1, 1), b3 + hstep, voffB);
            PG8_WAIT_V(6); PG8_BAR; PG8_MMA(1, 1, At, B1); PG8_BAR;
            }
        }
        if constexpr (ALIGN_EPI) { if (wr == 0) PG8_BAR; }
        if constexpr (!Epi::AFTER_DRAIN) { E(acc, cur, wr, wc, fr, fq); S.done(cur); }
        if (!has_next) break;
#pragma unroll
        for (int a = 0; a < 2; ++a)
#pragma unroll
            for (int b = 0; b < 2; ++b)
#pragma unroll
                for (int m = 0; m < 4; ++m)
#pragma unroll
                    for (int n = 0; n < 2; ++n) acc[a][b][m][n] = (f32x4){0.f, 0.f, 0.f, 0.f};
        cur = nxt; cA = nA; cB = nB; ++ui;
        if constexpr (ALIGN_EPI) { if (wr == 1) PG8_BAR; }
    }
    PG8_WAIT_V(0);
    if constexpr (!ALIGN_EPI) { if (wr == 0) PG8_BAR; }
    PG8_BAR;
    if constexpr (Epi::AFTER_DRAIN) { E.fused(acc, cur, wr, wc, fr, fq, lds, wid, lane); S.done(cur); }
#undef PG8_SA
#undef PG8_SB
#undef PG8_STAGE
#undef PG8_LDA
#undef PG8_LDB
#undef PG8_MMA
#undef PG8_WAIT_V
#undef PG8_WAIT_L
#undef PG8_BAR
#undef PG8_SCHED
}
}
#define GAS __attribute__((address_space(1)))
#define LAS __attribute__((address_space(3)))
typedef unsigned short bf16;
typedef unsigned v4u __attribute__((ext_vector_type(4)));
typedef float f32x4 __attribute__((ext_vector_type(4)));
typedef short bf16x8 __attribute__((ext_vector_type(8)));
typedef GAS unsigned gu32;
typedef GAS unsigned long long gu64;
#define RLX_AGENT __ATOMIC_RELAXED, __HIP_MEMORY_SCOPE_AGENT
#define LDS_WAIT() asm volatile("s_waitcnt lgkmcnt(0)" ::: "memory")
#define VM_WAIT() asm volatile("s_waitcnt vmcnt(0)" ::: "memory")
__device__ __forceinline__ unsigned long long rt() { return __builtin_amdgcn_s_memrealtime(); }
__device__ __forceinline__ unsigned f2bf(float f) { unsigned u = __builtin_bit_cast(unsigned, f); return (u + 0x7fffu + ((u >> 16) & 1u)) >> 16; }
__device__ __forceinline__ unsigned pk2(float lo, float hi) { return f2bf(lo) | (f2bf(hi) << 16); }

#define XB_TMO      128
#define XB_XCNT(j)  (256  + 64 * (j))
#define XB_XSUB(j)  (1280 + 64 * (j))
#define XB_XGEN(j)  (2304 + 64 * (j))
#define XB_TOP      3328
#define XB_TOPGEN   3392
#define XCD_BAR_WORDS 3456
#define XB_SPIN_CAP (1u << 18)

__device__ __forceinline__ unsigned xb_ld(unsigned* p)              { return __hip_atomic_load(p, __ATOMIC_RELAXED, __HIP_MEMORY_SCOPE_AGENT); }
__device__ __forceinline__ unsigned xb_add(unsigned* p, unsigned v) { return __hip_atomic_fetch_add(p, v, __ATOMIC_RELAXED, __HIP_MEMORY_SCOPE_AGENT); }
__device__ __forceinline__ unsigned xb_xcc_id() { return (unsigned)__builtin_amdgcn_s_getreg((3 << 11) | 20) & 0xFu; }
#define XB_SPIN(cond, bar) do { unsigned _sp = 0; while (cond) { __builtin_amdgcn_s_sleep(1); \
    if ((++_sp & 255u) == 0u) { if (xb_ld(&(bar)[XB_TMO])) break; if (_sp > XB_SPIN_CAP) { atomicAdd(&(bar)[XB_TMO], 1u); break; } } } } while (0)

__device__ __forceinline__ void xb_spin_while_eq(unsigned* p, unsigned old, unsigned* bar) {
    unsigned v0 = xb_ld(p); __builtin_amdgcn_s_sleep(8); unsigned v1 = xb_ld(p); __builtin_amdgcn_s_sleep(8); unsigned v2 = xb_ld(p); __builtin_amdgcn_s_sleep(8); unsigned v3 = xb_ld(p);
    for (unsigned sp = 0;;) {
        if (v0 != old) return; v0 = xb_ld(p); __builtin_amdgcn_s_sleep(8);
        if (v1 != old) return; v1 = xb_ld(p); __builtin_amdgcn_s_sleep(8);
        if (v2 != old) return; v2 = xb_ld(p); __builtin_amdgcn_s_sleep(8);
        if (v3 != old) return; v3 = xb_ld(p); __builtin_amdgcn_s_sleep(8);
        if ((++sp & 63u) == 0u) { if (xb_ld(&bar[XB_TMO])) return; if (sp > (XB_SPIN_CAP >> 2)) { atomicAdd(&bar[XB_TMO], 1u); return; } }
    }
}

struct XcdBarrier {
    unsigned* bar; unsigned x;
    volatile LAS unsigned* st;
};

__device__ __forceinline__ XcdBarrier xcd_barrier_post(unsigned* bar, volatile LAS unsigned* st) {
    XcdBarrier b; b.bar = bar; b.x = xb_xcc_id(); b.st = st;
    if (threadIdx.x == 0) (void)xb_add(&bar[XB_XCNT(b.x)], 1u);
    return b;
}
__device__ __forceinline__ void xcd_barrier_complete(unsigned* bar, unsigned x, unsigned& nloc, unsigned& nx) {
    const unsigned G = gridDim.x * gridDim.y * gridDim.z;
    unsigned sum, cnt, mine, sp = 0u;
    for (;;) {
        sum = 0u; cnt = 0u; mine = 0u;
        unsigned cv[16];
#pragma unroll
        for (unsigned j = 0; j < 16; ++j) cv[j] = xb_ld(&bar[XB_XCNT(j)]);
        __builtin_amdgcn_sched_barrier(0);
#pragma unroll
        for (unsigned j = 0; j < 16; ++j) { const unsigned c = cv[j]; sum += c; cnt += (c > 0u) ? 1u : 0u; mine = (j == x) ? c : mine; }
        if (sum == G) break;
        __builtin_amdgcn_s_sleep(1);
        if ((++sp & 255u) == 0u) { if (xb_ld(&bar[XB_TMO])) break; if (sp > XB_SPIN_CAP) { atomicAdd(&bar[XB_TMO], 1u); break; } }
    }
    nloc = mine > 0u ? mine : 1u; nx = cnt > 0u ? cnt : 1u;
}

__device__ __forceinline__ void xcd_barrier(const XcdBarrier& b, const bool thread0) {
    asm volatile("s_waitcnt vmcnt(0)" ::: "memory");
    __syncthreads();
    if (thread0) {
        unsigned* bar = b.bar;
        __builtin_amdgcn_s_waitcnt(0);
        unsigned nloc = b.st[0], nx = b.st[1];
        if (nloc == 0u) { xcd_barrier_complete(bar, b.x, nloc, nx); b.st[0] = nloc; b.st[1] = nx; }
        const unsigned old = xb_add(&bar[XB_XSUB(b.x)], 1u);
        const unsigned gen = old / nloc;
        if (old + 1u == (gen + 1u) * nloc) {
            __builtin_amdgcn_fence(__ATOMIC_RELEASE, "agent");
            asm volatile("s_waitcnt vmcnt(0)" ::: "memory");
            const unsigned og = xb_add(&bar[XB_TOP], 1u);
            const unsigned tg = og / nx;
            if (og + 1u == (tg + 1u) * nx) xb_add(&bar[XB_TOPGEN], 1u);
            else xb_spin_while_eq(&bar[XB_TOPGEN], tg, bar);
            __builtin_amdgcn_fence(__ATOMIC_ACQUIRE, "agent");
            xb_add(&bar[XB_XGEN(b.x)], 1u);
            asm volatile("s_waitcnt vmcnt(0)" ::: "memory");
        } else {
            xb_spin_while_eq(&bar[XB_XGEN(b.x)], gen, bar);
            __builtin_amdgcn_fence(__ATOMIC_ACQUIRE, "agent");
            asm volatile("s_waitcnt vmcnt(0)" ::: "memory");
        }
    }
    __syncthreads();
}

constexpr int NWAVES = 8, NTHR = 512;
constexpr int D = 1024, T = 8192, NB = 2, M = NB * T, SB = 32, FF = 2816, NF2 = 5632, NH = 8, HD = 128, KVH = 4, KVD = 512;
constexpr int NPG = 64, PAGE = 128;
constexpr int NBLK = 32;
constexpr float EPS = 1e-6f;
constexpr size_t O_YP = 0, O_YS = 16777216, O_PCONV = 16809984, O_PH = 16822272, O_PK = 16826368, O_PV = 25214976, O_SCONV = 33603584, O_SH = 33800192, O_SK = 33865728, O_SV = 33882112, O_END = 33898496;
constexpr size_t MiB = 1u << 20;
constexpr size_t WS_CTL = 0;
constexpr size_t WS_RSS = 1 * MiB;
constexpr size_t WS_RSSS = 2 * MiB + 256 * 1024;
constexpr size_t WS_KM = 2 * MiB + 512 * 1024;
constexpr size_t WS_CNT = 2 * MiB + 768 * 1024;
constexpr size_t WS_SUMG = 3 * MiB;
constexpr size_t ZERO_BYTES = 4 * MiB;
constexpr size_t WS_WRGIN = 4 * MiB;
constexpr size_t WS_WG = WS_WRGIN + 8 * MiB;
constexpr size_t WS_WRGOUT = WS_WG + 1 * MiB;
constexpr size_t WS_WFIN = WS_WRGOUT + 4 * MiB;
constexpr size_t WS_WFOUT = WS_WFIN + 44 * MiB;
constexpr size_t WS_WQKV = WS_WFOUT + 22 * MiB;
constexpr size_t WS_WO = WS_WQKV + 6 * MiB;
constexpr size_t WS_X = WS_WO + 4 * MiB;
constexpr size_t WS_XB = WS_X + 64 * MiB;
constexpr size_t WS_GATE = WS_XB + 32 * MiB;
constexpr size_t WS_U = WS_GATE + 32 * MiB;
constexpr size_t WS_HG = WS_U + 32 * MiB;
constexpr size_t WS_ACT = WS_HG + 32 * MiB;
constexpr size_t WS_Q = WS_ACT + 88 * MiB;
constexpr size_t WS_KB = WS_Q + 32 * MiB;
constexpr size_t WS_VT = WS_KB + 16 * MiB;
constexpr size_t WS_OB = WS_VT + 16 * MiB;
constexpr size_t WS_PARTO = WS_OB + 32 * MiB;
constexpr size_t WS_PARTML = WS_PARTO + 96 * MiB;
constexpr size_t WS_LIST = WS_PARTML + 3 * MiB;
constexpr size_t WS_SUMM = WS_LIST + 16 * MiB;
constexpr size_t WS_KMC = WS_SUMM + 1 * MiB;
constexpr size_t WS_S = WS_KMC + 2 * MiB;
constexpr size_t WS_XS = WS_S, WS_XSB = WS_S + 128 * 1024, WS_PROJS = WS_S + 192 * 1024, WS_HGS = WS_S + 448 * 1024, WS_ACTS = WS_S + 512 * 1024, WS_QS = WS_S + 704 * 1024, WS_OSB = WS_S + 832 * 1024;
constexpr size_t WS_END = WS_S + 1 * MiB;
constexpr size_t WS_DX = WS_END + 16 * MiB, WS_DXB = WS_DX + 64 * MiB, WS_DRSS = WS_DXB + 32 * MiB, WS_DKM = WS_DRSS + 1 * MiB, WS_NEED = WS_DKM + 1 * MiB;
constexpr int RING_OFF = 0, RING_BYTES = 131072;
constexpr int LDS_MISC_OFF = 144384;
constexpr int LDS_BYTES = 147456;
constexpr int CW_BAR = 4096;
constexpr int CW_FINP = 8192, CW_FINS = 8192 + 64 * 64;

typedef unsigned short bf16;
typedef pg8::bf16x8 bf16x8;
typedef float f32x16 __attribute__((ext_vector_type(16)));
typedef unsigned u32x2 __attribute__((ext_vector_type(2)));
using pg8::rss_t; using pg8::RSS_SCALE; using pg8::RSS_INV; using pg8::cvt_pk_bf16; using pg8::fast_exp2; using pg8::fast_rcp; using pg8::sigmoidf_; using pg8::gelu_tanh; using pg8::silu_;

struct Args { const void* in[25]; float* out; unsigned char* ws; int ph_lo, ph_hi; };
struct Frame { LAS unsigned char* lds; int tid, lane, wave, bid, G; unsigned char* ws; float* out; };
__device__ __forceinline__ Frame make_frame(const Args& args, LAS unsigned char* lds, int wave_s) {
    Frame F; int t = pg8::tid_of(wave_s); asm volatile("" : "+v"(t)); F.tid = t; F.lane = t & 63; F.wave = __builtin_amdgcn_readfirstlane(t >> 6);
    F.bid = blockIdx.x; F.G = gridDim.x; F.lds = lds;
    GAS unsigned char* w = (GAS unsigned char*)args.ws; asm volatile("" : "+s"(w)); F.ws = (unsigned char*)w; GAS float* o = (GAS float*)args.out; asm volatile("" : "+s"(o)); F.out = (float*)o; return F;
}

__device__ __forceinline__ float wave_sum(float v) {
#pragma unroll
    for (int o = 1; o < 64; o <<= 1) v += __shfl_xor(v, o);
    return v;
}
__device__ __forceinline__ float wave_max(float v) {
#pragma unroll
    for (int o = 1; o < 64; o <<= 1) v = fmaxf(v, __shfl_xor(v, o));
    return v;
}
__device__ __forceinline__ unsigned short f2bf1(float f) { return (unsigned short)(cvt_pk_bf16(f, 0.f) & 0xffffu); }
__device__ __forceinline__ float bf2f(unsigned short b) { return __uint_as_float(((unsigned)b) << 16); }
__device__ __forceinline__ float bflo(unsigned w) { return __uint_as_float(w << 16); }
__device__ __forceinline__ float bfhi(unsigned w) { return __uint_as_float(w & 0xffff0000u); }

struct P0Item { const float* W; const float* g; bf16* WT; int K, N, k0, n0, drow0; };
__device__ __forceinline__ void p0_item_make(P0Item& d, const float* W, const float* g, int K, int N, bf16* WT, int mode, int row_off, int item) {
    const int nblk = N / 32, kb = item / nblk, nb = item % nblk; d.W = W; d.g = g; d.WT = WT; d.K = K; d.N = N; d.k0 = 64 * kb; d.n0 = 32 * nb;
    int drow0 = row_off + d.n0;
    if (mode == 1) { const int c = d.n0 < FF ? d.n0 : d.n0 - FF; drow0 = 256 * (c >> 7) + (c & 127) + (d.n0 < FF ? 0 : 128); }
    d.drow0 = drow0;
}
__device__ __forceinline__ void p0_item_load(const P0Item& d, f32x4 (&wv)[8], int lane) {
#pragma unroll
    for (int i = 0; i < 8; ++i) wv[i] = *(const f32x4*)(d.W + (size_t)(d.k0 + 8 * i + (lane >> 3)) * d.N + d.n0 + 4 * (lane & 7));
}
__device__ __forceinline__ void p0_item_finish(const P0Item& d, const f32x4 (&wv)[8], LAS float* scr, int lane) {
#pragma unroll
    for (int i = 0; i < 8; ++i) { const int kk = 8 * i + (lane >> 3); f32x4 v = wv[i]; if (d.g) v = v * d.g[d.k0 + kk]; LAS float* sp = scr + kk * 33 + 4 * (lane & 7); sp[0] = v[0]; sp[1] = v[1]; sp[2] = v[2]; sp[3] = v[3]; }
    LDS_WAIT(); asm volatile("" ::: "memory");
    const int c = lane & 7;
#pragma unroll
    for (int j = 0; j < 4; ++j) { const int n = (lane >> 3) + 8 * j; const LAS float* s = scr + (8 * c) * 33 + n;
        v4u o; o.x = cvt_pk_bf16(s[0 * 33], s[1 * 33]); o.y = cvt_pk_bf16(s[2 * 33], s[3 * 33]); o.z = cvt_pk_bf16(s[4 * 33], s[5 * 33]); o.w = cvt_pk_bf16(s[6 * 33], s[7 * 33]);
        *(v4u*)(d.WT + (size_t)(d.drow0 + n) * d.K + d.k0 + 8 * c) = o; }
    LDS_WAIT(); asm volatile("" ::: "memory");
}
__device__ __forceinline__ void p0_row(const float* xrow, bf16* orow, rss_t* ss_out, int lane) {
    const f32x4* xr = (const f32x4*)xrow + lane; f32x4 v[4]; float s = 0.f;
#pragma unroll
    for (int j = 0; j < 4; ++j) { v[j] = xr[64 * j]; s += (v[j].x * v[j].x + v[j].y * v[j].y) + (v[j].z * v[j].z + v[j].w * v[j].w); }
    s = wave_sum(s);
    u32x2* o8 = (u32x2*)orow + lane;
#pragma unroll
    for (int j = 0; j < 4; ++j) { u32x2 w; w.x = cvt_pk_bf16(v[j].x, v[j].y); w.y = cvt_pk_bf16(v[j].z, v[j].w); o8[64 * j] = w; }
    if (lane == 0) *ss_out = (rss_t)(s * RSS_SCALE);
}
constexpr int I_RGIN = 16 * 64, I_G = 2 * 4, I_RGOUT = 16 * 32, I_FIN = 16 * 176, I_FOUT = 44 * 32, I_SQ = 16 * 32;
constexpr int WL_RG = I_RGIN + 16 * I_G + I_RGOUT + I_FIN + I_FOUT, WL_A0 = 3 * I_SQ + I_FIN + I_FOUT, WL_A1 = 2 * I_SQ + I_FIN + I_FOUT;
__host__ __device__ constexpr int WL_BASE(int l) { return l == 0 ? 0 : l == 1 ? WL_RG : l == 2 ? 2 * WL_RG : l == 3 ? 2 * WL_RG + WL_A0 : 2 * WL_RG + WL_A0 + WL_A1; }
#define P0_DECODE(D, it_) do { int r = (it_); const float* g_mix = (const float*)A.in[7]; const float* g_ffn = (const float*)A.in[8]; \
        const int l = r < WL_BASE(1) ? 0 : r < WL_BASE(2) ? 1 : r < WL_BASE(3) ? 2 : 3; r -= WL_BASE(l); \
        if (l < 2) { \
            if (r < I_RGIN) { p0_item_make(D, (const float*)A.in[9] + (size_t)l * 1024 * 2048, g_mix + l * 1024, 1024, 2048, (bf16*)(ws + WS_WRGIN) + (size_t)l * 2048 * 1024, 0, 0, r); break; } r -= I_RGIN; \
            if (r < 16 * I_G) { const int q = r / I_G, nb = q >> 1, sel = q & 1;   \
                p0_item_make(D, (const float*)A.in[sel ? 14 : 12] + (size_t)(l * 8 + nb) * 128 * 128, nullptr, 128, 128, (bf16*)(ws + WS_WG) + (size_t)(l * 8 + nb) * 256 * 128, 0, sel * 128, r % I_G); break; } r -= 16 * I_G; \
            if (r < I_RGOUT) { p0_item_make(D, (const float*)A.in[17] + (size_t)l * 1024 * 1024, nullptr, 1024, 1024, (bf16*)(ws + WS_WRGOUT) + (size_t)l * 1024 * 1024, 0, 0, r); break; } r -= I_RGOUT; \
        } else if (l == 2) { \
            if (r < I_SQ) { p0_item_make(D, (const float*)A.in[20], g_mix + 2 * 1024, 1024, 1024, (bf16*)(ws + WS_WQKV), 0, 0, r); break; } r -= I_SQ; \
            if (r < I_SQ) { p0_item_make(D, (const float*)A.in[19], (const float*)A.in[18], 1024, 1024, (bf16*)(ws + WS_WQKV), 0, 1024, r); break; } r -= I_SQ; \
            if (r < I_SQ) { p0_item_make(D, (const float*)A.in[21], nullptr, 1024, 1024, (bf16*)(ws + WS_WO), 0, 0, r); break; } r -= I_SQ; \
        } else { \
            if (r < I_SQ) { p0_item_make(D, (const float*)A.in[20] + (size_t)1024 * 1024, g_mix + 3 * 1024, 1024, 1024, (bf16*)(ws + WS_WQKV) + (size_t)2048 * 1024, 0, 0, r); break; } r -= I_SQ; \
            if (r < I_SQ) { p0_item_make(D, (const float*)A.in[21] + (size_t)1024 * 1024, nullptr, 1024, 1024, (bf16*)(ws + WS_WO) + (size_t)1024 * 1024, 0, 0, r); break; } r -= I_SQ; \
        } \
        if (r < I_FIN) { p0_item_make(D, (const float*)A.in[22] + (size_t)l * 1024 * NF2, g_ffn + l * 1024, 1024, NF2, (bf16*)(ws + WS_WFIN) + (size_t)l * NF2 * 1024, 1, 0, r); break; } r -= I_FIN; \
        p0_item_make(D, (const float*)A.in[23] + (size_t)l * FF * 1024, nullptr, FF, 1024, (bf16*)(ws + WS_WFOUT) + (size_t)l * 1024 * FF, 0, 0, r); } while (0)
__device__ __forceinline__ void conv_shadow(Frame& F, const Args& A, int lcur, int slot, int shift, int nunits) {
    if (lcur >= 3) return;
    unsigned char* ws = F.ws;
    const int nidle = F.G - nunits, rank = (F.bid - (shift % F.G) - nunits + 2 * F.G) % F.G;
    if (rank >= nidle) return;
    const int cap0 = (F.G - 64) * 8, cap1 = (F.G - 32) * 8, cap2 = (F.G - 88) * 8;
    const int off = slot == 0 ? 0 : slot == 1 ? cap0 : slot == 2 ? cap0 + cap1 : cap0 + cap1 + cap2;
    const int nl = WL_BASE(lcur + 2) - WL_BASE(lcur + 1);
    const int end = slot == 3 ? nl : (off + (slot == 0 ? cap0 : slot == 1 ? cap1 : cap2) < nl ? off + (slot == 0 ? cap0 : slot == 1 ? cap1 : cap2) : nl);
    LAS float* scr = (LAS float*)(F.lds + (F.wave < 3 ? 32768 + F.wave * 8448 : 98304 + (F.wave - 3) * 8448));
    for (int it = off + rank * 8 + F.wave; it < end; it += nidle * 8) { P0Item d; f32x4 wv[8]; P0_DECODE(d, WL_BASE(lcur + 1) + it); p0_item_load(d, wv, F.lane); p0_item_finish(d, wv, scr, F.lane); }
}
__device__ __forceinline__ void p0_prologue(Frame& F, const Args& A) {
    LAS float* scr = (LAS float*)(F.lds + F.wave * 16384);
    const int gw = F.bid * NWAVES + F.wave, NGW = F.G * NWAVES;
    unsigned char* ws = F.ws;
    constexpr int NITEMS = WL_BASE(1);
    { P0Item dc, dn; f32x4 wa[8], wb[8];
      if (gw < NITEMS) { P0_DECODE(dc, gw); p0_item_load(dc, wa, F.lane);
#pragma unroll 1
        for (int it = gw; it < NITEMS; it += 2 * NGW) {
            { const int itn = it + NGW < NITEMS ? it + NGW : it; P0_DECODE(dn, itn); p0_item_load(dn, wb, F.lane); }
            p0_item_finish(dc, wa, scr, F.lane);
            if (it + NGW >= NITEMS) break;
            { const int itn = it + 2 * NGW < NITEMS ? it + 2 * NGW : it + NGW; P0_DECODE(dc, itn); p0_item_load(dc, wa, F.lane); }
            p0_item_finish(dn, wb, scr, F.lane);
        } } }
#define P0_ROWPTRS(m_, xp, op, sp) do { if ((m_) < M) { xp = (const float*)A.in[0] + (size_t)(m_) * D; op = (bf16*)(ws + WS_XB) + (size_t)(m_) * D; sp = (rss_t*)(ws + WS_RSS) + (m_); } \
        else { xp = (const float*)A.in[1] + (size_t)((m_) - M) * D; op = (bf16*)(ws + WS_XSB) + (size_t)((m_) - M) * D; sp = (rss_t*)(ws + WS_RSSS) + ((m_) - M); } } while (0)
#pragma unroll 1
    for (int m = gw; m < M + SB; m += 2 * NGW) {
        const int m2 = m + NGW < M + SB ? m + NGW : m;
        const float* x0; bf16* o0; rss_t* s0; const float* x1; bf16* o1; rss_t* s1;
        P0_ROWPTRS(m, x0, o0, s0); P0_ROWPTRS(m2, x1, o1, s1);
        f32x4 v0[4], v1[4];
#pragma unroll
        for (int j = 0; j < 4; ++j) { v0[j] = *((const f32x4*)x0 + F.lane + 64 * j); v1[j] = *((const f32x4*)x1 + F.lane + 64 * j); }
        float q0 = 0.f, q1 = 0.f;
#pragma unroll
        for (int j = 0; j < 4; ++j) { q0 += (v0[j].x * v0[j].x + v0[j].y * v0[j].y) + (v0[j].z * v0[j].z + v0[j].w * v0[j].w); q1 += (v1[j].x * v1[j].x + v1[j].y * v1[j].y) + (v1[j].z * v1[j].z + v1[j].w * v1[j].w); }
        q0 = wave_sum(q0); q1 = wave_sum(q1);
#pragma unroll
        for (int j = 0; j < 4; ++j) { u32x2 w; w.x = cvt_pk_bf16(v0[j].x, v0[j].y); w.y = cvt_pk_bf16(v0[j].z, v0[j].w); *((u32x2*)o0 + F.lane + 64 * j) = w;
            u32x2 w2; w2.x = cvt_pk_bf16(v1[j].x, v1[j].y); w2.y = cvt_pk_bf16(v1[j].z, v1[j].w); *((u32x2*)o1 + F.lane + 64 * j) = w2; }
        if (F.lane == 0) { *s0 = (rss_t)(q0 * RSS_SCALE); *s1 = (rss_t)(q1 * RSS_SCALE); }
    }
#undef P0_ROWPTRS
}

template <int NG, int NSTEP, int BATCH>
__device__ __forceinline__ void sgemm_tile(Frame& F, const bf16* A, int lda, const bf16* Bt, int ldb, int n0a, int n0b, LAS float* part, LAS float* fin) {
    static_assert(NSTEP % BATCH == 0, "batches");
    constexpr int ksl = NSTEP * 16; const int r = F.lane & 31, h = F.lane >> 5;
    f32x16 acc[NG];
#pragma unroll
    for (int g = 0; g < NG; ++g)
#pragma unroll
        for (int i = 0; i < 16; ++i) acc[g][i] = 0.f;
    const bf16* ap = A + (size_t)r * lda + F.wave * ksl + 8 * h;
    const bf16* bp0 = Bt + (size_t)(n0a + r) * ldb + F.wave * ksl + 8 * h;
    const bf16* bp1 = Bt + (size_t)(n0b + r) * ldb + F.wave * ksl + 8 * h;
#pragma unroll
    for (int k0 = 0; k0 < NSTEP; k0 += BATCH) {
        bf16x8 av[BATCH], b0v[BATCH], b1v[BATCH];
#pragma unroll
        for (int k = 0; k < BATCH; ++k) { av[k] = *(const bf16x8*)(ap + 16 * (k0 + k)); b0v[k] = *(const bf16x8*)(bp0 + 16 * (k0 + k)); if (NG == 2) b1v[k] = *(const bf16x8*)(bp1 + 16 * (k0 + k)); }
#pragma unroll
        for (int k = 0; k < BATCH; ++k) { acc[0] = __builtin_amdgcn_mfma_f32_32x32x16_bf16(av[k], b0v[k], acc[0], 0, 0, 0);
            if (NG == 2) acc[NG - 1] = __builtin_amdgcn_mfma_f32_32x32x16_bf16(av[k], b1v[k], acc[NG - 1], 0, 0, 0); }
    }
#pragma unroll
    for (int g = 0; g < NG; ++g)
#pragma unroll
        for (int i = 0; i < 16; ++i) { const int row = (i & 3) + 8 * (i >> 2) + 4 * h; part[g * 16384 + (F.wave * 32 + row) * 32 + r] = acc[g][i]; }
    __syncthreads();
    for (int e = F.tid; e < NG * 1024; e += NTHR) { const int g = e >> 10, idx = e & 1023; float s = 0.f;
#pragma unroll
        for (int w = 0; w < 8; ++w) s += part[g * 16384 + w * 1024 + idx];
        fin[g * 32 * 33 + (idx >> 5) * 33 + (idx & 31)] = s; }
    __syncthreads();
}
enum { SG_RGIN = 0, SG_RESID = 1, SG_FFNIN = 2, SG_QKV = 3, SG_RESFIN = 4 };
struct SgArgs { const bf16* A; int lda; const bf16* Bt; int K; int nunits; const rss_t* rss_in; rss_t* rss_out; const float* xin; float* xout; bf16* xbout; float* fout; bf16* bout; float* sk; float* sv; unsigned* fcnt; const float* gfin; };
template <int KIND, int KDIM>
__device__ __forceinline__ void sgemm_units(Frame& F, const SgArgs& S, int shift) {
    LAS float* part = (LAS float*)(F.lds + 32768); LAS float* fin = (LAS float*)(F.lds + 131072);
    for (int su = (F.bid + F.G - (shift % F.G)) % F.G; su < S.nunits; su += F.G) {
        rss_t pre_r[2]; float pre_x[2];
#pragma unroll
        for (int k = 0; k < 2; ++k) { const int e = F.tid + NTHR * k, m = e >> 5, n = e & 31; pre_r[k] = (KIND != SG_RESID && KIND != SG_RESFIN) ? S.rss_in[m] : (rss_t)0; pre_x[k] = (KIND == SG_RESID || KIND == SG_RESFIN) ? S.xin[m * 1024 + 32 * su + n] : 0.f; }
        if (KIND == SG_FFNIN) { const int n0 = 256 * (su >> 2) + 32 * (su & 3); sgemm_tile<2, 8, 8>(F, S.A, S.lda, S.Bt, KDIM, n0, n0 + 128, part, fin); }
        else sgemm_tile<1, KDIM / 128, (KDIM == 1024 ? 8 : 11)>(F, S.A, S.lda, S.Bt, KDIM, 32 * su, 32 * su, part, fin);
#pragma unroll
        for (int k = 0; k < 2; ++k) { const int e = F.tid + NTHR * k, m = e >> 5, n = e & 31; const float v = fin[m * 33 + n];
            const float rs = __builtin_amdgcn_rsqf((float)pre_r[k] * RSS_INV + EPS);
            if (KIND == SG_RGIN) { S.fout[m * 2048 + 32 * su + n] = v * rs; }
            if (KIND == SG_RESID) { const int c = 32 * su + n; const float x = pre_x[k] + v; S.xout[m * 1024 + c] = x; S.xbout[m * 1024 + c] = f2bf1(x);
                float ss = x * x;
#pragma unroll
                for (int o = 1; o < 32; o <<= 1) ss += __shfl_xor(ss, o);
                if (n == 0) atomicAdd(S.rss_out + m, (rss_t)(ss * RSS_SCALE)); }
            if (KIND == SG_RESFIN) { const int c = 32 * su + n; const float x = pre_x[k] + v; pre_x[k] = x;
                float ss = x * x;
#pragma unroll
                for (int o = 1; o < 32; o <<= 1) ss += __shfl_xor(ss, o);
                if (n == 0) atomicAdd(S.rss_out + m, (rss_t)(ss * RSS_SCALE)); (void)c; }
            if (KIND == SG_FFNIN) { const float g = v * rs, u = fin[32 * 33 + m * 33 + n] * rs; S.bout[m * FF + 32 * su + n] = f2bf1(silu_(g) * u); }
            if (KIND == SG_QKV) { const int c = 32 * su + n; float x = v * rs;
                if (c < 1536 && (su & 3) == 0) {
                    const int d = n & 15; float rev = 8192.0f * fast_exp2(-(float)d * (18.931568569324174f / 16.0f)) * 0.15915494309189535f; rev = rev - floorf(rev);
                    const float co = __builtin_amdgcn_cosf(rev), si = __builtin_amdgcn_sinf(rev); const float other = fin[m * 33 + (n ^ 16)] * rs;
                    x = n < 16 ? x * co - other * si : x * co + other * si; }
                if (c < 1024) S.fout[m * 1024 + c] = x * pg8::QSCALE; else if (c < 1536) S.sk[m * 512 + (c - 1024)] = x; else S.sv[m * 512 + (c - 1536)] = x; }
        }
        if (KIND == SG_RESFIN) {
            asm volatile("s_waitcnt vmcnt(0)" ::: "memory"); __syncthreads();
            if (F.tid == 0) { __hip_atomic_fetch_add(S.fcnt, 1u, __ATOMIC_RELAXED, __HIP_MEMORY_SCOPE_AGENT);
                for (unsigned sp = 0; sp < (1u << 22); ++sp) { if (__hip_atomic_load(S.fcnt, __ATOMIC_RELAXED, __HIP_MEMORY_SCOPE_AGENT) >= (unsigned)S.nunits) break; __builtin_amdgcn_s_sleep(2); } }
            __syncthreads();
#pragma unroll
            for (int k = 0; k < 2; ++k) { const int e = F.tid + NTHR * k, m = e >> 5, n = e & 31, c = 32 * su + n;
                const float rs = __builtin_amdgcn_rsqf((float)__hip_atomic_load(S.rss_out + m, __ATOMIC_RELAXED, __HIP_MEMORY_SCOPE_AGENT) * RSS_INV + EPS);
                S.fout[m * 1024 + c] = pre_x[k] * rs * S.gfin[c]; }
        }
        __syncthreads();
    }
}

__device__ __forceinline__ bf16x8 ld_bf16x8_g(const bf16* p) { return *(const bf16x8*)p; }
__device__ __forceinline__ f32x4 mfma16(const bf16x8 a, const bf16x8 b, const f32x4 c) { return __builtin_amdgcn_mfma_f32_16x16x32_bf16(a, b, c, 0, 0, 0); }
__device__ __forceinline__ float one_minus_exp(float x) {
    if (x > -0.3f) { const float p = x * (1.0f + x * (0.5f + x * (1.0f / 6.0f + x * (1.0f / 24.0f + x * (1.0f / 120.0f + x * (1.0f / 720.0f + x * (1.0f / 5040.0f))))))); return -p; }
    return 1.0f - fast_exp2(1.44269504089f * x);
}
__device__ __forceinline__ float softplus_neg(float lam) { return (lam > 15.f) ? __expf(-lam) : ((lam < -15.f) ? -lam : __logf(1.0f + __expf(-lam))); }
__device__ __forceinline__ void lru_ab(float ga, float gi, float nba, float nbi, float cch2, float uc, float& a, float& bb) {
    const float r = fast_rcp(1.0f + fast_exp2(fmaf(ga, -1.44269504089f, nba))), ig = fast_rcp(1.0f + fast_exp2(fmaf(gi, -1.44269504089f, nbi)));
    a = fast_exp2(cch2 * r); bb = __builtin_amdgcn_sqrtf(fmaxf(fmaf(-a, a, 1.0f), 0.f)) * (ig * uc);
}
typedef float f32x2s __attribute__((ext_vector_type(2)));
__device__ __forceinline__ void lru_ab2(f32x2s ga, f32x2s gi, float nba, float nbi, float cch2, f32x2s uc, f32x2s& a, f32x2s& bb) {
    const f32x2s k = (f32x2s){-1.44269504089f, -1.44269504089f}, one = (f32x2s){1.0f, 1.0f};
    const f32x2s za = ga * k + (f32x2s){nba, nba}, zi = gi * k + (f32x2s){nbi, nbi};
    const f32x2s da = (f32x2s){fast_exp2(za.x), fast_exp2(za.y)} + one, di = (f32x2s){fast_exp2(zi.x), fast_exp2(zi.y)} + one;
    const f32x2s r = (f32x2s){fast_rcp(da.x), fast_rcp(da.y)}, ig = (f32x2s){fast_rcp(di.x), fast_rcp(di.y)};
    const f32x2s ex = r * (f32x2s){cch2, cch2};
    a = (f32x2s){fast_exp2(ex.x), fast_exp2(ex.y)};
    const f32x2s t = one - a * a;
    float t0, t1; asm("v_max_f32 %0, %1, 0" : "=v"(t0) : "v"(t.x)); asm("v_max_f32 %0, %1, 0" : "=v"(t1) : "v"(t.y));
    bb = (f32x2s){__builtin_amdgcn_sqrtf(t0), __builtin_amdgcn_sqrtf(t1)} * (ig * uc);
}
constexpr int SC_RAWU = 0, SC_RAWG = 17408, SC_AT = 33792, SC_UCF = 51200, SC_KRED = 90112, SC_CW = 98304, SC_OUT = 102400, SC_AT_PITCH = 272, SC_UCF_PITCH = 132;
#define SC_BARRIER() do { asm volatile("s_waitcnt lgkmcnt(0)" ::: "memory"); __builtin_amdgcn_s_barrier(); asm volatile("" ::: "memory"); } while (0)
template <int PASS>
__device__ __forceinline__ void scan_phase(Frame& F, const Args& A, int l) {
    unsigned char* ws = F.ws;
    const bf16* U = (const bf16*)(ws + WS_U); const bf16* GT = (const bf16*)(ws + WS_GATE); bf16* HG = (bf16*)(ws + WS_HG);
    typedef __attribute__((address_space(1))) unsigned long long gu64_t;
    gu64_t* SUMG = (gu64_t*)(ws + WS_SUMG) + (size_t)l * 256 * 256; const unsigned epoch = (unsigned)l + 1u;
    const int lane = F.lane, fr = lane & 15, fq = lane >> 4, w = F.wave, tid = F.tid;
    LAS unsigned char* lds = F.lds;
    for (int unit = F.bid; unit < 256; unit += F.G) {
        const int b = unit >> 7, cb = (unit >> 4) & 7, c = unit & 15, ch0 = cb * 128, chl = 16 * w + fr, ch = ch0 + chl;
        const float ba = ((const float*)A.in[13])[l * 1024 + ch], bi = ((const float*)A.in[15])[l * 1024 + ch];
        const float lam = ((const float*)A.in[16])[l * 1024 + ch];
        const float sp = softplus_neg(lam);
        const float cch2 = -8.0f * sp * 1.44269504089f, nba = -1.44269504089f * ba, nbi = -1.44269504089f * bi;
        bf16x8 Ba[4], Bi[4];
        { const bf16* wg = (const bf16*)(ws + WS_WG) + ((size_t)(l * 8 + cb) * 256 + chl) * 128 + 8 * fq;
#pragma unroll
          for (int ks = 0; ks < 4; ++ks) { Ba[ks] = ld_bf16x8_g(wg + 32 * ks); Bi[ks] = ld_bf16x8_g(wg + 128 * 128 + 32 * ks); } }
        const int cg = tid & 15;
        float hin = 0.f, Arun = 1.f, Brun = 0.f;
        const int tc0 = c * 512;
        const int ku = ((l * 2 + (PASS - 1)) * 256 + unit) & 1023, kb_ = ku >> 5, kj_ = ku & 31;
        const GAS float* ckp[2];
#pragma unroll
        for (int pg = 0; pg < 2; ++pg) ckp[pg] = (const GAS float*)A.in[2] + (size_t)((const int*)A.in[6])[kb_ * NPG + 2 * kj_ + pg] * PAGE * KVD + (size_t)(tid >> 7) * KVD + 4 * (tid & 127);
        f32x4 kreg[8], ksum = (f32x4){0.f, 0.f, 0.f, 0.f};
#define SC_KLOAD(st_) do { const GAS float* kp_ = ckp[(st_) >> 2] + (size_t)(32 * ((st_) & 3)) * KVD; _Pragma("unroll") for (int k = 0; k < 8; ++k) kreg[k] = *(const GAS f32x4*)(kp_ + (size_t)(4 * k) * KVD); } while (0)
#define SC_KACC() do { _Pragma("unroll") for (int k = 0; k < 8; ++k) ksum += kreg[k]; } while (0)
        v4u pu[3], pgt[2];
#define SC_PREFETCH(st_) do { const int t0_ = tc0 + (st_) * 64; \
            _Pragma("unroll") for (int k = 0; k < 3; ++k) { const int p = tid + 512 * k, pc = p < 67 * 16 ? p : 67 * 16 - 1;     \
                const int t = t0_ - 3 + (pc >> 4); pu[k] = *(const v4u*)(U + ((size_t)(b * T + (t > 0 ? t : 0))) * 1024 + ch0 + 8 * (pc & 15));     \
                if (t0_ == 0) { if (t < 0) pu[k] = (v4u){0u, 0u, 0u, 0u}; } }     \
            if (PASS == 2) { _Pragma("unroll") for (int k = 0; k < 2; ++k) { const int p = tid + 512 * k; pgt[k] = *(const v4u*)(GT + ((size_t)(b * T + t0_ + (p >> 4))) * 1024 + ch0 + 8 * (p & 15)); } } } while (0)
#define SC_STORE_OUT(tbase_) do { _Pragma("unroll") for (int k = 0; k < 2; ++k) { const int p = tid + 512 * k; const v4u ov = *(const LAS v4u*)(lds + SC_OUT + p * 16); \
            *(v4u*)(HG + ((size_t)(b * T + (tbase_) + (p >> 4))) * 1024 + ch0 + 8 * (p & 15)) = ov; } } while (0)
        float cwv[5] = {0.f, 0.f, 0.f, 0.f, 0.f};
        if (tid < 128) {
#pragma unroll
            for (int q = 0; q < 4; ++q) cwv[q] = ((const float*)A.in[10])[(l * 4 + q) * 1024 + ch0 + tid];
            cwv[4] = ((const float*)A.in[11])[l * 1024 + ch0 + tid]; }
        SC_PREFETCH(0); SC_KLOAD(0);
        if (PASS == 2 && c > 0) {
            unsigned long long ga[15], gb[15]; gu64_t* g0 = SUMG + (size_t)((b * 8 + cb) * 16) * 256 + chl;
            for (unsigned sp = 0; sp < (1u << 20); ++sp) { bool ok = true;
#pragma unroll
                for (int j = 0; j < 15; ++j) { gu64_t* g = g0 + (size_t)(j < c ? j : 0) * 256; ga[j] = __hip_atomic_load(g, __ATOMIC_RELAXED, __HIP_MEMORY_SCOPE_AGENT); gb[j] = __hip_atomic_load(g + 128, __ATOMIC_RELAXED, __HIP_MEMORY_SCOPE_AGENT); }
#pragma unroll
                for (int j = 0; j < 15; ++j) ok = ok && (j >= c || ((unsigned)(ga[j] >> 32) == epoch && (unsigned)(gb[j] >> 32) == epoch));
                if (__all(ok)) break; __builtin_amdgcn_s_sleep(2); }
#pragma unroll
            for (int j = 0; j < 15; ++j) if (j < c) hin = __uint_as_float((unsigned)ga[j]) * hin + __uint_as_float((unsigned)gb[j]); }
        __syncthreads();
        if (tid < 128) { LAS float* cwl = (LAS float*)(lds + SC_CW);
#pragma unroll
            for (int q = 0; q < 5; ++q) cwl[q * 128 + tid] = cwv[q]; }
        __syncthreads();
        for (int st = 0; st < 8; ++st) {
            const int t0 = tc0 + st * 64;
            SC_BARRIER();
            if (PASS == 2 && st > 0) { SC_STORE_OUT(t0 - 64); }
#pragma unroll
            for (int k = 0; k < 3; ++k) { const int p = tid + 512 * k; if (p < 67 * 16) *(LAS v4u*)(lds + SC_RAWU + p * 16) = pu[k]; }
            if (PASS == 2) {
#pragma unroll
                for (int k = 0; k < 2; ++k) { const int p = tid + 512 * k, t = p >> 4; *(LAS v4u*)(lds + SC_RAWG + ((16 * ((t >> 2) & 3) + 4 * (t >> 4) + (t & 3)) * 16 + (p & 15)) * 16) = pgt[k]; } }
            SC_BARRIER();
            { const int stn = st + 1 < 8 ? st + 1 : 7; SC_PREFETCH(stn); SC_KACC(); SC_KLOAD(stn); }
#pragma unroll 1
            for (int k = 0; k < 2; ++k) { const int t = (tid >> 4) + 32 * k; float uc[8];
                f32x2s u2[4];
                { const LAS f32x4* cb4 = (const LAS f32x4*)(lds + SC_CW + (4 * 128 + 8 * cg) * 4); const f32x4 b0 = cb4[0], b1 = cb4[1];
                  u2[0] = (f32x2s){b0[0], b0[1]}; u2[1] = (f32x2s){b0[2], b0[3]}; u2[2] = (f32x2s){b1[0], b1[1]}; u2[3] = (f32x2s){b1[2], b1[3]}; }
#pragma unroll
                for (int q = 0; q < 4; ++q) { const v4u rw = *(const LAS v4u*)(lds + SC_RAWU + ((t + q) * 16 + cg) * 16);
                    const LAS f32x4* cw4 = (const LAS f32x4*)(lds + SC_CW + (q * 128 + 8 * cg) * 4); const f32x4 w0 = cw4[0], w1 = cw4[1];
                    u2[0] += (f32x2s){w0[0], w0[1]} * (f32x2s){bflo(rw.x), bfhi(rw.x)}; u2[1] += (f32x2s){w0[2], w0[3]} * (f32x2s){bflo(rw.y), bfhi(rw.y)};
                    u2[2] += (f32x2s){w1[0], w1[1]} * (f32x2s){bflo(rw.z), bfhi(rw.z)}; u2[3] += (f32x2s){w1[2], w1[3]} * (f32x2s){bflo(rw.w), bfhi(rw.w)}; }
                uc[0] = u2[0].x; uc[1] = u2[0].y; uc[2] = u2[1].x; uc[3] = u2[1].y; uc[4] = u2[2].x; uc[5] = u2[2].y; uc[6] = u2[3].x; uc[7] = u2[3].y;
                v4u o; o.x = cvt_pk_bf16(uc[0], uc[1]); o.y = cvt_pk_bf16(uc[2], uc[3]); o.z = cvt_pk_bf16(uc[4], uc[5]); o.w = cvt_pk_bf16(uc[6], uc[7]);
                const int tr = 16 * ((t >> 2) & 3) + 4 * (t >> 4) + (t & 3);
                *(LAS v4u*)(lds + SC_AT + tr * SC_AT_PITCH + cg * 16) = o;
                LAS float* uf = (LAS float*)(lds + SC_UCF) + tr * SC_UCF_PITCH + 8 * cg;
                *(LAS f32x4*)uf = (f32x4){uc[0], uc[1], uc[2], uc[3]}; *(LAS f32x4*)(uf + 4) = (f32x4){uc[4], uc[5], uc[6], uc[7]}; }
            SC_BARRIER();
            float av[16], bv[16];
#pragma unroll
            for (int s = 0; s < 4; ++s) {
                f32x4 aa = (f32x4){0.f, 0.f, 0.f, 0.f}, ai = (f32x4){0.f, 0.f, 0.f, 0.f};
#pragma unroll
                for (int ks = 0; ks < 4; ++ks) { const bf16x8 af = *(const LAS bf16x8*)(lds + SC_AT + (16 * s + fr) * SC_AT_PITCH + ks * 64 + fq * 16); aa = mfma16(af, Ba[ks], aa); ai = mfma16(af, Bi[ks], ai); }
#pragma unroll
                for (int i = 0; i < 4; i += 2) { const LAS float* up = (const LAS float*)(lds + SC_UCF) + (16 * s + 4 * fq + i) * SC_UCF_PITCH + chl; const f32x2s ucv = (f32x2s){up[0], up[SC_UCF_PITCH]};
                    f32x2s a2, b2; lru_ab2((f32x2s){aa[i], aa[i + 1]}, (f32x2s){ai[i], ai[i + 1]}, nba, nbi, cch2, ucv, a2, b2);
                    av[4 * s + i] = a2.x; av[4 * s + i + 1] = a2.y; bv[4 * s + i] = b2.x; bv[4 * s + i + 1] = b2.y; }
            }
            float Ac = 1.f, Bc = 0.f;
#pragma unroll
            for (int i = 0; i < 16; ++i) { Bc = av[i] * Bc + bv[i]; Ac = av[i] * Ac; }
            { const float Ap = __shfl_up(Ac, 16), Bp = __shfl_up(Bc, 16); if (fq >= 1) { Bc = Ac * Bp + Bc; Ac = Ac * Ap; } }
            { const float Ap = __shfl_up(Ac, 32), Bp = __shfl_up(Bc, 32); if (fq >= 2) { Bc = Ac * Bp + Bc; Ac = Ac * Ap; } }
            const float Atot = __shfl(Ac, 48 + fr), Btot = __shfl(Bc, 48 + fr);
            if (PASS == 1) { Brun = Atot * Brun + Btot; Arun = Atot * Arun; }
            else {
                float Ae = __shfl_up(Ac, 16), Be = __shfl_up(Bc, 16); if (fq == 0) { Ae = 1.f; Be = 0.f; }
                float h = Ae * hin + Be;
#pragma unroll
                for (int i = 0; i < 16; ++i) { const int tl = 16 * fq + i; h = av[i] * h + bv[i];
                    const float gv = bf2f(((const LAS unsigned short*)(lds + SC_RAWG))[(16 * (i >> 2) + 4 * fq + (i & 3)) * 128 + chl]);
                    ((LAS unsigned short*)(lds + SC_OUT))[tl * 128 + chl] = f2bf1(h * gv);
                    if (c == 15 && st == 7 && fq == 3 && i == 15) F.out[O_PH + (size_t)(l * 2 + b) * 1024 + ch] = h; }
                hin = Atot * hin + Btot;
            }
        }
        if (PASS == 2) { SC_BARRIER(); SC_STORE_OUT(tc0 + 448); }
        if (PASS == 1 && fq == 0) { gu64_t* g = SUMG + (size_t)((b * 8 + cb) * 16 + c) * 256 + chl;
            __hip_atomic_store(g, ((unsigned long long)epoch << 32) | __float_as_uint(Arun), __ATOMIC_RELAXED, __HIP_MEMORY_SCOPE_AGENT);
            __hip_atomic_store(g + 128, ((unsigned long long)epoch << 32) | __float_as_uint(Brun), __ATOMIC_RELAXED, __HIP_MEMORY_SCOPE_AGENT); }
        { LAS f32x4* red = (LAS f32x4*)(lds + SC_KRED); red[(tid >> 7) * 128 + (tid & 127)] = ksum; __syncthreads();
          if (tid < 128) { const f32x4 t = (red[tid] + red[128 + tid]) + (red[256 + tid] + red[384 + tid]); *((f32x4*)((float*)(ws + WS_KMC) + (size_t)ku * 512) + tid) = t * (1.0f / 256.0f); } }
        __syncthreads();
    }
}
__device__ __forceinline__ void srg_step(Frame& F, const Args& A, int l) {
    unsigned char* ws = F.ws; LAS unsigned char* lds = F.lds;
    const float* PROJ = (const float*)(ws + WS_PROJS); bf16* HGS = (bf16*)(ws + WS_HGS);
    const int lane = F.lane, fr = lane & 15, fq = lane >> 4, w = F.wave, tid = F.tid;
    for (int cb = F.bid; cb < 8; cb += F.G) {
        const int ch0 = cb * 128, chl = 16 * w + fr, ch = ch0 + chl;
        __syncthreads();
        { const int b = tid >> 4, cg = tid & 15; const int c0 = ch0 + 8 * cg;
          const float* sc = (const float*)A.in[4] + (size_t)((l * SB + b) * 3) * 1024 + c0;
          float* sco = F.out + O_SCONV + (size_t)((l * SB + b) * 3) * 1024 + c0;
          const float* cwp = (const float*)A.in[10] + (size_t)l * 4 * 1024 + c0;
          f32x4 sv[3][2], un[2], wv[4][2], bv[2];
#pragma unroll
          for (int q = 0; q < 3; ++q) { sv[q][0] = *(const f32x4*)(sc + q * 1024); sv[q][1] = *(const f32x4*)(sc + q * 1024 + 4); }
          un[0] = *(const f32x4*)(PROJ + b * 2048 + 1024 + c0); un[1] = *(const f32x4*)(PROJ + b * 2048 + 1024 + c0 + 4);
#pragma unroll
          for (int q = 0; q < 4; ++q) { wv[q][0] = *(const f32x4*)(cwp + q * 1024); wv[q][1] = *(const f32x4*)(cwp + q * 1024 + 4); }
          bv[0] = *(const f32x4*)((const float*)A.in[11] + l * 1024 + c0); bv[1] = *(const f32x4*)((const float*)A.in[11] + l * 1024 + c0 + 4);
          f32x4 u0 = bv[0] + wv[0][0] * sv[0][0] + wv[1][0] * sv[1][0] + wv[2][0] * sv[2][0] + wv[3][0] * un[0];
          f32x4 u1 = bv[1] + wv[0][1] * sv[0][1] + wv[1][1] * sv[1][1] + wv[2][1] * sv[2][1] + wv[3][1] * un[1];
          *(f32x4*)sco = sv[1][0]; *(f32x4*)(sco + 4) = sv[1][1]; *(f32x4*)(sco + 1024) = sv[2][0]; *(f32x4*)(sco + 1024 + 4) = sv[2][1]; *(f32x4*)(sco + 2048) = un[0]; *(f32x4*)(sco + 2048 + 4) = un[1];
          v4u o; o.x = cvt_pk_bf16(u0[0], u0[1]); o.y = cvt_pk_bf16(u0[2], u0[3]); o.z = cvt_pk_bf16(u1[0], u1[1]); o.w = cvt_pk_bf16(u1[2], u1[3]);
          *(LAS v4u*)(lds + SC_AT + b * SC_AT_PITCH + cg * 16) = o;
          LAS float* uf = (LAS float*)(lds + SC_UCF) + b * SC_UCF_PITCH + 8 * cg;
          *(LAS f32x4*)uf = u0; *(LAS f32x4*)(uf + 4) = u1; }
        __syncthreads();
        const float ba = ((const float*)A.in[13])[l * 1024 + ch], bi = ((const float*)A.in[15])[l * 1024 + ch];
        const float lam = ((const float*)A.in[16])[l * 1024 + ch];
        const float sp = softplus_neg(lam); const float cch = -8.0f * sp;
        const bf16* wg = (const bf16*)(ws + WS_WG) + ((size_t)(l * 8 + cb) * 256 + chl) * 128 + 8 * fq;
        bf16x8 Ba[4], Bi[4]; float h0v[2][4], gtv[2][4];
#pragma unroll
        for (int ks = 0; ks < 4; ++ks) { Ba[ks] = ld_bf16x8_g(wg + 32 * ks); Bi[ks] = ld_bf16x8_g(wg + 128 * 128 + 32 * ks); }
#pragma unroll
        for (int s = 0; s < 2; ++s)
#pragma unroll
            for (int i = 0; i < 4; ++i) { const int b = 16 * s + 4 * fq + i; h0v[s][i] = ((const float*)A.in[5])[(size_t)(l * SB + b) * 1024 + ch]; gtv[s][i] = PROJ[b * 2048 + ch]; }
#pragma unroll
        for (int s = 0; s < 2; ++s) {
            f32x4 aa = (f32x4){0.f, 0.f, 0.f, 0.f}, ai = (f32x4){0.f, 0.f, 0.f, 0.f};
#pragma unroll
            for (int ks = 0; ks < 4; ++ks) { const bf16x8 af = *(const LAS bf16x8*)(lds + SC_AT + (16 * s + fr) * SC_AT_PITCH + ks * 64 + fq * 16); aa = mfma16(af, Ba[ks], aa); ai = mfma16(af, Bi[ks], ai); }
#pragma unroll
            for (int i = 0; i < 4; ++i) { const int b = 16 * s + 4 * fq + i; const float ucv = ((const LAS float*)(lds + SC_UCF))[b * SC_UCF_PITCH + chl]; float a, bb; lru_ab(aa[i], ai[i], -1.44269504089f * ba, -1.44269504089f * bi, 1.44269504089f * cch, ucv, a, bb);
                const float h = a * h0v[s][i] + bb;
                F.out[O_SH + (size_t)(l * SB + b) * 1024 + ch] = h;
                HGS[b * 1024 + ch] = f2bf1(h * gelu_tanh(gtv[s][i])); }
        }
    }
}

constexpr int AT_K = 0, AT_KP = 256, AT_V = 65536, AT_VP = 544, AT_MISC = 135168;
__device__ __forceinline__ void sel_phase(Frame& F, int a, bool dry) {
    unsigned char* ws = F.ws; LAS unsigned char* lds = F.lds;
    const bf16* Q = (const bf16*)(ws + WS_Q); const float* KM = (const float*)(ws + WS_KM);
    unsigned* CNT = (unsigned*)(ws + WS_CNT) + a * 256 + (dry ? 1024 : 0); unsigned* LIST = (unsigned*)(ws + (dry ? WS_END : WS_LIST));
    LAS unsigned* cnt = (LAS unsigned*)(lds + AT_MISC); LAS unsigned* base = cnt + 32;
    const int lane = F.lane, r32 = lane & 31, hh5 = lane >> 5, tid = F.tid;
    for (int u = F.bid; u < 248; u += F.G) {
        const int bg = u / 31, qt = u % 31 + 1, b = bg >> 2, g = bg & 3;
        __syncthreads();
        if (tid < 32) cnt[tid] = 0u;
        __syncthreads();
        bf16x8 kmh[8], kml[8];
        { const float* kp = KM + (size_t)(b * 32 + r32) * 512 + g * 128 + 8 * hh5; f32x4 kx[8][2];
#pragma unroll
          for (int ks = 0; ks < 8; ++ks) { kx[ks][0] = *(const f32x4*)(kp + 16 * ks); kx[ks][1] = *(const f32x4*)(kp + 16 * ks + 4); }
#pragma unroll
          for (int ks = 0; ks < 8; ++ks) { const f32x4 x0 = kx[ks][0], x1 = kx[ks][1]; float x[8] = {x0[0], x0[1], x0[2], x0[3], x1[0], x1[1], x1[2], x1[3]};
              unsigned hw[4], lw[4];
#pragma unroll
              for (int j = 0; j < 4; ++j) { hw[j] = cvt_pk_bf16(x[2 * j], x[2 * j + 1]); lw[j] = cvt_pk_bf16(x[2 * j] - bflo(hw[j]), x[2 * j + 1] - bfhi(hw[j])); }
              v4u hv = (v4u){hw[0], hw[1], hw[2], hw[3]}, lv = (v4u){lw[0], lw[1], lw[2], lw[3]};
              kmh[ks] = __builtin_bit_cast(bf16x8, hv); kml[ks] = __builtin_bit_cast(bf16x8, lv); } }
        int selj[2][3]; unsigned rank[2][3];
        const int nsel = qt < 3 ? qt : 3;
        bf16x8 qf8[2][8];
#pragma unroll
        for (int tk = 0; tk < 2; ++tk) { const int task = F.wave + 8 * tk, hh = task >> 3, s32 = task & 7, h = 2 * g + hh;
            const bf16* qp = Q + ((size_t)(b * T + 256 * qt + 32 * s32 + r32)) * 1024 + h * 128 + 8 * hh5;
#pragma unroll
            for (int ks = 0; ks < 8; ++ks) qf8[tk][ks] = ld_bf16x8_g(qp + 16 * ks); }
        __builtin_amdgcn_sched_barrier(0);
#pragma unroll
        for (int tk = 0; tk < 2; ++tk) {
            const int task = F.wave + 8 * tk, hh = task >> 3, s32 = task & 7;
            f32x16 acc;
#pragma unroll
            for (int i = 0; i < 16; ++i) acc[i] = 0.f;
#pragma unroll
            for (int ks = 0; ks < 8; ++ks) { acc = __builtin_amdgcn_mfma_f32_32x32x16_bf16(kmh[ks], qf8[tk][ks], acc, 0, 0, 0); acc = __builtin_amdgcn_mfma_f32_32x32x16_bf16(kml[ks], qf8[tk][ks], acc, 0, 0, 0); }
            float sc[16];
#pragma unroll
            for (int i = 0; i < 16; ++i) { const int blk = (i & 3) + 8 * (i >> 2) + 4 * hh5; sc[i] = blk < qt ? acc[i] : -3.0e38f; }
#pragma unroll
            for (int rd = 0; rd < 3; ++rd) {
                float bv = -3.4e38f; int bi = 64;
#pragma unroll
                for (int i = 0; i < 16; ++i) { const int blk = (i & 3) + 8 * (i >> 2) + 4 * hh5; if (sc[i] > bv) { bv = sc[i]; bi = blk; } }
                const float ov = __shfl_xor(bv, 32); const int oi = __shfl_xor(bi, 32);
                if (ov > bv || (ov == bv && oi < bi)) { bv = ov; bi = oi; }
                selj[tk][rd] = bi;
#pragma unroll
                for (int i = 0; i < 16; ++i) { const int blk = (i & 3) + 8 * (i >> 2) + 4 * hh5; if (blk == bi) sc[i] = -3.4e38f; }
            }
            if (lane < 32) {
#pragma unroll
                for (int sl = 0; sl < 3; ++sl) if (sl < nsel) rank[tk][sl] = atomicAdd((unsigned*)(cnt + selj[tk][sl]), 1u);
            }
        }
        __syncthreads();
        if (tid < 32) { const unsigned n = cnt[tid]; base[tid] = n ? atomicAdd(CNT + (b * 4 + g) * 32 + tid, n) : 0u; }
        __syncthreads();
        if (lane < 32) {
#pragma unroll
            for (int tk = 0; tk < 2; ++tk) { const int task = F.wave + 8 * tk, hh = task >> 3, s32 = task & 7; const unsigned t = (unsigned)(256 * qt + 32 * s32 + r32);
#pragma unroll
                for (int sl = 0; sl < 3; ++sl) if (sl < nsel) { const int j = selj[tk][sl]; LIST[((size_t)((b * 4 + g) * 32 + j)) * 16384 + base[j] + rank[tk][sl]] = t | ((unsigned)hh << 13) | ((unsigned)sl << 14); } }
        }
    }
}
__device__ __forceinline__ void load_kv_block(Frame& F, int b, int g, int j) {
    const bf16* KB = (const bf16*)(F.ws + WS_KB) + ((size_t)(b * T + 256 * j)) * 512 + g * 128;
    const bf16* VT = (const bf16*)(F.ws + WS_VT) + ((size_t)(b * 4 + g) * 128) * 8192 + 256 * j;
    v4u kr[8], vr[8];
#pragma unroll
    for (int k = 0; k < 8; ++k) { const int p = F.tid + 512 * k; kr[k] = *(const v4u*)(KB + (size_t)(p >> 4) * 512 + 8 * (p & 15)); }
#pragma unroll
    for (int k = 0; k < 8; ++k) { const int p = F.tid + 512 * k; vr[k] = *(const v4u*)(VT + (size_t)(p >> 5) * 8192 + 8 * (p & 31)); }
#pragma unroll
    for (int k = 0; k < 8; ++k) { const int p = F.tid + 512 * k, key = p >> 4; *(LAS v4u*)(F.lds + AT_K + key * AT_KP + (((p & 15) ^ ((key & 3) + 4 * ((key >> 3) & 3))) * 16)) = kr[k]; }
#pragma unroll
    for (int k = 0; k < 8; ++k) { const int p = F.tid + 512 * k; *(LAS v4u*)(F.lds + AT_V + (p >> 5) * AT_VP + (p & 31) * 16) = vr[k]; }
}
__device__ __forceinline__ void kv_block_fetch(Frame& F, int b, int g, int j, v4u (&kr)[8], v4u (&vr)[8]) {
    const bf16* KB = (const bf16*)(F.ws + WS_KB) + ((size_t)(b * T + 256 * j)) * 512 + g * 128;
    const bf16* VT = (const bf16*)(F.ws + WS_VT) + ((size_t)(b * 4 + g) * 128) * 8192 + 256 * j;
#pragma unroll
    for (int k = 0; k < 8; ++k) { const int p = F.tid + 512 * k; kr[k] = *(const v4u*)(KB + (size_t)(p >> 4) * 512 + 8 * (p & 15)); }
#pragma unroll
    for (int k = 0; k < 8; ++k) { const int p = F.tid + 512 * k; vr[k] = *(const v4u*)(VT + (size_t)(p >> 5) * 8192 + 8 * (p & 31)); }
}
__device__ __forceinline__ void kv_block_store(Frame& F, const v4u (&kr)[8], const v4u (&vr)[8]) {
#pragma unroll
    for (int k = 0; k < 8; ++k) { const int p = F.tid + 512 * k, key = p >> 4; *(LAS v4u*)(F.lds + AT_K + key * AT_KP + (((p & 15) ^ ((key & 3) + 4 * ((key >> 3) & 3))) * 16)) = kr[k]; }
#pragma unroll
    for (int k = 0; k < 8; ++k) { const int p = F.tid + 512 * k; *(LAS v4u*)(F.lds + AT_V + (p >> 5) * AT_VP + (p & 31) * 16) = vr[k]; }
}
#define AT_SCHED __builtin_amdgcn_sched_barrier(0)
typedef float f32x2_t __attribute__((ext_vector_type(2)));
__device__ __forceinline__ float vmax3(float a, float b, float c_) { float r; asm("v_max3_f32 %0, %1, %2, %3" : "=v"(r) : "v"(a), "v"(b), "v"(c_)); return r; }
__device__ __forceinline__ f32x2_t vpk_sub(f32x2_t a, f32x2_t b) { f32x2_t r; asm("v_pk_add_f32 %0, %1, %2 neg_lo:[0,1] neg_hi:[0,1]" : "=v"(r) : "v"(a), "v"(b)); return r; }
__device__ __forceinline__ float vmax2(float a, float b) { float r; asm("v_max_f32 %0, %1, %2" : "=v"(r) : "v"(a), "v"(b)); return r; }
template <bool CAUSAL, bool DB = true>
__device__ __forceinline__ void attn_scores(LAS const unsigned char* lds, const bf16x8 (&qf)[4], int qidx, int fr, int fq, float mfloor, float& m_out, float& l_out, bf16x8 (&pf)[8], bf16x8 (&fb)[2][8]) {
    f32x4 s[16];
    LAS const unsigned char* kb4[4];
#pragma unroll
    for (int ks = 0; ks < 4; ++ks) kb4[ks] = lds + AT_K + (8 * (fr >> 2) + (fr & 3)) * AT_KP + (((4 * ks + fq) ^ fr) * 16);
#define AT_LOADK(buf, p) do { _Pragma("unroll") for (int odd = 0; odd < 2; ++odd) _Pragma("unroll") for (int ks = 0; ks < 4; ++ks) \
        fb[buf][odd * 4 + ks] = *(const LAS bf16x8*)(kb4[ks] + (32 * (p) + 4 * odd) * AT_KP); } while (0)
    AT_LOADK(0, 0);
#pragma unroll
    for (int p = 0; p < 8; ++p) {
        if (DB && p + 1 < 8) AT_LOADK((p + 1) & 1, p + 1);
        AT_SCHED;
#pragma unroll
        for (int odd = 0; odd < 2; ++odd) { f32x4 acc = (f32x4){0.f, 0.f, 0.f, 0.f};
#pragma unroll
            for (int ks = 0; ks < 4; ++ks) acc = mfma16(fb[DB ? (p & 1) : 0][odd * 4 + ks], qf[ks], acc);
            if (CAUSAL) {
#pragma unroll
                for (int i = 0; i < 4; ++i) if (32 * p + 8 * fq + 4 * odd + i > qidx) acc[i] = -1.0e30f; }
            s[2 * p + odd] = acc; }
        AT_SCHED;
        if (!DB && p + 1 < 8) AT_LOADK(0, p + 1);
    }
#undef AT_LOADK
    LAS const unsigned char* vbase = lds + AT_V + fr * AT_VP + fq * 16;
#pragma unroll
    for (int dt = 0; dt < 8; ++dt) fb[0][dt] = *(const LAS bf16x8*)(vbase + 16 * dt * AT_VP);
    float m0 = mfloor, m1 = -3.0e38f;
#pragma unroll
    for (int t = 0; t < 16; ++t) { m0 = vmax3(m0, s[t][0], s[t][1]); m1 = vmax3(m1, s[t][2], s[t][3]); }
    float m = vmax2(m0, m1);
    m = vmax2(m, __shfl_xor(m, 16)); m = vmax2(m, __shfl_xor(m, 32));
    f32x4 l4 = (f32x4){0.f, 0.f, 0.f, 0.f}; const f32x2_t m2 = (f32x2_t){m, m};
#pragma unroll
    for (int t = 0; t < 16; ++t) { const f32x2_t d0 = vpk_sub((f32x2_t){s[t][0], s[t][1]}, m2), d1 = vpk_sub((f32x2_t){s[t][2], s[t][3]}, m2);
        const f32x4 e = (f32x4){fast_exp2(d0.x), fast_exp2(d0.y), fast_exp2(d1.x), fast_exp2(d1.y)}; s[t] = e; l4 += e; }
    float l = (l4[0] + l4[1]) + (l4[2] + l4[3]);
    l += __shfl_xor(l, 16); l += __shfl_xor(l, 32);
#pragma unroll
    for (int p = 0; p < 8; ++p) { v4u pw; pw.x = cvt_pk_bf16(s[2 * p][0], s[2 * p][1]); pw.y = cvt_pk_bf16(s[2 * p][2], s[2 * p][3]); pw.z = cvt_pk_bf16(s[2 * p + 1][0], s[2 * p + 1][1]); pw.w = cvt_pk_bf16(s[2 * p + 1][2], s[2 * p + 1][3]);
        pf[p] = __builtin_bit_cast(bf16x8, pw); }
    m_out = m; l_out = l;
}
template <bool DB, bool ZERO>
__device__ __forceinline__ void attn_pv(LAS const unsigned char* lds, const bf16x8 (&pf)[8], int fr, int fq, f32x4 (&o)[8], bf16x8 (&fb)[2][8]) {
    LAS const unsigned char* vbase = lds + AT_V + fr * AT_VP + fq * 16;
    if (ZERO) {
#pragma unroll
        for (int dt = 0; dt < 8; ++dt) o[dt] = (f32x4){0.f, 0.f, 0.f, 0.f}; }
#pragma unroll
    for (int p = 0; p < 8; ++p) {
        if (DB && p + 1 < 8) {
#pragma unroll
            for (int dt = 0; dt < 8; ++dt) fb[(p + 1) & 1][dt] = *(const LAS bf16x8*)(vbase + 16 * dt * AT_VP + (p + 1) * 64); }
        AT_SCHED;
#pragma unroll
        for (int dt = 0; dt < 8; ++dt) o[dt] = mfma16(fb[DB ? (p & 1) : 0][dt], pf[p], o[dt]);
        AT_SCHED;
        if (!DB && p + 1 < 8) {
#pragma unroll
            for (int dt = 0; dt < 8; ++dt) fb[0][dt] = *(const LAS bf16x8*)(vbase + 16 * dt * AT_VP + (p + 1) * 64); }
    }
}
template <bool CAUSAL>
__device__ __forceinline__ void attn_tile(LAS const unsigned char* lds, const bf16x8 (&qf)[4], int npair, int qidx, int fr, int fq, float& m_out, float& l_out, f32x4 (&o)[8]) {
    bf16x8 pf[8], fb[2][8]; (void)npair;
    attn_scores<CAUSAL>(lds, qf, qidx, fr, fq, -1.0e30f, m_out, l_out, pf, fb);
    attn_pv<true, true>(lds, pf, fr, fq, o, fb);
}
__device__ __forceinline__ void att1_phase(Frame& F, const Args& A, int a, bool stage_next, bool with_satt) {
    unsigned char* ws = F.ws; LAS unsigned char* lds = F.lds;
    const bf16* Q = (const bf16*)(ws + WS_Q); const unsigned* CNT = (const unsigned*)(ws + WS_CNT) + a * 256; const unsigned* LIST = (const unsigned*)(ws + WS_LIST);
    unsigned char* PARTO = (unsigned char*)(ws + WS_PARTO); float* PARTML = (float*)(ws + WS_PARTML);
    LAS int* pre = (LAS int*)(lds + AT_MISC);
    const int lane = F.lane, fr = lane & 15, fq = lane >> 4, tid = F.tid;
    const bool sa_on = with_satt && F.bid < SB * NH;
    const int sb_ = F.bid >> 3, sh_ = F.bid & 7, sg_ = sh_ >> 1, r32 = lane & 31, hw = tid >> 5;
    const GAS float* sck = (const GAS float*)A.in[2]; const GAS float* scv = (const GAS float*)A.in[3];
    LAS float* q_s = (LAS float*)(lds + AT_MISC + 2048); LAS float* sc_s = q_s + 128; LAS int* sel_s = (LAS int*)(sc_s + 32); LAS int* pg_s = sel_s + 4;
    LAS int* cnt_s = (LAS int*)(lds + AT_MISC + 3072);
    int craw = 0; if (tid < 256) craw = (int)CNT[tid];
    const int cchunks = (craw + 127) >> 7;
    float qv_ = 0.f; f32x4 kg0 = (f32x4){0.f, 0.f, 0.f, 0.f}, kg1 = kg0;
    if (sa_on) { const float* QS = (const float*)(ws + WS_QS); const float* KMC = (const float*)(ws + WS_KMC);
        if (tid < 128) qv_ = QS[sb_ * 1024 + sh_ * 128 + tid];
        const float* kp = KMC + (size_t)(sb_ * 32 + (tid >> 4)) * 512 + sg_ * 128 + 8 * (tid & 15); kg0 = *(const f32x4*)kp; kg1 = *(const f32x4*)(kp + 4); }
    __builtin_amdgcn_sched_barrier(0);
    __syncthreads();
    if (tid < 8) pg_s[tid] = 0;
    int cscan = cchunks;
#pragma unroll
    for (int o = 1; o < 64; o <<= 1) { const int y = __shfl_up(cscan, o); if (lane >= o) cscan += y; }
    if (tid < 256 && lane == 63) pre[260 + F.wave] = cscan;
    if (tid < 256) cnt_s[tid] = craw;
    if (sa_on && tid < 128) q_s[tid] = qv_;
    __syncthreads();
    if (tid < 256) { int base = 0;
#pragma unroll
        for (int w = 0; w < 3; ++w) if (w < F.wave) base += pre[260 + w];
        pre[tid + 1] = base + cscan; }
    if (tid == 0) pre[0] = 0;
    if (sa_on) {
        const int* pt = (const int*)A.in[6];
        { const int j = tid >> 4, dg = tid & 15; float s = 0.f;
#pragma unroll
          for (int i = 0; i < 4; ++i) s += q_s[8 * dg + i] * kg0[i];
#pragma unroll
          for (int i = 0; i < 4; ++i) s += q_s[8 * dg + 4 + i] * kg1[i];
          s += __shfl_xor(s, 1); s += __shfl_xor(s, 2); s += __shfl_xor(s, 4); s += __shfl_xor(s, 8);
          if (dg == 0) sc_s[j] = s; }
        __syncthreads();
        if (tid < 32) { const float mine = sc_s[tid]; int rk = 0;
#pragma unroll
            for (int i = 0; i < 32; ++i) { const float ov = sc_s[i]; rk += (ov > mine || (ov == mine && i < tid)) ? 1 : 0; }
            if (rk < 3) sel_s[rk] = tid; }
        __syncthreads();
        if (tid < 6) pg_s[tid] = pt[sb_ * NPG + 2 * sel_s[tid >> 1] + (tid & 1)];
    }
    __syncthreads();
    f32x4 sq4 = (f32x4){0.f, 0.f, 0.f, 0.f}, sacc = (f32x4){0.f, 0.f, 0.f, 0.f}; float sm = -1.0e30f, sl_ = 0.f; int ski = sa_on ? 0 : 48;
    if (sa_on) sq4 = *(const LAS f32x4*)(q_s + 4 * r32);
    f32x4 skb[2], svb[2];
#define SA_LOADN(KB_, VB_, N_, BASE_) do { _Pragma("unroll") for (int j_ = 0; j_ < (N_); ++j_) { const int i_ = (BASE_) + j_ < 48 ? (BASE_) + j_ : 47; \
        const size_t o_ = ((size_t)(pg_s[i_ >> 3] * PAGE + hw + 16 * (i_ & 7)) * 4 + sg_) * 128 + 4 * r32; KB_[j_] = *(const GAS f32x4*)(sck + o_); VB_[j_] = *(const GAS f32x4*)(scv + o_); } } while (0)
#define SA_FOLDN(KB_, VB_, N_) do { _Pragma("unroll") for (int j_ = 0; j_ < (N_); ++j_) { float s_ = sq4[0] * KB_[j_][0] + sq4[1] * KB_[j_][1] + sq4[2] * KB_[j_][2] + sq4[3] * KB_[j_][3]; \
        s_ += __shfl_xor(s_, 1); s_ += __shfl_xor(s_, 2); s_ += __shfl_xor(s_, 4); s_ += __shfl_xor(s_, 8); s_ += __shfl_xor(s_, 16); \
        if (ski + j_ < 48) { const float mn_ = fmaxf(sm, s_), cs_ = fast_exp2(sm - mn_), p_ = fast_exp2(s_ - mn_); sl_ = sl_ * cs_ + p_; sacc = sacc * cs_ + VB_[j_] * p_; sm = mn_; } } ski += (N_); } while (0)
#define SA_ISSUE() SA_LOADN(skb, svb, 2, ski)
#define SA_CONSUME() do { float s0_ = sq4[0] * skb[0][0] + sq4[1] * skb[0][1] + sq4[2] * skb[0][2] + sq4[3] * skb[0][3], s1_ = sq4[0] * skb[1][0] + sq4[1] * skb[1][1] + sq4[2] * skb[1][2] + sq4[3] * skb[1][3]; \
        s0_ += __shfl_xor(s0_, 1); s1_ += __shfl_xor(s1_, 1); s0_ += __shfl_xor(s0_, 2); s1_ += __shfl_xor(s1_, 2); s0_ += __shfl_xor(s0_, 4); s1_ += __shfl_xor(s1_, 4); \
        s0_ += __shfl_xor(s0_, 8); s1_ += __shfl_xor(s1_, 8); s0_ += __shfl_xor(s0_, 16); s1_ += __shfl_xor(s1_, 16); \
        const float a0_ = ski < 48 ? s0_ : -3.0e38f, a1_ = ski + 1 < 48 ? s1_ : -3.0e38f; const float mn_ = vmax3(sm, a0_, a1_); \
        const float cs_ = fast_exp2(sm - mn_), p0_ = fast_exp2(a0_ - mn_), p1_ = fast_exp2(a1_ - mn_); \
        sl_ = sl_ * cs_ + (p0_ + p1_); sacc = sacc * cs_ + (svb[0] * p0_ + svb[1] * p1_); sm = mn_; ski += 2; } while (0)
    const int NI = pre[256];
    const int vb = (F.G & 7) == 0 ? (F.bid & 7) * (F.G >> 3) + (F.bid >> 3) : F.bid;
    const int i0 = (int)(((long)vb * NI) / F.G), i1 = (int)(((long)(vb + 1) * NI) / F.G);
    int li = 0;
    for (int it = i0; it < i1;) {
        while (pre[li + 1] <= it) ++li;
        const int seg_end = pre[li + 1] < i1 ? pre[li + 1] : i1;
        const int b = li >> 7, g = (li >> 5) & 3, j = li & 31, n = cnt_s[li];
        const int r0 = (it - pre[li]) * 128, r1t = (seg_end - pre[li]) * 128, r1 = r1t < n ? r1t : n, ng = (r1 - r0 + 15) >> 4;
        const unsigned* LL = LIST + (size_t)li * 16384;
#define A1_ENTRY(gi_) LL[(r0 + 16 * (gi_) + fr) < r1 ? (r0 + 16 * (gi_) + fr) : (r0 + 16 * (gi_))]
#define A1_LOADQ(dst, ent_) do { const bf16* qp_ = Q + ((size_t)(b * T + (int)((ent_) & 8191u))) * 1024 + (2 * g + (int)(((ent_) >> 13) & 1u)) * 128 + 8 * fq; \
        _Pragma("unroll") for (int ks = 0; ks < 4; ++ks) dst[ks] = ld_bf16x8_g(qp_ + 32 * ks); } while (0)
        int gi = F.wave; bf16x8 qf[4];
        unsigned ent_c, ent_n;
        { v4u kr[8], vr[8]; f32x4 pka[4], pva[4];
          { const int g0 = gi < ng ? gi : 0, g1 = gi + 8 < ng ? gi + 8 : g0; ent_c = A1_ENTRY(g0); ent_n = A1_ENTRY(g1); }
          AT_SCHED;
          kv_block_fetch(F, b, g, j, kr, vr);
          AT_SCHED;
          A1_LOADQ(qf, ent_c);
          SA_LOADN(pka, pva, 4, ski);
          __syncthreads();
          kv_block_store(F, kr, vr); __syncthreads();
          SA_FOLDN(pka, pva, 4); }
        if (F.wave & 4) __builtin_amdgcn_s_sleep(32);
        if (F.wave < ng) {
#pragma unroll 1
            for (; gi < ng; gi += 8) {
                const int g2 = gi + 16 < ng ? gi + 16 : gi; const unsigned ent_nn = A1_ENTRY(g2);
                SA_ISSUE();
                const bool valid = (r0 + 16 * gi + fr) < r1;
                const int t = ent_c & 8191, hh = (ent_c >> 13) & 1, sl = ent_c >> 14, h = 2 * g + hh; const size_t row = (size_t)(b * T + t);
                float m, l; f32x4 o[8];
                { bf16x8 pf[8], fb[2][8]; attn_scores<false, false>(lds, qf, 0, fr, fq, -1.0e30f, m, l, pf, fb);
                  AT_SCHED;
                  A1_LOADQ(qf, ent_n);
                  attn_pv<false, true>(lds, pf, fr, fq, o, fb); }
                const float inv = __builtin_amdgcn_rcpf(l); const size_t pb = (row * 8 + h) * 3 + sl;
                unsigned char* po = valid ? PARTO + pb * 128 + 32 * fq : (unsigned char*)(ws + WS_END) + 32 * lane; float* pm = valid ? PARTML + pb * 2 : (float*)(ws + WS_END + 65536) + 2 * lane;
                unsigned w8[8];
#pragma unroll
                for (int dt = 0; dt < 8; ++dt) { const f32x4 on = o[dt] * inv; int w_ = __builtin_amdgcn_cvt_pk_fp8_f32(on[0], on[1], 0, false); w_ = __builtin_amdgcn_cvt_pk_fp8_f32(on[2], on[3], w_, true); w8[dt] = (unsigned)w_; }
                *(v4u*)po = (v4u){w8[0], w8[1], w8[2], w8[3]}; *(v4u*)(po + 16) = (v4u){w8[4], w8[5], w8[6], w8[7]};
                if (fq == 0) { f32x2_t ml; ml.x = m; ml.y = l; *(f32x2_t*)pm = ml; }
                SA_CONSUME();
                ent_c = ent_n; ent_n = ent_nn;
            }
        }
#undef A1_ENTRY
#undef A1_LOADQ
        it = seg_end;
    }
    if (ski < 48) { f32x4 tka[8], tva[8], tkb[8], tvb[8];
        SA_LOADN(tka, tva, 8, ski);
#pragma unroll 1
        for (;;) { SA_LOADN(tkb, tvb, 8, ski + 8); SA_FOLDN(tka, tva, 8); if (ski >= 48) break;
                   SA_LOADN(tka, tva, 8, ski + 8); SA_FOLDN(tkb, tvb, 8); if (ski >= 48) break; } }
#undef SA_ISSUE
#undef SA_CONSUME
#undef SA_LOADN
#undef SA_FOLDN
    if (sa_on) {
        LAS float* comb = (LAS float*)lds;
        const float* sk = F.out + O_SK; const float* sv = F.out + O_SV; bf16* OSB = (bf16*)(ws + WS_OSB);
        __syncthreads();
        *(LAS f32x4*)(comb + hw * 132 + 4 + 4 * r32) = sacc; if (r32 == 0) { comb[hw * 132] = sm; comb[hw * 132 + 1] = sl_; }
        if (hw == 0) { const f32x4 k4 = *((const f32x4*)(sk + (size_t)(sb_ * 4 + sg_) * 128) + r32); float s = sq4[0] * k4[0] + sq4[1] * k4[1] + sq4[2] * k4[2] + sq4[3] * k4[3];
            s += __shfl_xor(s, 1); s += __shfl_xor(s, 2); s += __shfl_xor(s, 4); s += __shfl_xor(s, 8); s += __shfl_xor(s, 16);
            if (r32 == 0) comb[16 * 132] = s; }
        __syncthreads();
        if (tid < 128) { const float ss = comb[16 * 132]; float M_ = ss;
#pragma unroll
            for (int i = 0; i < 16; ++i) M_ = fmaxf(M_, comb[i * 132]);
            const float es = fast_exp2(ss - M_); float den = es, num = es * sv[(size_t)(sb_ * 4 + sg_) * 128 + tid];
#pragma unroll
            for (int i = 0; i < 16; ++i) { const float e = fast_exp2(comb[i * 132] - M_); den += e * comb[i * 132 + 1]; num += e * comb[i * 132 + 4 + tid]; }
            OSB[sb_ * 1024 + sh_ * 128 + tid] = f2bf1(num * __builtin_amdgcn_rcpf(den)); }
    }
    if (stage_next && F.bid < 256) {
        __syncthreads(); load_kv_block(F, F.bid >> 7, (F.bid >> 5) & 3, F.bid & 31); }
}
__device__ __forceinline__ void att2_phase(Frame& F, bool staged) {
    unsigned char* ws = F.ws; LAS unsigned char* lds = F.lds;
    const bf16* Q = (const bf16*)(ws + WS_Q); const unsigned char* PARTO = (const unsigned char*)(ws + WS_PARTO); const float* PARTML = (const float*)(ws + WS_PARTML); bf16* OB = (bf16*)(ws + WS_OB);
    const int lane = F.lane, fr = lane & 15, fq = lane >> 4;
    for (int u = F.bid; u < 256; u += F.G) {
        const int b = u >> 7, g = (u >> 5) & 3, qb = u & 31;
        const int nsl = qb < 3 ? qb : 3;
        bf16x8 qf[4]; f32x2_t ml[3], mln[3];
#define A2_ROW(k_) ((size_t)(b * T + 256 * qb + 16 * ((F.wave + 8 * (k_)) & 15) + fr))
#define A2_HEAD(k_) (2 * g + ((F.wave + 8 * (k_)) >> 4))
#define A2_LOAD(QD, MLD, k_) do { const size_t row_ = A2_ROW(k_); const int h_ = A2_HEAD(k_); const bf16* qp_ = Q + row_ * 1024 + h_ * 128 + 8 * fq; \
        _Pragma("unroll") for (int ks = 0; ks < 4; ++ks) QD[ks] = ld_bf16x8_g(qp_ + 32 * ks); \
        _Pragma("unroll") for (int sl = 0; sl < 3; ++sl) { MLD[sl].x = -1.0e30f; MLD[sl].y = 0.f; if (sl < nsl) MLD[sl] = *(const f32x2_t*)(PARTML + ((row_ * 8 + h_) * 3 + sl) * 2); } } while (0)
        A2_LOAD(qf, ml, 0);
        if (!(staged && u == F.bid)) { __syncthreads(); load_kv_block(F, b, g, qb); }
        __syncthreads();
        if (F.wave & 4) __builtin_amdgcn_s_sleep(32);
#pragma unroll 1
        for (int k = 0; k < 4; ++k) {
            const size_t row = A2_ROW(k); const int h = A2_HEAD(k), qidx = 16 * ((F.wave + 8 * k) & 15) + fr;
            v4u pw[3][2]; const unsigned char* po = PARTO + ((row * 8 + h) * 3) * 128 + 32 * fq;
#pragma unroll
            for (int sl = 0; sl < 3; ++sl) if (sl < nsl) { pw[sl][0] = *(const v4u*)(po + sl * 128); pw[sl][1] = *(const v4u*)(po + sl * 128 + 16); }
            float m, l; f32x4 o[8]; bf16x8 pf[8], fb[2][8];
            const float mfl = fmaxf(fmaxf(ml[0].x, ml[1].x), ml[2].x);
            attn_scores<true, false>(lds, qf, qidx, fr, fq, mfl, m, l, pf, fb);
            AT_SCHED;
            { const int k1 = k + 1 < 4 ? k + 1 : k; A2_LOAD(qf, mln, k1); }
            float den = l, wsl[3];
#pragma unroll
            for (int sl = 0; sl < 3; ++sl) { wsl[sl] = (sl < nsl) ? ml[sl].y * fast_exp2(ml[sl].x - m) : 0.f; den += wsl[sl]; }
#pragma unroll
            for (int dt = 0; dt < 8; ++dt) { f32x4 r = (f32x4){0.f, 0.f, 0.f, 0.f};
#pragma unroll
                for (int sl = 0; sl < 3; ++sl) if (sl < nsl) { const int w_ = (int)pw[sl][dt >> 2][dt & 3]; const f32x2_t lo = __builtin_amdgcn_cvt_pk_f32_fp8(w_, false), hi = __builtin_amdgcn_cvt_pk_f32_fp8(w_, true);
                    r[0] += wsl[sl] * lo.x; r[1] += wsl[sl] * lo.y; r[2] += wsl[sl] * hi.x; r[3] += wsl[sl] * hi.y; }
                o[dt] = r; }
            attn_pv<false, false>(lds, pf, fr, fq, o, fb);
            const float inv = __builtin_amdgcn_rcpf(den);
#pragma unroll
            for (int dt = 0; dt < 8; ++dt) { const f32x4 on = o[dt] * inv; u32x2 w; w.x = cvt_pk_bf16(on[0], on[1]); w.y = cvt_pk_bf16(on[2], on[3]);
                *(u32x2*)(OB + row * 1024 + h * 128 + 16 * dt + 4 * fq) = w; }
#pragma unroll
            for (int sl = 0; sl < 3; ++sl) ml[sl] = mln[sl];
        }
#undef A2_LOAD
#undef A2_ROW
#undef A2_HEAD
    }
}
constexpr int SA_Q = 0, SA_SC = 512, SA_SEL = 640, SA_PG = 672, SA_LG = 1024, SA_RED = 4352, SA_OP = 4608;
#define SA_BARRIER() do { asm volatile("s_waitcnt lgkmcnt(0)" ::: "memory"); __builtin_amdgcn_s_barrier(); asm volatile("" ::: "memory"); } while (0)
__device__ __forceinline__ void satt_phase(Frame& F, const Args& A) {
    unsigned char* ws = F.ws; LAS unsigned char* lds = F.lds;
    const float* QS = (const float*)(ws + WS_QS); const float* KMC = (const float*)(ws + WS_KMC); bf16* OSB = (bf16*)(ws + WS_OSB);
    const float* ck = (const float*)A.in[2]; const float* cv = (const float*)A.in[3]; const int* pt = (const int*)A.in[6];
    const float* sk = F.out + O_SK; const float* sv = F.out + O_SV;
    LAS float* q_s = (LAS float*)(lds + SA_Q); LAS float* sc_s = (LAS float*)(lds + SA_SC); LAS int* sel_s = (LAS int*)(lds + SA_SEL); LAS int* pg_s = (LAS int*)(lds + SA_PG); LAS float* lg = (LAS float*)(lds + SA_LG);
    LAS float* red = (LAS float*)(lds + SA_RED); LAS f32x4* op = (LAS f32x4*)(lds + SA_OP);
    const int tid = F.tid, lane = F.lane;
    for (int u = F.bid; u < SB * NH; u += F.G) {
        const int b = u >> 3, h = u & 7, g = h >> 1;
        __syncthreads();
        if (tid < 128) q_s[tid] = QS[b * 1024 + h * 128 + tid];
        __syncthreads();
        { const int j = tid >> 4, dg = tid & 15; const float* kp = KMC + (size_t)(b * 32 + j) * 512 + g * 128 + 8 * dg; float s = 0.f;
#pragma unroll
          for (int i = 0; i < 8; ++i) s += q_s[8 * dg + i] * kp[i];
          s += __shfl_xor(s, 1); s += __shfl_xor(s, 2); s += __shfl_xor(s, 4); s += __shfl_xor(s, 8);
          if (dg == 0) sc_s[j] = s; }
        __syncthreads();
        if (tid == 0) { float v[32];
#pragma unroll
            for (int i = 0; i < 32; ++i) v[i] = sc_s[i];
#pragma unroll
            for (int rd = 0; rd < 3; ++rd) { float bv = -3.4e38f; int bi = 0;
#pragma unroll
                for (int i = 0; i < 32; ++i) if (v[i] > bv) { bv = v[i]; bi = i; }
                sel_s[rd] = bi;
#pragma unroll
                for (int i = 0; i < 32; ++i) if (i == bi) v[i] = -3.4e38f; } }
        __syncthreads();
        if (tid < 6) pg_s[tid] = pt[b * NPG + 2 * sel_s[tid >> 1] + (tid & 1)];
        __syncthreads();
        const int r32 = lane & 31, hw = tid >> 5;
        const f32x4 q4 = *(const LAS f32x4*)(q_s + 4 * r32);
        f32x4 ka[8], kb[8];
#define SA_LOAD(dst, base_, bt_) do { const f32x4* p_ = (const f32x4*)((base_) + ((size_t)(pg_s[bt_] * PAGE + hw) * 4 + g) * 128) + r32; _Pragma("unroll") for (int i = 0; i < 8; ++i) dst[i] = p_[(size_t)i * 2048]; } while (0)
#define SA_DOT(src, bt_) do { _Pragma("unroll") for (int i = 0; i < 8; ++i) { float s = q4[0] * src[i][0] + q4[1] * src[i][1] + q4[2] * src[i][2] + q4[3] * src[i][3]; \
            s += __shfl_xor(s, 1); s += __shfl_xor(s, 2); s += __shfl_xor(s, 4); s += __shfl_xor(s, 8); s += __shfl_xor(s, 16); if (r32 == 0) lg[(bt_) * 128 + hw + 16 * i] = s; } } while (0)
        SA_LOAD(ka, ck, 0);
#pragma unroll
        for (int bt = 0; bt < 6; bt += 2) {
            SA_LOAD(kb, ck, bt + 1); SA_DOT(ka, bt);
            if (bt + 2 < 6) SA_LOAD(ka, ck, bt + 2); else SA_LOAD(ka, cv, 0);
            SA_DOT(kb, bt + 1);
        }
        if (hw == 0) { const f32x4 k4 = *((const f32x4*)(sk + (size_t)(b * 4 + g) * 128) + r32); float s = q4[0] * k4[0] + q4[1] * k4[1] + q4[2] * k4[2] + q4[3] * k4[3];
            s += __shfl_xor(s, 1); s += __shfl_xor(s, 2); s += __shfl_xor(s, 4); s += __shfl_xor(s, 8); s += __shfl_xor(s, 16);
            if (r32 == 0) lg[768] = s; }
        SA_BARRIER();
        float mx = -3.4e38f;
        for (int i = tid; i < 769; i += NTHR) mx = fmaxf(mx, lg[i]);
        mx = wave_max(mx); if (lane == 0) red[F.wave] = mx;
        SA_BARRIER();
        mx = red[0];
#pragma unroll
        for (int i = 1; i < 8; ++i) mx = fmaxf(mx, red[i]);
        SA_BARRIER();
        float sm = 0.f;
        for (int i = tid; i < 769; i += NTHR) { const float e = fast_exp2(lg[i] - mx); lg[i] = e; sm += e; }
        sm = wave_sum(sm); if (lane == 0) red[F.wave] = sm;
        SA_BARRIER();
        sm = 0.f;
#pragma unroll
        for (int i = 0; i < 8; ++i) sm += red[i];
        f32x4 acc = (f32x4){0.f, 0.f, 0.f, 0.f};
#define SA_ACC(src, bt_) do { _Pragma("unroll") for (int i = 0; i < 8; ++i) acc += src[i] * lg[(bt_) * 128 + hw + 16 * i]; } while (0)
#pragma unroll
        for (int bt = 0; bt < 6; bt += 2) {
            SA_LOAD(kb, cv, bt + 1); SA_ACC(ka, bt);
            if (bt + 2 < 6) SA_LOAD(ka, cv, bt + 2);
            SA_ACC(kb, bt + 1);
        }
#undef SA_ACC
#undef SA_DOT
#undef SA_LOAD
        if (hw == 0) { const f32x4 v4 = *((const f32x4*)(sv + (size_t)(b * 4 + g) * 128) + r32); acc += v4 * lg[768]; }
        op[hw * 32 + r32] = acc;
        __syncthreads();
        if (tid < 32) { f32x4 t = op[tid];
#pragma unroll
            for (int i = 1; i < 16; ++i) t += op[i * 32 + tid];
            t = t * (1.0f / sm);
            u32x2 w; w.x = cvt_pk_bf16(t[0], t[1]); w.y = cvt_pk_bf16(t[2], t[3]); *(u32x2*)(OSB + b * 1024 + h * 128 + 4 * tid) = w; }
    }
}
__device__ __forceinline__ void final_phase(Frame& F, const Args& A) {
    unsigned char* ws = F.ws; const float* gf = (const float*)A.in[24];
    const int gw = F.bid * NWAVES + F.wave, NGW = F.G * NWAVES;
    f32x4 gv[4];
#pragma unroll
    for (int j = 0; j < 4; ++j) gv[j] = *((const f32x4*)gf + F.lane + 64 * j);
#pragma unroll 1
    for (int m0 = gw; m0 < M + SB; m0 += 2 * NGW) {
        f32x4 xv[2][4]; rss_t sv[2]; float* yp[2]; bool live[2];
#pragma unroll
        for (int k = 0; k < 2; ++k) { const int m = m0 + k * NGW < M + SB ? m0 + k * NGW : m0; live[k] = (k == 0) || (m0 + NGW < M + SB); const bool P = m < M; const int r = P ? m : m - M;
            sv[k] = P ? ((const rss_t*)(ws + WS_RSS))[8 * M + r] : ((const rss_t*)(ws + WS_RSSS))[8 * SB + r];
            yp[k] = P ? F.out + O_YP + (size_t)r * D : F.out + O_YS + (size_t)r * D;
            if (P) { const u32x2* xbr = (const u32x2*)((const bf16*)(ws + WS_XB) + (size_t)r * D);
#pragma unroll
                for (int j = 0; j < 4; ++j) { const u32x2 w = xbr[F.lane + 64 * j]; xv[k][j] = (f32x4){bflo(w.x), bfhi(w.x), bflo(w.y), bfhi(w.y)}; }
            } else { const float* x = (const float*)(ws + WS_XS) + (size_t)r * D;
#pragma unroll
                for (int j = 0; j < 4; ++j) xv[k][j] = *((const f32x4*)x + F.lane + 64 * j); } }
#pragma unroll
        for (int k = 0; k < 2; ++k) { const float rs = 1.0f / sqrtf((float)sv[k] * (1.0f / 16777216.0f) * (1.0f / 1024.0f) + EPS);
            if (live[k]) {
#pragma unroll
                for (int j = 0; j < 4; ++j) *((f32x4*)yp[k] + F.lane + 64 * j) = xv[k][j] * rs * gv[j]; } }
    }
}

constexpr int NPH = 30;
#ifndef MK_MULTI
#define MK_MULTI 0
#endif
__global__ void __launch_bounds__(NTHR, 2) yoco_fwd(Args args) {
    extern __shared__ __attribute__((aligned(16))) unsigned char lds_raw[];
    LAS unsigned char* const lds_base = (LAS unsigned char*)lds_raw;
    volatile LAS unsigned* MISC = (volatile LAS unsigned*)(lds_base + LDS_MISC_OFF);
    if (threadIdx.x < 32) MISC[threadIdx.x] = 0u;
    const int wave_s = __builtin_amdgcn_readfirstlane((int)threadIdx.x >> 6);
    __syncthreads();
#ifndef REPMASK
#define REPMASK 0u
#endif
#define REPMASK_IS_ZERO (REPMASK == 0u)
#define lo (args.ph_lo)
#define hi (args.ph_hi)
#define hi_bar ((gridDim.x == 256 && lo <= 28 && hi > 29 && REPMASK_IS_ZERO) ? 29 : hi)
    unsigned* ctl = (unsigned*)(args.ws + WS_CTL);
    XcdBarrier bar; bar.bar = ctl + CW_BAR; bar.x = 0; bar.st = MISC + 8;
    if (hi - lo > 1) bar = xcd_barrier_post(ctl + CW_BAR, MISC + 8);
#ifndef PHMASK
#define PHMASK 0xFFFFFFFFu
#endif
#define PH_BEGIN(id, bit) if (((PHMASK >> (bit)) & 1u) && lo <= (id) && (id) < hi) { Frame F = make_frame(args, lds_base, wave_s); unsigned char* ws = F.ws; \
    rss_t* RSS = (rss_t*)(ws + WS_RSS); rss_t* RSSS = (rss_t*)(ws + WS_RSSS); bf16* XB = (bf16*)(ws + WS_XB); float* X = (float*)(ws + WS_X); float* XS = (float*)(ws + WS_XS); bf16* XSB = (bf16*)(ws + WS_XSB); \
    LAS unsigned char* ring = F.lds + RING_OFF; (void)RSS; (void)RSSS; (void)XB; (void)X; (void)XS; (void)XSB; (void)ring; \
    const rss_t* rss_in = RSS + (size_t)(2 * l) * M; rss_t* rss_mid = RSS + (size_t)(2 * l + 1) * M; rss_t* rss_out = RSS + (size_t)(2 * l + 2) * M; \
    const rss_t* rsss_in = RSSS + (2 * l) * SB; rss_t* rsss_mid = RSSS + (2 * l + 1) * SB; rss_t* rsss_out = RSSS + (2 * l + 2) * SB; (void)rss_in; (void)rss_mid; (void)rss_out; (void)rsss_in; (void)rsss_mid; (void)rsss_out; \
    for (int rep = (int)((REPMASK >> (bit)) & 1u); rep >= 0; --rep) { const bool dry = rep > 0; (void)dry;
#ifndef PROBE_SCAN1_EXTRA
#define PROBE_SCAN1_EXTRA
#endif
#ifndef PROBE_SCAN2_EXTRA
#define PROBE_SCAN2_EXTRA
#endif
#define RS_TAB ((LAS float*)(F.lds + 140544))
#define RS_LOAD(rssp) rss_t rs_raw_ = (hasu && F.tid < 256) ? (rssp)[u0.pm * 256 + F.tid] : (rss_t)0
#define RS_STORE() do { if (hasu && F.tid < 256) RS_TAB[F.tid] = pg8::rs_of(rs_raw_); } while (0)
#ifndef PROBE_BAR_EXTRA
#define PROBE_BAR_EXTRA
#endif
#define PH_END(id) } if ((id) + 1 < hi_bar) { xcd_barrier(bar, pg8::tid_of(wave_s) == 0); PROBE_BAR_EXTRA } }

    { const int l = 0; PH_BEGIN(0, 0) p0_prologue(F, args); PH_END(0) }

    for (int l = 0; l < 4; ++l) {
        const int pb = 1 + 7 * l;
        if (l < 2) {
            PH_BEGIN(pb + 0, 1)
                pg8::StaticOrder SO; SO.init(M, 2048, F.G, F.bid); pg8::Unit u0{}; const bool hasu = SO.next(0, u0);
                auto hook = [&]() { RS_LOAD(rss_in); { SgArgs S{}; S.A = XSB; S.lda = 1024; S.Bt = (const bf16*)(ws + WS_WRGIN) + (size_t)l * 2048 * 1024; S.K = 1024; S.nunits = 64; S.rss_in = rsss_in; S.fout = (float*)(ws + WS_PROJS);
                  sgemm_units<SG_RGIN, 1024>(F, S, 0); }
                  if (!dry) { conv_shadow(F, args, l, 0, 0, 64); } RS_STORE(); __syncthreads(); };
                { pg8::Gemm g{XB, (const bf16*)(ws + WS_WRGIN) + (size_t)l * 2048 * 1024, M, 2048, 1024}; g.wv = F.wave; pg8::StaticOrder S = SO;
                  pg8::EpiRgIn E{rss_in, (bf16*)(ws + WS_GATE), (bf16*)(ws + WS_U), F.out + O_PCONV + (size_t)l * 2 * 3 * 1024}; E.rsl = RS_TAB; E.rs_pm = hasu ? u0.pm : -1;
                  pg8::gemm_phase<pg8::EpiRgIn, pg8::StaticOrder, true, true, false>(ring, g, S, E, hook); }
            PH_END(pb + 0)
            PH_BEGIN(pb + 1, 2) scan_phase<1>(F, args, l); PROBE_SCAN1_EXTRA srg_step(F, args, l); scan_phase<2>(F, args, l); PROBE_SCAN2_EXTRA PH_END(pb + 1)
            PH_BEGIN(pb + 4, 4)
                auto hook = [&]() { { SgArgs S{}; S.A = (const bf16*)(ws + WS_HGS); S.lda = 1024; S.Bt = (const bf16*)(ws + WS_WRGOUT) + (size_t)l * 1024 * 1024; S.K = 1024; S.nunits = 32;
                  S.xin = l == 0 ? (const float*)args.in[1] : XS; S.xout = XS; S.xbout = XSB; S.rss_out = rsss_mid; if (!dry) sgemm_units<SG_RESID, 1024>(F, S, 0); }
                  if (!dry) { conv_shadow(F, args, l, 1, 0, 32); } __syncthreads(); };
                { pg8::Gemm g{(const bf16*)(ws + WS_HG), (const bf16*)(ws + WS_WRGOUT) + (size_t)l * 1024 * 1024, M, 1024, 1024}; g.wv = F.wave; pg8::StaticOrder S; S.init(M, 1024, F.G, F.bid);
                  pg8::EpiResid E{XB, dry ? (bf16*)(ws + WS_DXB) : XB, dry ? (rss_t*)(ws + WS_DRSS) : rss_mid};
                  pg8::gemm_phase<pg8::EpiResid, pg8::StaticOrder, true, true, false>(ring, g, S, E, hook); }
            PH_END(pb + 4)
        } else {
            const int a = l - 2;
            PH_BEGIN(pb + 0, 5)
                pg8::StaticOrder SO; SO.init(M, a ? 1024 : 2048, F.G, F.bid); pg8::Unit u0{}; const bool hasu = SO.next(0, u0);
                auto hook = [&]() { RS_LOAD(rss_in); { SgArgs S{}; S.A = XSB; S.lda = 1024; S.Bt = (const bf16*)(ws + WS_WQKV) + (size_t)(a ? 2048 : 0) * 1024; S.K = 1024; S.nunits = a ? 32 : 64; S.rss_in = rsss_in;
                  S.fout = (float*)(ws + WS_QS); S.sk = F.out + O_SK; S.sv = F.out + O_SV; if (!dry) sgemm_units<SG_QKV, 1024>(F, S, 0); }
                  if (!dry && a == 0) { conv_shadow(F, args, l, 0, 0, 64); } RS_STORE(); __syncthreads(); };
                { const int N = a ? 1024 : 2048; pg8::Gemm g{XB, (const bf16*)(ws + WS_WQKV) + (size_t)(a ? 2048 : 0) * 1024, M, N, 1024}; g.wv = F.wave; pg8::StaticOrder S = SO;
                  pg8::EpiQkv E{rss_in, (bf16*)(ws + WS_Q), (bf16*)(ws + WS_KB), (bf16*)(ws + WS_VT), F.out + O_PK, F.out + O_PV, (float*)(ws + (dry ? WS_DKM : WS_KM))}; E.rsl = RS_TAB; E.rs_pm = hasu ? u0.pm : -1;
                  pg8::gemm_phase<pg8::EpiQkv, pg8::StaticOrder, true, true, false>(ring, g, S, E, hook); }
            PH_END(pb + 0)
            PH_BEGIN(pb + 1, 6) sel_phase(F, a, dry); if (lo > pb + 1 || hi <= pb + 2) satt_phase(F, args); PH_END(pb + 1)
            PH_BEGIN(pb + 2, 7) att1_phase(F, args, a, REPMASK == 0u && pb + 3 < hi, lo <= pb + 1); PH_END(pb + 2)
            PH_BEGIN(pb + 3, 8) att2_phase(F, REPMASK == 0u && lo <= pb + 2); PH_END(pb + 3)
            PH_BEGIN(pb + 4, 9)
                auto hook = [&]() { { SgArgs S{}; S.A = (const bf16*)(ws + WS_OSB); S.lda = 1024; S.Bt = (const bf16*)(ws + WS_WO) + (size_t)a * 1024 * 1024; S.K = 1024; S.nunits = 32;
                  S.xin = XS; S.xout = XS; S.xbout = XSB; S.rss_out = rsss_mid; if (!dry) sgemm_units<SG_RESID, 1024>(F, S, 0); }
                  if (!dry && a == 0) { conv_shadow(F, args, l, 1, 0, 32); } __syncthreads(); };
                { pg8::Gemm g{(const bf16*)(ws + WS_OB), (const bf16*)(ws + WS_WO) + (size_t)a * 1024 * 1024, M, 1024, 1024}; g.wv = F.wave; pg8::StaticOrder S; S.init(M, 1024, F.G, F.bid);
                  pg8::EpiResid E{XB, dry ? (bf16*)(ws + WS_DXB) : XB, dry ? (rss_t*)(ws + WS_DRSS) : rss_mid};
                  pg8::gemm_phase<pg8::EpiResid, pg8::StaticOrder, true, true, false>(ring, g, S, E, hook); }
            PH_END(pb + 4)
        }
        PH_BEGIN(pb + 5, 10)
            pg8::StaticOrder SO; SO.init(M, NF2, F.G, F.bid); pg8::Unit u0{}; const bool hasu = SO.next(0, u0);
            auto hook = [&]() { RS_LOAD(rss_mid); { SgArgs S{}; S.A = XSB; S.lda = 1024; S.Bt = (const bf16*)(ws + WS_WFIN) + (size_t)l * NF2 * 1024; S.K = 1024; S.nunits = 88; S.rss_in = rsss_mid; S.bout = (bf16*)(ws + WS_ACTS);
              sgemm_units<SG_FFNIN, 1024>(F, S, 128); }
              if (!dry) { conv_shadow(F, args, l, 2, 128, 88); } RS_STORE(); __syncthreads(); };
            { pg8::Gemm g{XB, (const bf16*)(ws + WS_WFIN) + (size_t)l * NF2 * 1024, M, NF2, 1024}; g.wv = F.wave;
              const int nfull = (64 * 22) / F.G;
              { pg8::RoundsOrder S; S.init(M, NF2, F.G, F.bid); S.maxr = nfull; pg8::EpiFfnIn<false> E{rss_mid, (bf16*)(ws + WS_ACT)}; E.rsl = RS_TAB; E.rs_pm = hasu ? u0.pm : -1;
                pg8::gemm_phase<pg8::EpiFfnIn<false>, pg8::RoundsOrder, true, true, false>(ring, g, S, E, hook); }
              if (2 * (64 * 22 - nfull * F.G) <= F.G) { pg8::HalfOrder S; S.init(M, NF2, F.G, F.bid); S.maxr = nfull; pg8::EpiFfnIn<true> E{rss_mid, (bf16*)(ws + WS_ACT)};
                pg8::gemm_phase<pg8::EpiFfnIn<true>, pg8::HalfOrder, true, true, true>(ring, g, S, E); }
              else { pg8::HalfOrder S0; (void)S0; struct Rest : pg8::StaticOrder { int r0; __device__ bool next(int i, pg8::Unit& u) const { return pg8::StaticOrder::next(i + r0, u); } } S; S.init(M, NF2, F.G, F.bid); S.r0 = nfull; pg8::EpiFfnIn<false> E{rss_mid, (bf16*)(ws + WS_ACT)};
                pg8::gemm_phase<pg8::EpiFfnIn<false>, Rest, true, true>(ring, g, S, E); } }
        PH_END(pb + 5)
        PH_BEGIN(pb + 6, 11)
            const bool fuse_fin = (l == 3) && F.G == 256 && hi > 29 && !dry && REPMASK == 0u;
            unsigned* fctl = (unsigned*)(ws + WS_CTL);
            auto hook = [&]() { { SgArgs S{}; S.A = (const bf16*)(ws + WS_ACTS); S.lda = FF; S.Bt = (const bf16*)(ws + WS_WFOUT) + (size_t)l * 1024 * FF; S.K = FF; S.nunits = 32;
              S.xin = XS; S.xout = XS; S.xbout = XSB; S.rss_out = rsss_out;
              if (fuse_fin) { S.fcnt = fctl + CW_FINS; S.gfin = (const float*)args.in[24]; S.fout = F.out + O_YS; sgemm_units<SG_RESFIN, FF>(F, S, 0); }
              else if (!dry) sgemm_units<SG_RESID, FF>(F, S, 0); }
              if (!dry) { conv_shadow(F, args, l, 3, 0, 32); } __syncthreads(); };
            { pg8::Gemm g{(const bf16*)(ws + WS_ACT), (const bf16*)(ws + WS_WFOUT) + (size_t)l * 1024 * FF, M, 1024, FF}; g.wv = F.wave; pg8::StaticOrder S; S.init(M, 1024, F.G, F.bid);
              if (fuse_fin) { pg8::EpiResidFinal E{XB, rss_out, fctl + CW_FINP, (const float*)args.in[24], F.out + O_YP};
                pg8::gemm_phase<pg8::EpiResidFinal, pg8::StaticOrder, false, true, false>(ring, g, S, E, hook); }
              else { pg8::EpiResid E{XB, dry ? (bf16*)(ws + WS_DXB) : XB, dry ? (rss_t*)(ws + WS_DRSS) : rss_out};
                pg8::gemm_phase<pg8::EpiResid, pg8::StaticOrder, true, true, false>(ring, g, S, E, hook); } }
        PH_END(pb + 6)
    }
    if (!(gridDim.x == 256 && lo <= 28 && hi > 29 && REPMASK == 0u)) { const int l = 0; PH_BEGIN(29, 12) final_phase(F, args); PH_END(29) }
#undef PH_BEGIN
#undef PH_END
#undef lo
#undef hi
#undef hi_bar
}

extern "C" void kernel_launch(void* const* d_in, const int* in_sizes, int n_in, void* d_out, int out_size, void* d_ws, size_t ws_size, hipStream_t stream) {
    static int grid = 0;
    if (grid == 0) {
        if (n_in != 25 || out_size != (int)O_END || ws_size < WS_NEED) { fprintf(stderr, "kernel_launch: unexpected shapes (n_in %d, out %d, ws %zu); nothing launched\n", n_in, out_size, ws_size); grid = -1; return; }
        int dev = 0, cus = 0, per_cu = 0;
        if (hipGetDevice(&dev) != hipSuccess || hipDeviceGetAttribute(&cus, hipDeviceAttributeMultiprocessorCount, dev) != hipSuccess) { fprintf(stderr, "kernel_launch: device query failed\n"); grid = -1; return; }
        if (hipFuncSetAttribute((const void*)yoco_fwd, hipFuncAttributeMaxDynamicSharedMemorySize, LDS_BYTES) != hipSuccess) { fprintf(stderr, "kernel_launch: hipFuncSetAttribute failed\n"); grid = -1; return; }
        if (hipOccupancyMaxActiveBlocksPerMultiprocessor(&per_cu, (const void*)yoco_fwd, NTHR, LDS_BYTES) != hipSuccess || per_cu < 1) { fprintf(stderr, "kernel_launch: occupancy query says %d blocks per CU\n", per_cu); per_cu = 1; }
        (void)hipGetLastError();
        grid = cus;
    }
    if (grid < 0) return;
    (void)in_sizes;
    if (hipMemsetAsync(d_ws, 0, ZERO_BYTES, stream) != hipSuccess) { fprintf(stderr, "kernel_launch: memset failed\n"); return; }
    Args a; memset(&a, 0, sizeof(a));
    for (int i = 0; i < 25; ++i) a.in[i] = d_in[i];
    a.out = (float*)d_out; a.ws = (unsigned char*)d_ws;
#if MK_MULTI
    for (int p = 0; p < NPH; ++p) {
        if (p >= 1 && p <= 28) { const int l = (p - 1) / 7, k = (p - 1) % 7; if (l < 2 && (k == 2 || k == 3)) continue; }
        a.ph_lo = p; a.ph_hi = p + 1;
        hipLaunchKernelGGL(yoco_fwd, dim3(grid), dim3(NTHR), LDS_BYTES, stream, a);
    }
#else
    a.ph_lo = 0; a.ph_hi = NPH;
    hipLaunchKernelGGL(yoco_fwd, dim3(grid), dim3(NTHR), LDS_BYTES, stream, a);
#endif
    const hipError_t le = hipPeekAtLastError();
    if (le != hipSuccess) fprintf(stderr, "kernel_launch: launch failed: %s\n", hipGetErrorName(le));
}
```

```cpp
#include <hip/hip_runtime.h>
#include <cstdio>
#include <cstdint>
#include <cstring>
#define MK_MULTI 0
namespace pg8 {
#define PG8_LAS __attribute__((address_space(3)))
typedef unsigned short bf16_t;
typedef short bf16x8 __attribute__((ext_vector_type(8)));
typedef float f32x4 __attribute__((ext_vector_type(4)));
typedef unsigned u32x4 __attribute__((ext_vector_type(4)));
constexpr int BM = 256, BK = 64, HALF = 128, HTB = HALF * BK * 2  , STAGE_BYTES = 8 * HTB, NXCD = 8, WGM = 8;

__host__ __device__ __forceinline__ int lds_byte(int r, int c) { const int st = (r >> 4) * 2 + (c >> 5), rr = r & 15, cc = c & 31, ob = rr * 64 + cc * 2; return st * 1024 + (ob ^ (((ob >> 9) & 1) << 5)); }
__host__ __device__ __forceinline__ void stage_rc(int b, int& R, int& C) { const int st = b / 1024, sb = b % 1024, swz = sb ^ (((sb >> 9) & 1) << 5); R = (st >> 1) * 16 + swz / 64; C = (st & 1) * 32 + (swz % 64) / 2; }
__host__ __device__ __forceinline__ int perm32(int rho) { const int n = rho >> 4, i = rho & 15; return 8 * (i >> 2) + 4 * n + (i & 3); }

struct Unit { int pm, pn, rofs; };
struct Gemm { const bf16_t* A; const bf16_t* Bt; int M, N, K; int wv = 0; };
__device__ __forceinline__ int tid_of(int wave) { int l_; asm volatile("v_mbcnt_lo_u32_b32 %0, -1, 0\n\tv_mbcnt_hi_u32_b32 %0, -1, %0" : "=&v"(l_));
    return l_ + 64 * wave; }

struct StaticOrder {
    int nM, nN, nwg, G, c;
    __host__ __device__ void init(int M, int N, int G_, int c_) { nM = M / BM; nN = N / BM; nwg = nM * nN; G = G_; c = c_; }
    __host__ __device__ __forceinline__ bool next(int i, Unit& u) const {
        const long L = (long)i * G + c; if (L >= nwg) return false;
        int wgid = (int)L; { const int q = nwg / NXCD, r = nwg % NXCD, xcd = wgid % NXCD, off = wgid / NXCD; wgid = (xcd < r ? xcd * (q + 1) : r * (q + 1) + (xcd - r) * q) + off; }
        const int nig = WGM * nN, gid = wgid / nig, fm = gid * WGM, gsz = (nM - fm) < WGM ? (nM - fm) : WGM;
        u.pm = fm + ((wgid % nig) % gsz); u.pn = (wgid % nig) / gsz; u.rofs = 0; return true;
    }
    __device__ __forceinline__ void a_ready(const Unit&) const {}
    __device__ __forceinline__ void done(const Unit&) const {}
};
struct RoundsOrder : StaticOrder { int maxr; __host__ __device__ __forceinline__ bool next(int i, Unit& u) const { return i < maxr && StaticOrder::next(i, u); } };
struct HalfOrder : StaticOrder { int maxr; __host__ __device__ __forceinline__ bool next(int i, Unit& u) const { if (i != 0) return false; StaticOrder t = *this; t.c = c >> 1; if (!t.next(maxr, u)) return false; u.rofs = (c & 1) * HALF; return true; } };


__device__ __forceinline__ unsigned cvt_pk_bf16(float lo, float hi) { unsigned r; asm volatile("v_cvt_pk_bf16_f32 %0, %1, %2" : "=v"(r) : "v"(lo), "v"(hi)); return r; }
typedef float f32x2 __attribute__((ext_vector_type(2)));
typedef unsigned u32x2 __attribute__((ext_vector_type(2)));
constexpr float RMS_EPS = 1e-6f;
__device__ __forceinline__ float fast_rcp(float x) { return __builtin_amdgcn_rcpf(x); }
__device__ __forceinline__ float fast_exp2(float x) { return __builtin_amdgcn_exp2f(x); }
__device__ __forceinline__ float sigmoidf_(float z) { return fast_rcp(1.0f + fast_exp2(-1.44269504089f * z)); }
__device__ __forceinline__ float gelu_tanh(float x) { const float z = 1.5957691216057308f * (x + 0.044715f * x * x * x); return x * sigmoidf_(z); }
__device__ __forceinline__ float silu_(float x) { return x * sigmoidf_(x); }
typedef unsigned long long rss_t;
constexpr float RSS_SCALE = 16777216.0f, RSS_INV = 1.0f / (16777216.0f * 1024.0f);
__device__ __forceinline__ float row_rs(const rss_t* rowss, int r) { return __builtin_amdgcn_rsqf((float)rowss[r] * RSS_INV + RMS_EPS); }
__device__ __forceinline__ float rs_of(rss_t raw) { return __builtin_amdgcn_rsqf((float)raw * RSS_INV + RMS_EPS); }

struct EpiRgIn {
    static constexpr bool PERM = true, AFTER_DRAIN = false;
    const rss_t* rowss; bf16_t* gate; bf16_t* u; float* pconv;
    const PG8_LAS float* rsl = nullptr; int rs_pm = -1;
    __device__ __forceinline__ void operator()(const f32x4 (&acc)[2][2][4][2], const Unit& un, int wr, int wc, int fr, int fq) const {
        const bool isU = un.pn >= 4; const int colb = (un.pn & 3) * BM + wc * 32 + 8 * fq;
        rss_t rsw[2][4]; float rsv[2][4];
        if (un.pm == rs_pm) {
#pragma unroll
        for (int ai = 0; ai < 2; ++ai)
#pragma unroll
            for (int m = 0; m < 4; ++m) rsv[ai][m] = rsl[ai * HALF + wr * 64 + m * 16 + fr];
        } else {
#pragma unroll
        for (int ai = 0; ai < 2; ++ai)
#pragma unroll
            for (int m = 0; m < 4; ++m) rsw[ai][m] = rowss[un.pm * BM + ai * HALF + wr * 64 + m * 16 + fr];
#pragma unroll
        for (int ai = 0; ai < 2; ++ai)
#pragma unroll
            for (int m = 0; m < 4; ++m) rsv[ai][m] = rs_of(rsw[ai][m]);
        }
#pragma unroll
        for (int ai = 0; ai < 2; ++ai)
#pragma unroll
            for (int m = 0; m < 4; ++m) { const int r = un.pm * BM + ai * HALF + wr * 64 + m * 16 + fr; const float rs = rsv[ai][m];
#pragma unroll
                for (int bj = 0; bj < 2; ++bj) { f32x4 v0 = acc[ai][bj][m][0] * rs, v1 = acc[ai][bj][m][1] * rs; const int c = colb + bj * HALF;
                    if (!isU) {
#pragma unroll
                        for (int hv = 0; hv < 2; ++hv) { f32x4& x = hv ? v1 : v0;
                            const f32x4 z = (x * (x * x * 0.044715f + 1.0f)) * (-1.44269504089f * 1.5957691216057308f);
                            const f32x4 d = (f32x4){fast_exp2(z[0]), fast_exp2(z[1]), fast_exp2(z[2]), fast_exp2(z[3])} + 1.0f;
                            x = x * (f32x4){fast_rcp(d[0]), fast_rcp(d[1]), fast_rcp(d[2]), fast_rcp(d[3])}; }
                        u32x4 w; w.x = cvt_pk_bf16(v0[0], v0[1]); w.y = cvt_pk_bf16(v0[2], v0[3]); w.z = cvt_pk_bf16(v1[0], v1[1]); w.w = cvt_pk_bf16(v1[2], v1[3]);
                        *(u32x4*)(gate + (size_t)r * 1024 + c) = w;
                    } else {
                        u32x4 w; w.x = cvt_pk_bf16(v0[0], v0[1]); w.y = cvt_pk_bf16(v0[2], v0[3]); w.z = cvt_pk_bf16(v1[0], v1[1]); w.w = cvt_pk_bf16(v1[2], v1[3]);
                        *(u32x4*)(u + (size_t)r * 1024 + c) = w;
                        const int t = r & 8191;
                        if (t >= 8189) { float* pc = pconv + (size_t)((r >> 13) * 3 + (t - 8189)) * 1024 + c; *(f32x4*)pc = v0; *(f32x4*)(pc + 4) = v1; }
                    } } }
    }
};

__device__ __forceinline__ float bf_lo(unsigned w) { return __uint_as_float(w << 16); }
__device__ __forceinline__ float bf_hi(unsigned w) { return __uint_as_float(w & 0xffff0000u); }
struct EpiResid {
    static constexpr bool PERM = true, AFTER_DRAIN = false;
    const bf16_t* xin; bf16_t* xb; rss_t* rowss_out;
    __device__ __forceinline__ void operator()(const f32x4 (&acc)[2][2][4][2], const Unit& un, int wr, int wc, int fr, int fq) const {
        const int colb = un.pn * BM + wc * 32 + 8 * fq;
#pragma unroll
        for (int ai = 0; ai < 2; ++ai) {
            u32x4 xr[4][2];
#pragma unroll
            for (int m = 0; m < 4; ++m)
#pragma unroll
                for (int bj = 0; bj < 2; ++bj) xr[m][bj] = *(const u32x4*)(xin + (size_t)(un.pm * BM + ai * HALF + wr * 64 + m * 16 + fr) * 1024 + colb + bj * HALF);
#pragma unroll
            for (int m = 0; m < 4; ++m) { const int r = un.pm * BM + ai * HALF + wr * 64 + m * 16 + fr; float ss = 0.f;
#pragma unroll
                for (int bj = 0; bj < 2; ++bj) { const size_t off = (size_t)r * 1024 + colb + bj * HALF; const u32x4 xw = xr[m][bj];
                    const f32x4 x0 = (f32x4){bf_lo(xw.x), bf_hi(xw.x), bf_lo(xw.y), bf_hi(xw.y)} + acc[ai][bj][m][0], x1 = (f32x4){bf_lo(xw.z), bf_hi(xw.z), bf_lo(xw.w), bf_hi(xw.w)} + acc[ai][bj][m][1];
                    u32x4 w; w.x = cvt_pk_bf16(x0[0], x0[1]); w.y = cvt_pk_bf16(x0[2], x0[3]); w.z = cvt_pk_bf16(x1[0], x1[1]); w.w = cvt_pk_bf16(x1[2], x1[3]);
                    *(u32x4*)(xb + off) = w;
                    { const f32x4 sq = x0 * x0 + x1 * x1; ss += (sq[0] + sq[1]) + (sq[2] + sq[3]); } }
                ss += __shfl_xor(ss, 16); ss += __shfl_xor(ss, 32);
                if (fq == 0) atomicAdd(rowss_out + r, (rss_t)(ss * RSS_SCALE)); }
            asm volatile("" ::: "memory"); }
    }
};

struct EpiResidFinal {
    static constexpr bool PERM = true, AFTER_DRAIN = true;
    const bf16_t* xin; rss_t* rowss_out; unsigned* cnt; const float* gfin; float* y;
    __device__ __forceinline__ void fused(f32x4 (&acc)[2][2][4][2], const Unit& un, int wr, int wc, int fr, int fq, PG8_LAS unsigned char*, int, int) const {
        const int colb = un.pn * BM + wc * 32 + 8 * fq;
#pragma unroll
        for (int ai = 0; ai < 2; ++ai) {
            u32x4 xr[4][2];
#pragma unroll
            for (int m = 0; m < 4; ++m)
#pragma unroll
                for (int bj = 0; bj < 2; ++bj) xr[m][bj] = *(const u32x4*)(xin + (size_t)(un.pm * BM + ai * HALF + wr * 64 + m * 16 + fr) * 1024 + colb + bj * HALF);
#pragma unroll
            for (int m = 0; m < 4; ++m) { const int r = un.pm * BM + ai * HALF + wr * 64 + m * 16 + fr; float ss = 0.f;
#pragma unroll
                for (int bj = 0; bj < 2; ++bj) { const u32x4 xw = xr[m][bj];
                    const f32x4 x0 = (f32x4){bf_lo(xw.x), bf_hi(xw.x), bf_lo(xw.y), bf_hi(xw.y)} + acc[ai][bj][m][0], x1 = (f32x4){bf_lo(xw.z), bf_hi(xw.z), bf_lo(xw.w), bf_hi(xw.w)} + acc[ai][bj][m][1];
                    acc[ai][bj][m][0] = x0; acc[ai][bj][m][1] = x1;
                    { const f32x4 sq = x0 * x0 + x1 * x1; ss += (sq[0] + sq[1]) + (sq[2] + sq[3]); } }
                ss += __shfl_xor(ss, 16); ss += __shfl_xor(ss, 32);
                if (fq == 0) atomicAdd(rowss_out + r, (rss_t)(ss * RSS_SCALE)); }
            asm volatile("" ::: "memory"); }
        asm volatile("s_waitcnt vmcnt(0)" ::: "memory");
        __syncthreads();
        if (wr == 0 && wc == 0 && fr == 0 && fq == 0) { unsigned* c = cnt + 64 * un.pm; __hip_atomic_fetch_add(c, 1u, __ATOMIC_RELAXED, __HIP_MEMORY_SCOPE_AGENT);
            for (unsigned sp = 0; sp < (1u << 22); ++sp) { if (__hip_atomic_load(c, __ATOMIC_RELAXED, __HIP_MEMORY_SCOPE_AGENT) >= 4u) break; __builtin_amdgcn_s_sleep(2); } }
        __syncthreads();
        rss_t rsw[2][4]; float rsv[2][4];
#pragma unroll
        for (int ai = 0; ai < 2; ++ai)
#pragma unroll
            for (int m = 0; m < 4; ++m) rsw[ai][m] = __hip_atomic_load(rowss_out + (un.pm * BM + ai * HALF + wr * 64 + m * 16 + fr), __ATOMIC_RELAXED, __HIP_MEMORY_SCOPE_AGENT);
        __builtin_amdgcn_sched_barrier(0);
#pragma unroll
        for (int ai = 0; ai < 2; ++ai)
#pragma unroll
            for (int m = 0; m < 4; ++m) rsv[ai][m] = rs_of(rsw[ai][m]);
        f32x4 gv[2][2];
#pragma unroll
        for (int bj = 0; bj < 2; ++bj) { gv[bj][0] = *(const f32x4*)(gfin + colb + bj * HALF); gv[bj][1] = *(const f32x4*)(gfin + colb + bj * HALF + 4); }
#pragma unroll
        for (int ai = 0; ai < 2; ++ai)
#pragma unroll
            for (int m = 0; m < 4; ++m) { const size_t r = (size_t)(un.pm * BM + ai * HALF + wr * 64 + m * 16 + fr); const float rs = rsv[ai][m];
#pragma unroll
                for (int bj = 0; bj < 2; ++bj) { float* yp = y + r * 1024 + colb + bj * HALF; *(f32x4*)yp = acc[ai][bj][m][0] * rs * gv[bj][0]; *(f32x4*)(yp + 4) = acc[ai][bj][m][1] * rs * gv[bj][1]; } }
    }
};

template <bool HALFM> struct EpiFfnIn {
    static constexpr bool PERM = true, AFTER_DRAIN = false;
    const rss_t* rowss; bf16_t* act;
    const PG8_LAS float* rsl = nullptr; int rs_pm = -1;
    __device__ __forceinline__ void operator()(const f32x4 (&acc)[2][2][4][2], const Unit& un, int wr, int wc, int fr, int fq) const {
        const int colb = un.pn * HALF + wc * 32 + 8 * fq;
        rss_t rsw[2][4]; float rsv[2][4];
        if (un.pm == rs_pm) {
#pragma unroll
        for (int ai = 0; ai < (HALFM ? 1 : 2); ++ai)
#pragma unroll
            for (int m = 0; m < 4; ++m) rsv[ai][m] = rsl[un.rofs + ai * HALF + wr * 64 + m * 16 + fr];
        } else {
#pragma unroll
        for (int ai = 0; ai < (HALFM ? 1 : 2); ++ai)
#pragma unroll
            for (int m = 0; m < 4; ++m) rsw[ai][m] = rowss[un.pm * BM + un.rofs + ai * HALF + wr * 64 + m * 16 + fr];
#pragma unroll
        for (int ai = 0; ai < (HALFM ? 1 : 2); ++ai)
#pragma unroll
            for (int m = 0; m < 4; ++m) rsv[ai][m] = rs_of(rsw[ai][m]);
        }
#pragma unroll
        for (int ai = 0; ai < (HALFM ? 1 : 2); ++ai)
#pragma unroll
            for (int m = 0; m < 4; ++m) { const int r = un.pm * BM + un.rofs + ai * HALF + wr * 64 + m * 16 + fr; const float rs = rsv[ai][m];
                const float nrs = -1.44269504089f * rs, rs2 = rs * rs; f32x4 g0, g1;
                { const f32x4 G = acc[ai][0][m][0], U = acc[ai][1][m][0]; const f32x4 z = G * nrs; const f32x4 d = (f32x4){fast_exp2(z[0]), fast_exp2(z[1]), fast_exp2(z[2]), fast_exp2(z[3])} + 1.0f;
                  g0 = ((G * U) * rs2) * (f32x4){fast_rcp(d[0]), fast_rcp(d[1]), fast_rcp(d[2]), fast_rcp(d[3])}; }
                { const f32x4 G = acc[ai][0][m][1], U = acc[ai][1][m][1]; const f32x4 z = G * nrs; const f32x4 d = (f32x4){fast_exp2(z[0]), fast_exp2(z[1]), fast_exp2(z[2]), fast_exp2(z[3])} + 1.0f;
                  g1 = ((G * U) * rs2) * (f32x4){fast_rcp(d[0]), fast_rcp(d[1]), fast_rcp(d[2]), fast_rcp(d[3])}; }
                u32x4 w; w.x = cvt_pk_bf16(g0[0], g0[1]); w.y = cvt_pk_bf16(g0[2], g0[3]); w.z = cvt_pk_bf16(g1[0], g1[1]); w.w = cvt_pk_bf16(g1[2], g1[3]);
                *(u32x4*)(act + (size_t)r * 2816 + colb) = w; }
    }
};

constexpr float QSCALE = 0.08838834764831845f * 1.4426950408889634f;
struct EpiQkv {
    static constexpr bool PERM = false, AFTER_DRAIN = false;
    const rss_t* rowss; bf16_t* q; bf16_t* kb; bf16_t* vt; float* pk; float* pv; float* km;
    const PG8_LAS float* rsl = nullptr; int rs_pm = -1;
    __device__ __forceinline__ void operator()(const f32x4 (&acc)[2][2][4][2], const Unit& un, int wr, int wc, int fr, int fq) const {
        const int kind = un.pn < 4 ? 0 : (un.pn < 6 ? 1 : 2);
        float inv[4];
#pragma unroll
        for (int i = 0; i < 4; ++i) inv[i] = fast_exp2(-(float)(4 * fq + i) * (18.931568569324174f / 16.0f)) * 0.15915494309189535f;
        f32x4 cs[2][2];
#pragma unroll
        for (int bj = 0; bj < 2; ++bj)
#pragma unroll
            for (int n = 0; n < 2; ++n) cs[bj][n] = (f32x4){0.f, 0.f, 0.f, 0.f};
        rss_t rsw[2][4]; float rsv[2][4];
        if (un.pm == rs_pm) {
#pragma unroll
        for (int ai = 0; ai < 2; ++ai)
#pragma unroll
            for (int m = 0; m < 4; ++m) rsv[ai][m] = rsl[ai * HALF + wr * 64 + m * 16 + fr];
        } else {
#pragma unroll
        for (int ai = 0; ai < 2; ++ai)
#pragma unroll
            for (int m = 0; m < 4; ++m) rsw[ai][m] = rowss[un.pm * BM + ai * HALF + wr * 64 + m * 16 + fr];
#pragma unroll
        for (int ai = 0; ai < 2; ++ai)
#pragma unroll
            for (int m = 0; m < 4; ++m) rsv[ai][m] = rs_of(rsw[ai][m]);
        }
#pragma unroll
        for (int ai = 0; ai < 2; ++ai)
#pragma unroll
            for (int m = 0; m < 4; ++m) { const int r = un.pm * BM + ai * HALF + wr * 64 + m * 16 + fr; const float rs = rsv[ai][m]; const int t = r & 8191, b = r >> 13;
                float co[4], si[4];
                if (kind < 2 && wc == 0) {
#pragma unroll
                    for (int i = 0; i < 4; ++i) { float rev = (float)t * inv[i]; rev = rev - floorf(rev); co[i] = __builtin_amdgcn_cosf(rev); si[i] = __builtin_amdgcn_sinf(rev); } }
#pragma unroll
                for (int bj = 0; bj < 2; ++bj) { f32x4 v0 = acc[ai][bj][m][0] * rs, v1 = acc[ai][bj][m][1] * rs;
                    if (kind < 2 && wc == 0) {
#pragma unroll
                        for (int i = 0; i < 4; ++i) { const float x1 = v0[i], x2 = v1[i]; v0[i] = x1 * co[i] - x2 * si[i]; v1[i] = x2 * co[i] + x1 * si[i]; } }
                    const int d0 = wc * 32 + 4 * fq;
                    if (kind == 0) { const int h = un.pn * 2 + bj; bf16_t* qp = q + (size_t)r * 1024 + h * 128 + d0;
                        u32x2 w0, w1; w0.x = cvt_pk_bf16(v0[0] * QSCALE, v0[1] * QSCALE); w0.y = cvt_pk_bf16(v0[2] * QSCALE, v0[3] * QSCALE); w1.x = cvt_pk_bf16(v1[0] * QSCALE, v1[1] * QSCALE); w1.y = cvt_pk_bf16(v1[2] * QSCALE, v1[3] * QSCALE);
                        *(u32x2*)qp = w0; *(u32x2*)(qp + 16) = w1;
                    } else if (kind == 1) { const int g = (un.pn - 4) * 2 + bj; const size_t o = ((size_t)r * 4 + g) * 128 + d0;
                        *(f32x4*)(pk + o) = v0; *(f32x4*)(pk + o + 16) = v1;
                        u32x2 w0, w1; w0.x = cvt_pk_bf16(v0[0], v0[1]); w0.y = cvt_pk_bf16(v0[2], v0[3]); w1.x = cvt_pk_bf16(v1[0], v1[1]); w1.y = cvt_pk_bf16(v1[2], v1[3]);
                        *(u32x2*)(kb + o) = w0; *(u32x2*)(kb + o + 16) = w1;
                        cs[bj][0] += v0; cs[bj][1] += v1;
                    } else { const int g = (un.pn - 6) * 2 + bj; const size_t o = ((size_t)r * 4 + g) * 128 + d0;
                        *(f32x4*)(pv + o) = v0; *(f32x4*)(pv + o + 16) = v1;
                        bf16_t* vp = vt + ((size_t)(b * 4 + g) * 128 + d0) * 8192 + t;
#pragma unroll
                        for (int i = 0; i < 4; ++i) { vp[(size_t)i * 8192] = (bf16_t)(cvt_pk_bf16(v0[i], 0.f) & 0xffffu); vp[(size_t)(16 + i) * 8192] = (bf16_t)(cvt_pk_bf16(v1[i], 0.f) & 0xffffu); }
                    } } }
        if (kind == 1) {
            const int b = un.pm >> 5, blk = un.pm & 31;
#pragma unroll
            for (int bj = 0; bj < 2; ++bj)
#pragma unroll
                for (int n = 0; n < 2; ++n)
#pragma unroll
                    for (int i = 0; i < 4; ++i) { float s = cs[bj][n][i]; s += __shfl_xor(s, 1); s += __shfl_xor(s, 2); s += __shfl_xor(s, 4); s += __shfl_xor(s, 8);
                        if (fr == 0) unsafeAtomicAdd(km + (size_t)(b * 32 + blk) * 512 + ((un.pn - 4) * 2 + bj) * 128 + wc * 32 + 16 * n + 4 * fq + i, s * (1.0f / 256.0f)); }
        }
    }
};
struct NoHook { __device__ __forceinline__ void operator()() const {} };
template <class Epi, class Sched, bool ALIGN_EPI = false, bool SP2 = false, bool HALFM = false, class Hook = NoHook>
__device__ __forceinline__ void gemm_phase(PG8_LAS unsigned char* lds, const Gemm g, const Sched& S, const Epi& E, const Hook& hook = Hook()) {
    int tid_l = tid_of(g.wv); asm volatile("" : "+v"(tid_l));
    const int tid = tid_l, wid = __builtin_amdgcn_readfirstlane(tid >> 6), lane = tid & 63, wr = wid >> 2, wc = wid & 3, fr = lane & 15, fq = lane >> 4;
    const int K = g.K, nt = K / BK;
    unsigned voffA[2], voffB[2];
#pragma unroll
    for (int i = 0; i < 2; ++i) { int R, C; stage_rc(tid * 16 + i * 8192, R, C); const int Rb = Epi::PERM ? ((R & ~31) + perm32(R & 31)) : R;
        voffA[i] = (unsigned)(R * K + C) * 2u; voffB[i] = (unsigned)(Rb * K + C) * 2u; }
    const size_t kstep = (size_t)(BK * 2);
    const size_t hstep = (size_t)HALF * K * 2;
    const size_t tstep = 2 * hstep;
    const unsigned ldsw = (unsigned)wid * 1024u;
    const int aoff = lds_byte(wr * 64 + fr, fq * 8), boff = lds_byte(wc * 32 + fr, fq * 8);
#define PG8_SA(b, h) (((b) * 2 + (h)) * HTB)
#define PG8_SB(b, h) ((4 + (b) * 2 + (h)) * HTB)
#define PG8_STAGE(bufoff, gbase, voff) do { _Pragma("unroll") for (int _i = 0; _i < 2; ++_i) \
        __builtin_amdgcn_global_load_lds((const unsigned*)((const char*)(gbase) + (voff)[_i]), (PG8_LAS unsigned*)(lds + (bufoff) + ldsw + _i * 8192), 16, 0, 0); } while (0)
#define PG8_LDA(dst, b, h) do { _Pragma("unroll") for (int m = 0; m < 4; ++m) _Pragma("unroll") for (int k = 0; k < 2; ++k) dst[m][k] = *(const PG8_LAS bf16x8*)(lds + PG8_SA(b, h) + aoff + m * 2048 + k * 1024); } while (0)
#define PG8_LDB(dst, b, h) do { _Pragma("unroll") for (int n = 0; n < 2; ++n) _Pragma("unroll") for (int k = 0; k < 2; ++k) dst[n][k] = *(const PG8_LAS bf16x8*)(lds + PG8_SB(b, h) + boff + n * 2048 + k * 1024); } while (0)
#define PG8_MMA(ai, bj, At, Bt) do { __builtin_amdgcn_s_setprio(1); _Pragma("unroll") for (int m = 0; m < 4; ++m) _Pragma("unroll") for (int n = 0; n < 2; ++n) _Pragma("unroll") for (int k = 0; k < 2; ++k) \
        acc[ai][bj][m][n] = __builtin_amdgcn_mfma_f32_16x16x32_bf16(Bt[n][k], At[m][k], acc[ai][bj][m][n], 0, 0, 0); __builtin_amdgcn_s_setprio(0); } while (0)
#define PG8_WAIT_V(n) asm volatile("s_waitcnt vmcnt(" #n ")" ::: "memory")
#define PG8_WAIT_L(n) asm volatile("s_waitcnt lgkmcnt(" #n ")" ::: "memory")
#define PG8_BAR __builtin_amdgcn_s_barrier()
#define PG8_SCHED __builtin_amdgcn_sched_barrier(0)
    Unit cur, nxt; int ui = 0;
    if (!S.next(0, cur)) { hook(); return; }
    f32x4 acc[2][2][4][2];
#pragma unroll
    for (int a = 0; a < 2; ++a)
#pragma unroll
        for (int b = 0; b < 2; ++b)
#pragma unroll
            for (int m = 0; m < 4; ++m)
#pragma unroll
                for (int n = 0; n < 2; ++n) acc[a][b][m][n] = (f32x4){0.f, 0.f, 0.f, 0.f};
    bf16x8 At[4][2], B0[2][2], B1[2][2];
    const char* cA = (const char*)g.A + (size_t)cur.pm * tstep + (size_t)cur.rofs * K * 2; const char* cB = (const char*)g.Bt + (size_t)cur.pn * tstep;
    S.a_ready(cur);
    if constexpr (SP2) {
        PG8_STAGE(PG8_SB(0, 0), cB, voffB); PG8_STAGE(PG8_SB(0, 1), cB + hstep, voffB); PG8_STAGE(PG8_SA(0, 0), cA, voffA); PG8_STAGE(PG8_SA(0, 1), cA + hstep, voffA);
        hook();
        if (wr == 1) PG8_BAR;
        PG8_WAIT_V(2); PG8_BAR;
        PG8_STAGE(PG8_SB(1, 0), cB + kstep, voffB); PG8_STAGE(PG8_SA(1, 0), cA + kstep, voffA); PG8_STAGE(PG8_SB(1, 1), cB + hstep + kstep, voffB);
        PG8_WAIT_V(6); PG8_BAR;
    } else {
        PG8_STAGE(PG8_SB(0, 0), cB, voffB); PG8_STAGE(PG8_SA(0, 0), cA, voffA); PG8_STAGE(PG8_SB(0, 1), cB + hstep, voffB); PG8_STAGE(PG8_SA(0, 1), cA + hstep, voffA);
        hook();
        if (wr == 1) PG8_BAR;
        PG8_WAIT_V(4); PG8_BAR;
        PG8_STAGE(PG8_SB(1, 0), cB + kstep, voffB); PG8_STAGE(PG8_SA(1, 0), cA + kstep, voffA); PG8_STAGE(PG8_SB(1, 1), cB + hstep + kstep, voffB);
        PG8_WAIT_V(6); PG8_BAR;
    }
    for (;;) {
        const bool has_next = S.next(ui + 1, nxt);
        const char* nA = has_next ? (const char*)g.A + (size_t)nxt.pm * tstep + (size_t)nxt.rofs * K * 2 : cA; const char* nB = has_next ? (const char*)g.Bt + (size_t)nxt.pn * tstep : cB;
        for (int t = 0; t < nt; t += 2) {
            const bool last = (t == nt - 2);
            const char* a1 = cA + (size_t)(t + 1) * kstep;
            const char* a2 = last ? nA : cA + (size_t)(t + 2) * kstep; const char* b2 = last ? nB : cB + (size_t)(t + 2) * kstep;
            const char* a3 = a2 + kstep; const char* b3 = b2 + kstep;
            if (last && has_next) S.a_ready(nxt);
            if constexpr (SP2) {
            PG8_LDB(B0, 0, 0); PG8_LDB(B1, 0, 1); PG8_SCHED; PG8_LDA(At, 0, 0); PG8_STAGE(PG8_SA(1, 1), a1 + hstep, voffA);
            PG8_WAIT_V(8); PG8_WAIT_L(0); PG8_BAR; PG8_MMA(0, 0, At, B0); PG8_MMA(0, 1, At, B1); PG8_BAR; PG8_SCHED;
            if constexpr (!HALFM) PG8_LDA(At, 0, 1); PG8_STAGE(PG8_SB(0, 0), b2, voffB); PG8_STAGE(PG8_SB(0, 1), b2 + hstep, voffB); PG8_STAGE(PG8_SA(0, 0), a2, voffA);
            PG8_WAIT_V(8); PG8_WAIT_L(0); PG8_BAR; if constexpr (!HALFM) { PG8_MMA(1, 0, At, B0); PG8_MMA(1, 1, At, B1); } PG8_BAR; PG8_SCHED;
            PG8_LDB(B0, 1, 0); PG8_LDB(B1, 1, 1); PG8_SCHED; PG8_LDA(At, 1, 0); PG8_STAGE(PG8_SA(0, 1), a2 + hstep, voffA);
            PG8_WAIT_V(8); PG8_WAIT_L(0); PG8_BAR; PG8_MMA(0, 0, At, B0); PG8_MMA(0, 1, At, B1); PG8_BAR; PG8_SCHED;
            if constexpr (!HALFM) PG8_LDA(At, 1, 1); PG8_STAGE(PG8_SB(1, 0), b3, voffB); PG8_STAGE(PG8_SB(1, 1), b3 + hstep, voffB); PG8_STAGE(PG8_SA(1, 0), a3, voffA);
            PG8_WAIT_V(8); PG8_WAIT_L(0); PG8_BAR; if constexpr (!HALFM) { PG8_MMA(1, 0, At, B0); PG8_MMA(1, 1, At, B1); } PG8_BAR; PG8_SCHED;
            } else {
            PG8_LDB(B0, 0, 0); PG8_SCHED; PG8_LDA(At, 0, 0); PG8_STAGE(PG8_SA(1, 1), a1 + hstep, voffA);
            PG8_WAIT_L(8); PG8_BAR; PG8_WAIT_L(0); PG8_MMA(0, 0, At, B0); PG8_BAR; PG8_SCHED;
            PG8_LDB(B1, 0, 1); PG8_STAGE(PG8_SB(0, 0), b2, voffB);
            PG8_BAR; PG8_WAIT_L(0); PG8_MMA(0, 1, At, B1); PG8_BAR;
            PG8_LDA(At, 0, 1); PG8_STAGE(PG8_SA(0, 0), a2, voffA);
            PG8_BAR; PG8_WAIT_L(0); PG8_MMA(1, 0, At, B0); PG8_BAR; PG8_SCHED;
            PG8_STAGE(PG8_SB(0, 1), b2 + hstep, voffB);
            PG8_WAIT_V(6); PG8_BAR; PG8_MMA(1, 1, At, B1); PG8_BAR;
            PG8_LDB(B0, 1, 0); PG8_SCHED; PG8_LDA(At, 1, 0); PG8_STAGE(PG8_SA(0, 1), a2 + hstep, voffA);
            PG8_WAIT_L(8); PG8_BAR; PG8_WAIT_L(0); PG8_MMA(0, 0, At, B0); PG8_BAR; PG8_SCHED;
            PG8_LDB(B1, 1, 1); PG8_STAGE(PG8_SB(1, 0), b3, voffB);
            PG8_BAR; PG8_WAIT_L(0); PG8_MMA(0, 1, At, B1); PG8_BAR;
            PG8_LDA(At, 1, 1); PG8_STAGE(PG8_SA(1, 0), a3, voffA);
            PG8_BAR; PG8_WAIT_L(0); PG8_MMA(1, 0, At, B0); PG8_BAR; PG8_SCHED;
            PG8_STAGE(PG8_SB(1, 1), b3 + hstep, voffB);
            PG8_WAIT_V(6); PG8_BAR; PG8_MMA(1, 1, At, B1); PG8_BAR;
            }
        }
        if constexpr (ALIGN_EPI) { if (wr == 0) PG8_BAR; }
        if constexpr (!Epi::AFTER_DRAIN) { E(acc, cur, wr, wc, fr, fq); S.done(cur); }
        if (!has_next) break;
#pragma unroll
        for (int a = 0; a < 2; ++a)
#pragma unroll
            for (int b = 0; b < 2; ++b)
#pragma unroll
                for (int m = 0; m < 4; ++m)
#pragma unroll
                    for (int n = 0; n < 2; ++n) acc[a][b][m][n] = (f32x4){0.f, 0.f, 0.f, 0.f};
        cur = nxt; cA = nA; cB = nB; ++ui;
        if constexpr (ALIGN_EPI) { if (wr == 1) PG8_BAR; }
    }
    PG8_WAIT_V(0);
    if constexpr (!ALIGN_EPI) { if (wr == 0) PG8_BAR; }
    PG8_BAR;
    if constexpr (Epi::AFTER_DRAIN) { E.fused(acc, cur, wr, wc, fr, fq, lds, wid, lane); S.done(cur); }
#undef PG8_SA
#undef PG8_SB
#undef PG8_STAGE
#undef PG8_LDA
#undef PG8_LDB
#undef PG8_MMA
#undef PG8_WAIT_V
#undef PG8_WAIT_L
#undef PG8_BAR
#undef PG8_SCHED
}
}
#define GAS __attribute__((address_space(1)))
#define LAS __attribute__((address_space(3)))
typedef unsigned short bf16;
typedef unsigned v4u __attribute__((ext_vector_type(4)));
typedef float f32x4 __attribute__((ext_vector_type(4)));
typedef short bf16x8 __attribute__((ext_vector_type(8)));
typedef GAS unsigned gu32;
typedef GAS unsigned long long gu64;
#define RLX_AGENT __ATOMIC_RELAXED, __HIP_MEMORY_SCOPE_AGENT
#define LDS_WAIT() asm volatile("s_waitcnt lgkmcnt(0)" ::: "memory")
#define VM_WAIT() asm volatile("s_waitcnt vmcnt(0)" ::: "memory")
__device__ __forceinline__ unsigned long long rt() { return __builtin_amdgcn_s_memrealtime(); }
__device__ __forceinline__ unsigned f2bf(float f) { unsigned u = __builtin_bit_cast(unsigned, f); return (u + 0x7fffu + ((u >> 16) & 1u)) >> 16; }
__device__ __forceinline__ unsigned pk2(float lo, float hi) { return f2bf(lo) | (f2bf(hi) << 16); }

#define XB_TMO      128
#define XB_XCNT(j)  (256  + 64 * (j))
#define XB_XSUB(j)  (1280 + 64 * (j))
#define XB_XGEN(j)  (2304 + 64 * (j))
#define XB_TOP      3328
#define XB_TOPGEN   3392
#define XCD_BAR_WORDS 3456
#define XB_SPIN_CAP (1u << 18)

__device__ __forceinline__ unsigned xb_ld(unsigned* p)              { return __hip_atomic_load(p, __ATOMIC_RELAXED, __HIP_MEMORY_SCOPE_AGENT); }
__device__ __forceinline__ unsigned xb_add(unsigned* p, unsigned v) { return __hip_atomic_fetch_add(p, v, __ATOMIC_RELAXED, __HIP_MEMORY_SCOPE_AGENT); }
__device__ __forceinline__ unsigned xb_xcc_id() { return (unsigned)__builtin_amdgcn_s_getreg((3 << 11) | 20) & 0xFu; }
#define XB_SPIN(cond, bar) do { unsigned _sp = 0; while (cond) { __builtin_amdgcn_s_sleep(1); \
    if ((++_sp & 255u) == 0u) { if (xb_ld(&(bar)[XB_TMO])) break; if (_sp > XB_SPIN_CAP) { atomicAdd(&(bar)[XB_TMO], 1u); break; } } } } while (0)

__device__ __forceinline__ void xb_spin_while_eq(unsigned* p, unsigned old, unsigned* bar) {
    unsigned v0 = xb_ld(p); __builtin_amdgcn_s_sleep(8); unsigned v1 = xb_ld(p); __builtin_amdgcn_s_sleep(8); unsigned v2 = xb_ld(p); __builtin_amdgcn_s_sleep(8); unsigned v3 = xb_ld(p);
    for (unsigned sp = 0;;) {
        if (v0 != old) return; v0 = xb_ld(p); __builtin_amdgcn_s_sleep(8);
        if (v1 != old) return; v1 = xb_ld(p); __builtin_amdgcn_s_sleep(8);
        if (v2 != old) return; v2 = xb_ld(p); __builtin_amdgcn_s_sleep(8);
        if (v3 != old) return; v3 = xb_ld(p); __builtin_amdgcn_s_sleep(8);
        if ((++sp & 63u) == 0u) { if (xb_ld(&bar[XB_TMO])) return; if (sp > (XB_SPIN_CAP >> 2)) { atomicAdd(&bar[XB_TMO], 1u); return; } }
    }
}

struct XcdBarrier {
    unsigned* bar; unsigned x;
    volatile LAS unsigned* st;
};

__device__ __forceinline__ XcdBarrier xcd_barrier_post(unsigned* bar, volatile LAS unsigned* st) {
    XcdBarrier b; b.bar = bar; b.x = xb_xcc_id(); b.st = st;
    if (threadIdx.x == 0) (void)xb_add(&bar[XB_XCNT(b.x)], 1u);
    return b;
}
__device__ __forceinline__ void xcd_barrier_complete(unsigned* bar, unsigned x, unsigned& nloc, unsigned& nx) {
    const unsigned G = gridDim.x * gridDim.y * gridDim.z;
    unsigned sum, cnt, mine, sp = 0u;
    for (;;) {
        sum = 0u; cnt = 0u; mine = 0u;
        unsigned cv[16];
#pragma unroll
        for (unsigned j = 0; j < 16; ++j) cv[j] = xb_ld(&bar[XB_XCNT(j)]);
        __builtin_amdgcn_sched_barrier(0);
#pragma unroll
        for (unsigned j = 0; j < 16; ++j) { const unsigned c = cv[j]; sum += c; cnt += (c > 0u) ? 1u : 0u; mine = (j == x) ? c : mine; }
        if (sum == G) break;
        __builtin_amdgcn_s_sleep(1);
        if ((++sp & 255u) == 0u) { if (xb_ld(&bar[XB_TMO])) break; if (sp > XB_SPIN_CAP) { atomicAdd(&bar[XB_TMO], 1u); break; } }
    }
    nloc = mine > 0u ? mine : 1u; nx = cnt > 0u ? cnt : 1u;
}

__device__ __forceinline__ void xcd_barrier(const XcdBarrier& b, const bool thread0) {
    asm volatile("s_waitcnt vmcnt(0)" ::: "memory");
    __syncthreads();
    if (thread0) {
        unsigned* bar = b.bar;
        __builtin_amdgcn_s_waitcnt(0);
        unsigned nloc = b.st[0], nx = b.st[1];
        if (nloc == 0u) { xcd_barrier_complete(bar, b.x, nloc, nx); b.st[0] = nloc; b.st[1] = nx; }
        const unsigned old = xb_add(&bar[XB_XSUB(b.x)], 1u);
        const unsigned gen = old / nloc;
        if (old + 1u == (gen + 1u) * nloc) {
            __builtin_amdgcn_fence(__ATOMIC_RELEASE, "agent");
            asm volatile("s_waitcnt vmcnt(0)" ::: "memory");
            const unsigned og = xb_add(&bar[XB_TOP], 1u);
            const unsigned tg = og / nx;
            if (og + 1u == (tg + 1u) * nx) xb_add(&bar[XB_TOPGEN], 1u);
            else xb_spin_while_eq(&bar[XB_TOPGEN], tg, bar);
            __builtin_amdgcn_fence(__ATOMIC_ACQUIRE, "agent");
            xb_add(&bar[XB_XGEN(b.x)], 1u);
            asm volatile("s_waitcnt vmcnt(0)" ::: "memory");
        } else {
            xb_spin_while_eq(&bar[XB_XGEN(b.x)], gen, bar);
            __builtin_amdgcn_fence(__ATOMIC_ACQUIRE, "agent");
            asm volatile("s_waitcnt vmcnt(0)" ::: "memory");
        }
    }
    __syncthreads();
}

constexpr int NWAVES = 8, NTHR = 512;
constexpr int D = 1024, T = 8192, NB = 2, M = NB * T, SB = 32, FF = 2816, NF2 = 5632, NH = 8, HD = 128, KVH = 4, KVD = 512;
constexpr int NPG = 64, PAGE = 128;
constexpr int NBLK = 32;
constexpr float EPS = 1e-6f;
constexpr size_t O_YP = 0, O_YS = 16777216, O_PCONV = 16809984, O_PH = 16822272, O_PK = 16826368, O_PV = 25214976, O_SCONV = 33603584, O_SH = 33800192, O_SK = 33865728, O_SV = 33882112, O_END = 33898496;
constexpr size_t MiB = 1u << 20;
constexpr size_t WS_CTL = 0;
constexpr size_t WS_RSS = 1 * MiB;
constexpr size_t WS_RSSS = 2 * MiB + 256 * 1024;
constexpr size_t WS_KM = 2 * MiB + 512 * 1024;
constexpr size_t WS_CNT = 2 * MiB + 768 * 1024;
constexpr size_t WS_SUMG = 3 * MiB;
constexpr size_t ZERO_BYTES = 4 * MiB;
constexpr size_t WS_WRGIN = 4 * MiB;
constexpr size_t WS_WG = WS_WRGIN + 8 * MiB;
constexpr size_t WS_WRGOUT = WS_WG + 1 * MiB;
constexpr size_t WS_WFIN = WS_WRGOUT + 4 * MiB;
constexpr size_t WS_WFOUT = WS_WFIN + 44 * MiB;
constexpr size_t WS_WQKV = WS_WFOUT + 22 * MiB;
constexpr size_t WS_WO = WS_WQKV + 6 * MiB;
constexpr size_t WS_X = WS_WO + 4 * MiB;
constexpr size_t WS_XB = WS_X + 64 * MiB;
constexpr size_t WS_GATE = WS_XB + 32 * MiB;
constexpr size_t WS_U = WS_GATE + 32 * MiB;
constexpr size_t WS_HG = WS_U + 32 * MiB;
constexpr size_t WS_ACT = WS_HG + 32 * MiB;
constexpr size_t WS_Q = WS_ACT + 88 * MiB;
constexpr size_t WS_KB = WS_Q + 32 * MiB;
constexpr size_t WS_VT = WS_KB + 16 * MiB;
constexpr size_t WS_OB = WS_VT + 16 * MiB;
constexpr size_t WS_PARTO = WS_OB + 32 * MiB;
constexpr size_t WS_PARTML = WS_PARTO + 96 * MiB;
constexpr size_t WS_LIST = WS_PARTML + 3 * MiB;
constexpr size_t WS_SUMM = WS_LIST + 16 * MiB;
constexpr size_t WS_KMC = WS_SUMM + 1 * MiB;
constexpr size_t WS_S = WS_KMC + 2 * MiB;
constexpr size_t WS_XS = WS_S, WS_XSB = WS_S + 128 * 1024, WS_PROJS = WS_S + 192 * 1024, WS_HGS = WS_S + 448 * 1024, WS_ACTS = WS_S + 512 * 1024, WS_QS = WS_S + 704 * 1024, WS_OSB = WS_S + 832 * 1024;
constexpr size_t WS_END = WS_S + 1 * MiB;
constexpr size_t WS_DX = WS_END + 16 * MiB, WS_DXB = WS_DX + 64 * MiB, WS_DRSS = WS_DXB + 32 * MiB, WS_DKM = WS_DRSS + 1 * MiB, WS_NEED = WS_DKM + 1 * MiB;
constexpr int RING_OFF = 0, RING_BYTES = 131072;
constexpr int LDS_MISC_OFF = 144384;
constexpr int LDS_BYTES = 147456;
constexpr int CW_BAR = 4096;
constexpr int CW_FINP = 8192, CW_FINS = 8192 + 64 * 64;

typedef unsigned short bf16;
typedef pg8::bf16x8 bf16x8;
typedef float f32x16 __attribute__((ext_vector_type(16)));
typedef unsigned u32x2 __attribute__((ext_vector_type(2)));
using pg8::rss_t; using pg8::RSS_SCALE; using pg8::RSS_INV; using pg8::cvt_pk_bf16; using pg8::fast_exp2; using pg8::fast_rcp; using pg8::sigmoidf_; using pg8::gelu_tanh; using pg8::silu_;

struct Args { const void* in[25]; float* out; unsigned char* ws; int ph_lo, ph_hi; };
struct Frame { LAS unsigned char* lds; int tid, lane, wave, bid, G; unsigned char* ws; float* out; };
__device__ __forceinline__ Frame make_frame(const Args& args, LAS unsigned char* lds, int wave_s) {
    Frame F; int t = pg8::tid_of(wave_s); asm volatile("" : "+v"(t)); F.tid = t; F.lane = t & 63; F.wave = __builtin_amdgcn_readfirstlane(t >> 6);
    F.bid = blockIdx.x; F.G = gridDim.x; F.lds = lds;
    GAS unsigned char* w = (GAS unsigned char*)args.ws; asm volatile("" : "+s"(w)); F.ws = (unsigned char*)w; GAS float* o = (GAS float*)args.out; asm volatile("" : "+s"(o)); F.out = (float*)o; return F;
}

__device__ __forceinline__ float wave_sum(float v) {
#pragma unroll
    for (int o = 1; o < 64; o <<= 1) v += __shfl_xor(v, o);
    return v;
}
__device__ __forceinline__ float wave_max(float v) {
#pragma unroll
    for (int o = 1; o < 64; o <<= 1) v = fmaxf(v, __shfl_xor(v, o));
    return v;
}
__device__ __forceinline__ unsigned short f2bf1(float f) { return (unsigned short)(cvt_pk_bf16(f, 0.f) & 0xffffu); }
__device__ __forceinline__ float bf2f(unsigned short b) { return __uint_as_float(((unsigned)b) << 16); }
__device__ __forceinline__ float bflo(unsigned w) { return __uint_as_float(w << 16); }
__device__ __forceinline__ float bfhi(unsigned w) { return __uint_as_float(w & 0xffff0000u); }

struct P0Item { const float* W; const float* g; bf16* WT; int K, N, k0, n0, drow0; };
__device__ __forceinline__ void p0_item_make(P0Item& d, const float* W, const float* g, int K, int N, bf16* WT, int mode, int row_off, int item) {
    const int nblk = N / 32, kb = item / nblk, nb = item % nblk; d.W = W; d.g = g; d.WT = WT; d.K = K; d.N = N; d.k0 = 64 * kb; d.n0 = 32 * nb;
    int drow0 = row_off + d.n0;
    if (mode == 1) { const int c = d.n0 < FF ? d.n0 : d.n0 - FF; drow0 = 256 * (c >> 7) + (c & 127) + (d.n0 < FF ? 0 : 128); }
    d.drow0 = drow0;
}
__device__ __forceinline__ void p0_item_load(const P0Item& d, f32x4 (&wv)[8], int lane) {
#pragma unroll
    for (int i = 0; i < 8; ++i) wv[i] = *(const f32x4*)(d.W + (size_t)(d.k0 + 8 * i + (lane >> 3)) * d.N + d.n0 + 4 * (lane & 7));
}
__device__ __forceinline__ void p0_item_finish(const P0Item& d, const f32x4 (&wv)[8], LAS float* scr, int lane) {
#pragma unroll
    for (int i = 0; i < 8; ++i) { const int kk = 8 * i + (lane >> 3); f32x4 v = wv[i]; if (d.g) v = v * d.g[d.k0 + kk]; LAS float* sp = scr + kk * 33 + 4 * (lane & 7); sp[0] = v[0]; sp[1] = v[1]; sp[2] = v[2]; sp[3] = v[3]; }
    LDS_WAIT(); asm volatile("" ::: "memory");
    const int c = lane & 7;
#pragma unroll
    for (int j = 0; j < 4; ++j) { const int n = (lane >> 3) + 8 * j; const LAS float* s = scr + (8 * c) * 33 + n;
        v4u o; o.x = cvt_pk_bf16(s[0 * 33], s[1 * 33]); o.y = cvt_pk_bf16(s[2 * 33], s[3 * 33]); o.z = cvt_pk_bf16(s[4 * 33], s[5 * 33]); o.w = cvt_pk_bf16(s[6 * 33], s[7 * 33]);
        *(v4u*)(d.WT + (size_t)(d.drow0 + n) * d.K + d.k0 + 8 * c) = o; }
    LDS_WAIT(); asm volatile("" ::: "memory");
}
__device__ __forceinline__ void p0_row(const float* xrow, bf16* orow, rss_t* ss_out, int lane) {
    const f32x4* xr = (const f32x4*)xrow + lane; f32x4 v[4]; float s = 0.f;
#pragma unroll
    for (int j = 0; j < 4; ++j) { v[j] = xr[64 * j]; s += (v[j].x * v[j].x + v[j].y * v[j].y) + (v[j].z * v[j].z + v[j].w * v[j].w); }
    s = wave_sum(s);
    u32x2* o8 = (u32x2*)orow + lane;
#pragma unroll
    for (int j = 0; j < 4; ++j) { u32x2 w; w.x = cvt_pk_bf16(v[j].x, v[j].y); w.y = cvt_pk_bf16(v[j].z, v[j].w); o8[64 * j] = w; }
    if (lane == 0) *ss_out = (rss_t)(s * RSS_SCALE);
}
constexpr int I_RGIN = 16 * 64, I_G = 2 * 4, I_RGOUT = 16 * 32, I_FIN = 16 * 176, I_FOUT = 44 * 32, I_SQ = 16 * 32;
constexpr int WL_RG = I_RGIN + 16 * I_G + I_RGOUT + I_FIN + I_FOUT, WL_A0 = 3 * I_SQ + I_FIN + I_FOUT, WL_A1 = 2 * I_SQ + I_FIN + I_FOUT;
__host__ __device__ constexpr int WL_BASE(int l) { return l == 0 ? 0 : l == 1 ? WL_RG : l == 2 ? 2 * WL_RG : l == 3 ? 2 * WL_RG + WL_A0 : 2 * WL_RG + WL_A0 + WL_A1; }
#define P0_DECODE(D, it_) do { int r = (it_); const float* g_mix = (const float*)A.in[7]; const float* g_ffn = (const float*)A.in[8]; \
        const int l = r < WL_BASE(1) ? 0 : r < WL_BASE(2) ? 1 : r < WL_BASE(3) ? 2 : 3; r -= WL_BASE(l); \
        if (l < 2) { \
            if (r < I_RGIN) { p0_item_make(D, (const float*)A.in[9] + (size_t)l * 1024 * 2048, g_mix + l * 1024, 1024, 2048, (bf16*)(ws + WS_WRGIN) + (size_t)l * 2048 * 1024, 0, 0, r); break; } r -= I_RGIN; \
            if (r < 16 * I_G) { const int q = r / I_G, nb = q >> 1, sel = q & 1;   \
                p0_item_make(D, (const float*)A.in[sel ? 14 : 12] + (size_t)(l * 8 + nb) * 128 * 128, nullptr, 128, 128, (bf16*)(ws + WS_WG) + (size_t)(l * 8 + nb) * 256 * 128, 0, sel * 128, r % I_G); break; } r -= 16 * I_G; \
            if (r < I_RGOUT) { p0_item_make(D, (const float*)A.in[17] + (size_t)l * 1024 * 1024, nullptr, 1024, 1024, (bf16*)(ws + WS_WRGOUT) + (size_t)l * 1024 * 1024, 0, 0, r); break; } r -= I_RGOUT; \
        } else if (l == 2) { \
            if (r < I_SQ) { p0_item_make(D, (const float*)A.in[20], g_mix + 2 * 1024, 1024, 1024, (bf16*)(ws + WS_WQKV), 0, 0, r); break; } r -= I_SQ; \
            if (r < I_SQ) { p0_item_make(D, (const float*)A.in[19], (const float*)A.in[18], 1024, 1024, (bf16*)(ws + WS_WQKV), 0, 1024, r); break; } r -= I_SQ; \
            if (r < I_SQ) { p0_item_make(D, (const float*)A.in[21], nullptr, 1024, 1024, (bf16*)(ws + WS_WO), 0, 0, r); break; } r -= I_SQ; \
        } else { \
            if (r < I_SQ) { p0_item_make(D, (const float*)A.in[20] + (size_t)1024 * 1024, g_mix + 3 * 1024, 1024, 1024, (bf16*)(ws + WS_WQKV) + (size_t)2048 * 1024, 0, 0, r); break; } r -= I_SQ; \
            if (r < I_SQ) { p0_item_make(D, (const float*)A.in[21] + (size_t)1024 * 1024, nullptr, 1024, 1024, (bf16*)(ws + WS_WO) + (size_t)1024 * 1024, 0, 0, r); break; } r -= I_SQ; \
        } \
        if (r < I_FIN) { p0_item_make(D, (const float*)A.in[22] + (size_t)l * 1024 * NF2, g_ffn + l * 1024, 1024, NF2, (bf16*)(ws + WS_WFIN) + (size_t)l * NF2 * 1024, 1, 0, r); break; } r -= I_FIN; \
        p0_item_make(D, (const float*)A.in[23] + (size_t)l * FF * 1024, nullptr, FF, 1024, (bf16*)(ws + WS_WFOUT) + (size_t)l * 1024 * FF, 0, 0, r); } while (0)
__device__ __forceinline__ void conv_shadow(Frame& F, const Args& A, int lcur, int slot, int shift, int nunits) {
    if (lcur >= 3) return;
    unsigned char* ws = F.ws;
    const int nidle = F.G - nunits, rank = (F.bid - (shift % F.G) - nunits + 2 * F.G) % F.G;
    if (rank >= nidle) return;
    const int cap0 = (F.G - 64) * 8, cap1 = (F.G - 32) * 8, cap2 = (F.G - 88) * 8;
    const int off = slot == 0 ? 0 : slot == 1 ? cap0 : slot == 2 ? cap0 + cap1 : cap0 + cap1 + cap2;
    const int nl = WL_BASE(lcur + 2) - WL_BASE(lcur + 1);
    const int end = slot == 3 ? nl : (off + (slot == 0 ? cap0 : slot == 1 ? cap1 : cap2) < nl ? off + (slot == 0 ? cap0 : slot == 1 ? cap1 : cap2) : nl);
    LAS float* scr = (LAS float*)(F.lds + (F.wave < 3 ? 32768 + F.wave * 8448 : 98304 + (F.wave - 3) * 8448));
    for (int it = off + rank * 8 + F.wave; it < end; it += nidle * 8) { P0Item d; f32x4 wv[8]; P0_DECODE(d, WL_BASE(lcur + 1) + it); p0_item_load(d, wv, F.lane); p0_item_finish(d, wv, scr, F.lane); }
}
__device__ __forceinline__ void p0_prologue(Frame& F, const Args& A) {
    LAS float* scr = (LAS float*)(F.lds + F.wave * 16384);
    const int gw = F.bid * NWAVES + F.wave, NGW = F.G * NWAVES;
    unsigned char* ws = F.ws;
    constexpr int NITEMS = WL_BASE(1);
    { P0Item dc, dn; f32x4 wa[8], wb[8];
      if (gw < NITEMS) { P0_DECODE(dc, gw); p0_item_load(dc, wa, F.lane);
#pragma unroll 1
        for (int it = gw; it < NITEMS; it += 2 * NGW) {
            { const int itn = it + NGW < NITEMS ? it + NGW : it; P0_DECODE(dn, itn); p0_item_load(dn, wb, F.lane); }
            p0_item_finish(dc, wa, scr, F.lane);
            if (it + NGW >= NITEMS) break;
            { const int itn = it + 2 * NGW < NITEMS ? it + 2 * NGW : it + NGW; P0_DECODE(dc, itn); p0_item_load(dc, wa, F.lane); }
            p0_item_finish(dn, wb, scr, F.lane);
        } } }
#define P0_ROWPTRS(m_, xp, op, sp) do { if ((m_) < M) { xp = (const float*)A.in[0] + (size_t)(m_) * D; op = (bf16*)(ws + WS_XB) + (size_t)(m_) * D; sp = (rss_t*)(ws + WS_RSS) + (m_); } \
        else { xp = (const float*)A.in[1] + (size_t)((m_) - M) * D; op = (bf16*)(ws + WS_XSB) + (size_t)((m_) - M) * D; sp = (rss_t*)(ws + WS_RSSS) + ((m_) - M); } } while (0)
#pragma unroll 1
    for (int m = gw; m < M + SB; m += 2 * NGW) {
        const int m2 = m + NGW < M + SB ? m + NGW : m;
        const float* x0; bf16* o0; rss_t* s0; const float* x1; bf16* o1; rss_t* s1;
        P0_ROWPTRS(m, x0, o0, s0); P0_ROWPTRS(m2, x1, o1, s1);
        f32x4 v0[4], v1[4];
#pragma unroll
        for (int j = 0; j < 4; ++j) { v0[j] = *((const f32x4*)x0 + F.lane + 64 * j); v1[j] = *((const f32x4*)x1 + F.lane + 64 * j); }
        float q0 = 0.f, q1 = 0.f;
#pragma unroll
        for (int j = 0; j < 4; ++j) { q0 += (v0[j].x * v0[j].x + v0[j].y * v0[j].y) + (v0[j].z * v0[j].z + v0[j].w * v0[j].w); q1 += (v1[j].x * v1[j].x + v1[j].y * v1[j].y) + (v1[j].z * v1[j].z + v1[j].w * v1[j].w); }
        q0 = wave_sum(q0); q1 = wave_sum(q1);
#pragma unroll
        for (int j = 0; j < 4; ++j) { u32x2 w; w.x = cvt_pk_bf16(v0[j].x, v0[j].y); w.y = cvt_pk_bf16(v0[j].z, v0[j].w); *((u32x2*)o0 + F.lane + 64 * j) = w;
            u32x2 w2; w2.x = cvt_pk_bf16(v1[j].x, v1[j].y); w2.y = cvt_pk_bf16(v1[j].z, v1[j].w); *((u32x2*)o1 + F.lane + 64 * j) = w2; }
        if (F.lane == 0) { *s0 = (rss_t)(q0 * RSS_SCALE); *s1 = (rss_t)(q1 * RSS_SCALE); }
    }
#undef P0_ROWPTRS
}

template <int NG, int NSTEP, int BATCH>
__device__ __forceinline__ void sgemm_tile(Frame& F, const bf16* A, int lda, const bf16* Bt, int ldb, int n0a, int n0b, LAS float* part, LAS float* fin) {
    static_assert(NSTEP % BATCH == 0, "batches");
    constexpr int ksl = NSTEP * 16; const int r = F.lane & 31, h = F.lane >> 5;
    f32x16 acc[NG];
#pragma unroll
    for (int g = 0; g < NG; ++g)
#pragma unroll
        for (int i = 0; i < 16; ++i) acc[g][i] = 0.f;
    const bf16* ap = A + (size_t)r * lda + F.wave * ksl + 8 * h;
    const bf16* bp0 = Bt + (size_t)(n0a + r) * ldb + F.wave * ksl + 8 * h;
    const bf16* bp1 = Bt + (size_t)(n0b + r) * ldb + F.wave * ksl + 8 * h;
#pragma unroll
    for (int k0 = 0; k0 < NSTEP; k0 += BATCH) {
        bf16x8 av[BATCH], b0v[BATCH], b1v[BATCH];
#pragma unroll
        for (int k = 0; k < BATCH; ++k) { av[k] = *(const bf16x8*)(ap + 16 * (k0 + k)); b0v[k] = *(const bf16x8*)(bp0 + 16 * (k0 + k)); if (NG == 2) b1v[k] = *(const bf16x8*)(bp1 + 16 * (k0 + k)); }
#pragma unroll
        for (int k = 0; k < BATCH; ++k) { acc[0] = __builtin_amdgcn_mfma_f32_32x32x16_bf16(av[k], b0v[k], acc[0], 0, 0, 0);
            if (NG == 2) acc[NG - 1] = __builtin_amdgcn_mfma_f32_32x32x16_bf16(av[k], b1v[k], acc[NG - 1], 0, 0, 0); }
    }
#pragma unroll
    for (int g = 0; g < NG; ++g)
#pragma unroll
        for (int i = 0; i < 16; ++i) { const int row = (i & 3) + 8 * (i >> 2) + 4 * h; part[g * 16384 + (F.wave * 32 + row) * 32 + r] = acc[g][i]; }
    __syncthreads();
    for (int e = F.tid; e < NG * 1024; e += NTHR) { const int g = e >> 10, idx = e & 1023; float s = 0.f;
#pragma unroll
        for (int w = 0; w < 8; ++w) s += part[g * 16384 + w * 1024 + idx];
        fin[g * 32 * 33 + (idx >> 5) * 33 + (idx & 31)] = s; }
    __syncthreads();
}
enum { SG_RGIN = 0, SG_RESID = 1, SG_FFNIN = 2, SG_QKV = 3, SG_RESFIN = 4 };
struct SgArgs { const bf16* A; int lda; const bf16* Bt; int K; int nunits; const rss_t* rss_in; rss_t* rss_out; const float* xin; float* xout; bf16* xbout; float* fout; bf16* bout; float* sk; float* sv; unsigned* fcnt; const float* gfin; };
template <int KIND, int KDIM>
__device__ __forceinline__ void sgemm_units(Frame& F, const SgArgs& S, int shift) {
    LAS float* part = (LAS float*)(F.lds + 32768); LAS float* fin = (LAS float*)(F.lds + 131072);
    for (int su = (F.bid + F.G - (shift % F.G)) % F.G; su < S.nunits; su += F.G) {
        rss_t pre_r[2]; float pre_x[2];
#pragma unroll
        for (int k = 0; k < 2; ++k) { const int e = F.tid + NTHR * k, m = e >> 5, n = e & 31; pre_r[k] = (KIND != SG_RESID && KIND != SG_RESFIN) ? S.rss_in[m] : (rss_t)0; pre_x[k] = (KIND == SG_RESID || KIND == SG_RESFIN) ? S.xin[m * 1024 + 32 * su + n] : 0.f; }
        if (KIND == SG_FFNIN) { const int n0 = 256 * (su >> 2) + 32 * (su & 3); sgemm_tile<2, 8, 8>(F, S.A, S.lda, S.Bt, KDIM, n0, n0 + 128, part, fin); }
        else sgemm_tile<1, KDIM / 128, (KDIM == 1024 ? 8 : 11)>(F, S.A, S.lda, S.Bt, KDIM, 32 * su, 32 * su, part, fin);
#pragma unroll
        for (int k = 0; k < 2; ++k) { const int e = F.tid + NTHR * k, m = e >> 5, n = e & 31; const float v = fin[m * 33 + n];
            const float rs = __builtin_amdgcn_rsqf((float)pre_r[k] * RSS_INV + EPS);
            if (KIND == SG_RGIN) { S.fout[m * 2048 + 32 * su + n] = v * rs; }
            if (KIND == SG_RESID) { const int c = 32 * su + n; const float x = pre_x[k] + v; S.xout[m * 1024 + c] = x; S.xbout[m * 1024 + c] = f2bf1(x);
                float ss = x * x;
#pragma unroll
                for (int o = 1; o < 32; o <<= 1) ss += __shfl_xor(ss, o);
                if (n == 0) atomicAdd(S.rss_out + m, (rss_t)(ss * RSS_SCALE)); }
            if (KIND == SG_RESFIN) { const int c = 32 * su + n; const float x = pre_x[k] + v; pre_x[k] = x;
                float ss = x * x;
#pragma unroll
                for (int o = 1; o < 32; o <<= 1) ss += __shfl_xor(ss, o);
                if (n == 0) atomicAdd(S.rss_out + m, (rss_t)(ss * RSS_SCALE)); (void)c; }
            if (KIND == SG_FFNIN) { const float g = v * rs, u = fin[32 * 33 + m * 33 + n] * rs; S.bout[m * FF + 32 * su + n] = f2bf1(silu_(g) * u); }
            if (KIND == SG_QKV) { const int c = 32 * su + n; float x = v * rs;
                if (c < 1536 && (su & 3) == 0) {
                    const int d = n & 15; float rev = 8192.0f * fast_exp2(-(float)d * (18.931568569324174f / 16.0f)) * 0.15915494309189535f; rev = rev - floorf(rev);
                    const float co = __builtin_amdgcn_cosf(rev), si = __builtin_amdgcn_sinf(rev); const float other = fin[m * 33 + (n ^ 16)] * rs;
                    x = n < 16 ? x * co - other * si : x * co + other * si; }
                if (c < 1024) S.fout[m * 1024 + c] = x * pg8::QSCALE; else if (c < 1536) S.sk[m * 512 + (c - 1024)] = x; else S.sv[m * 512 + (c - 1536)] = x; }
        }
        if (KIND == SG_RESFIN) {
            asm volatile("s_waitcnt vmcnt(0)" ::: "memory"); __syncthreads();
            if (F.tid == 0) { __hip_atomic_fetch_add(S.fcnt, 1u, __ATOMIC_RELAXED, __HIP_MEMORY_SCOPE_AGENT);
                for (unsigned sp = 0; sp < (1u << 22); ++sp) { if (__hip_atomic_load(S.fcnt, __ATOMIC_RELAXED, __HIP_MEMORY_SCOPE_AGENT) >= (unsigned)S.nunits) break; __builtin_amdgcn_s_sleep(2); } }
            __syncthreads();
#pragma unroll
            for (int k = 0; k < 2; ++k) { const int e = F.tid + NTHR * k, m = e >> 5, n = e & 31, c = 32 * su + n;
                const float rs = __builtin_amdgcn_rsqf((float)__hip_atomic_load(S.rss_out + m, __ATOMIC_RELAXED, __HIP_MEMORY_SCOPE_AGENT) * RSS_INV + EPS);
                S.fout[m * 1024 + c] = pre_x[k] * rs * S.gfin[c]; }
        }
        __syncthreads();
    }
}

__device__ __forceinline__ bf16x8 ld_bf16x8_g(const bf16* p) { return *(const bf16x8*)p; }
__device__ __forceinline__ f32x4 mfma16(const bf16x8 a, const bf16x8 b, const f32x4 c) { return __builtin_amdgcn_mfma_f32_16x16x32_bf16(a, b, c, 0, 0, 0); }
__device__ __forceinline__ float one_minus_exp(float x) {
    if (x > -0.3f) { const float p = x * (1.0f + x * (0.5f + x * (1.0f / 6.0f + x * (1.0f / 24.0f + x * (1.0f / 120.0f + x * (1.0f / 720.0f + x * (1.0f / 5040.0f))))))); return -p; }
    return 1.0f - fast_exp2(1.44269504089f * x);
}
__device__ __forceinline__ float softplus_neg(float lam) { return (lam > 15.f) ? __expf(-lam) : ((lam < -15.f) ? -lam : __logf(1.0f + __expf(-lam))); }
__device__ __forceinline__ void lru_ab(float ga, float gi, float nba, float nbi, float cch2, float uc, float& a, float& bb) {
    const float r = fast_rcp(1.0f + fast_exp2(fmaf(ga, -1.44269504089f, nba))), ig = fast_rcp(1.0f + fast_exp2(fmaf(gi, -1.44269504089f, nbi)));
    a = fast_exp2(cch2 * r); bb = __builtin_amdgcn_sqrtf(fmaxf(fmaf(-a, a, 1.0f), 0.f)) * (ig * uc);
}
typedef float f32x2s __attribute__((ext_vector_type(2)));
__device__ __forceinline__ void lru_ab2(f32x2s ga, f32x2s gi, float nba, float nbi, float cch2, f32x2s uc, f32x2s& a, f32x2s& bb) {
    const f32x2s k = (f32x2s){-1.44269504089f, -1.44269504089f}, one = (f32x2s){1.0f, 1.0f};
    const f32x2s za = ga * k + (f32x2s){nba, nba}, zi = gi * k + (f32x2s){nbi, nbi};
    const f32x2s da = (f32x2s){fast_exp2(za.x), fast_exp2(za.y)} + one, di = (f32x2s){fast_exp2(zi.x), fast_exp2(zi.y)} + one;
    const f32x2s r = (f32x2s){fast_rcp(da.x), fast_rcp(da.y)}, ig = (f32x2s){fast_rcp(di.x), fast_rcp(di.y)};
    const f32x2s ex = r * (f32x2s){cch2, cch2};
    a = (f32x2s){fast_exp2(ex.x), fast_exp2(ex.y)};
    const f32x2s t = one - a * a;
    float t0, t1; asm("v_max_f32 %0, %1, 0" : "=v"(t0) : "v"(t.x)); asm("v_max_f32 %0, %1, 0" : "=v"(t1) : "v"(t.y));
    bb = (f32x2s){__builtin_amdgcn_sqrtf(t0), __builtin_amdgcn_sqrtf(t1)} * (ig * uc);
}
constexpr int SC_RAWU = 0, SC_RAWG = 17408, SC_AT = 33792, SC_UCF = 51200, SC_KRED = 90112, SC_CW = 98304, SC_OUT = 102400, SC_AT_PITCH = 272, SC_UCF_PITCH = 132;
#define SC_BARRIER() do { asm volatile("s_waitcnt lgkmcnt(0)" ::: "memory"); __builtin_amdgcn_s_barrier(); asm volatile("" ::: "memory"); } while (0)
template <int PASS>
__device__ __forceinline__ void scan_phase(Frame& F, const Args& A, int l) {
    unsigned char* ws = F.ws;
    const bf16* U = (const bf16*)(ws + WS_U); const bf16* GT = (const bf16*)(ws + WS_GATE); bf16* HG = (bf16*)(ws + WS_HG);
    typedef __attribute__((address_space(1))) unsigned long long gu64_t;
    gu64_t* SUMG = (gu64_t*)(ws + WS_SUMG) + (size_t)l * 256 * 256; const unsigned epoch = (unsigned)l + 1u;
    const int lane = F.lane, fr = lane & 15, fq = lane >> 4, w = F.wave, tid = F.tid;
    LAS unsigned char* lds = F.lds;
    for (int unit = F.bid; unit < 256; unit += F.G) {
        const int b = unit >> 7, cb = (unit >> 4) & 7, c = unit & 15, ch0 = cb * 128, chl = 16 * w + fr, ch = ch0 + chl;
        const float ba = ((const float*)A.in[13])[l * 1024 + ch], bi = ((const float*)A.in[15])[l * 1024 + ch];
        const float lam = ((const float*)A.in[16])[l * 1024 + ch];
        const float sp = softplus_neg(lam);
        const float cch2 = -8.0f * sp * 1.44269504089f, nba = -1.44269504089f * ba, nbi = -1.44269504089f * bi;
        bf16x8 Ba[4], Bi[4];
        { const bf16* wg = (const bf16*)(ws + WS_WG) + ((size_t)(l * 8 + cb) * 256 + chl) * 128 + 8 * fq;
#pragma unroll
          for (int ks = 0; ks < 4; ++ks) { Ba[ks] = ld_bf16x8_g(wg + 32 * ks); Bi[ks] = ld_bf16x8_g(wg + 128 * 128 + 32 * ks); } }
        const int cg = tid & 15;
        float hin = 0.f, Arun = 1.f, Brun = 0.f;
        const int tc0 = c * 512;
        const int ku = ((l * 2 + (PASS - 1)) * 256 + unit) & 1023, kb_ = ku >> 5, kj_ = ku & 31;
        const GAS float* ckp[2];
#pragma unroll
        for (int pg = 0; pg < 2; ++pg) ckp[pg] = (const GAS float*)A.in[2] + (size_t)((const int*)A.in[6])[kb_ * NPG + 2 * kj_ + pg] * PAGE * KVD + (size_t)(tid >> 7) * KVD + 4 * (tid & 127);
        f32x4 kreg[8], ksum = (f32x4){0.f, 0.f, 0.f, 0.f};
#define SC_KLOAD(st_) do { const GAS float* kp_ = ckp[(st_) >> 2] + (size_t)(32 * ((st_) & 3)) * KVD; _Pragma("unroll") for (int k = 0; k < 8; ++k) kreg[k] = *(const GAS f32x4*)(kp_ + (size_t)(4 * k) * KVD); } while (0)
#define SC_KACC() do { _Pragma("unroll") for (int k = 0; k < 8; ++k) ksum += kreg[k]; } while (0)
        v4u pu[3], pgt[2];
#define SC_PREFETCH(st_) do { const int t0_ = tc0 + (st_) * 64; \
            _Pragma("unroll") for (int k = 0; k < 3; ++k) { const int p = tid + 512 * k, pc = p < 67 * 16 ? p : 67 * 16 - 1;     \
                const int t = t0_ - 3 + (pc >> 4); pu[k] = *(const v4u*)(U + ((size_t)(b * T + (t > 0 ? t : 0))) * 1024 + ch0 + 8 * (pc & 15));     \
                if (t0_ == 0) { if (t < 0) pu[k] = (v4u){0u, 0u, 0u, 0u}; } }     \
            if (PASS == 2) { _Pragma("unroll") for (int k = 0; k < 2; ++k) { const int p = tid + 512 * k; pgt[k] = *(const v4u*)(GT + ((size_t)(b * T + t0_ + (p >> 4))) * 1024 + ch0 + 8 * (p & 15)); } } } while (0)
#define SC_STORE_OUT(tbase_) do { _Pragma("unroll") for (int k = 0; k < 2; ++k) { const int p = tid + 512 * k; const v4u ov = *(const LAS v4u*)(lds + SC_OUT + p * 16); \
            *(v4u*)(HG + ((size_t)(b * T + (tbase_) + (p >> 4))) * 1024 + ch0 + 8 * (p & 15)) = ov; } } while (0)
        float cwv[5] = {0.f, 0.f, 0.f, 0.f, 0.f};
        if (tid < 128) {
#pragma unroll
            for (int q = 0; q < 4; ++q) cwv[q] = ((const float*)A.in[10])[(l * 4 + q) * 1024 + ch0 + tid];
            cwv[4] = ((const float*)A.in[11])[l * 1024 + ch0 + tid]; }
        SC_PREFETCH(0); SC_KLOAD(0);
        if (PASS == 2 && c > 0) {
            unsigned long long ga[15], gb[15]; gu64_t* g0 = SUMG + (size_t)((b * 8 + cb) * 16) * 256 + chl;
            for (unsigned sp = 0; sp < (1u << 20); ++sp) { bool ok = true;
#pragma unroll
                for (int j = 0; j < 15; ++j) { gu64_t* g = g0 + (size_t)(j < c ? j : 0) * 256; ga[j] = __hip_atomic_load(g, __ATOMIC_RELAXED, __HIP_MEMORY_SCOPE_AGENT); gb[j] = __hip_atomic_load(g + 128, __ATOMIC_RELAXED, __HIP_MEMORY_SCOPE_AGENT); }
#pragma unroll
                for (int j = 0; j < 15; ++j) ok = ok && (j >= c || ((unsigned)(ga[j] >> 32) == epoch && (unsigned)(gb[j] >> 32) == epoch));
                if (__all(ok)) break; __builtin_amdgcn_s_sleep(2); }
#pragma unroll
            for (int j = 0; j < 15; ++j) if (j < c) hin = __uint_as_float((unsigned)ga[j]) * hin + __uint_as_float((unsigned)gb[j]); }
        __syncthreads();
        if (tid < 128) { LAS float* cwl = (LAS float*)(lds + SC_CW);
#pragma unroll
            for (int q = 0; q < 5; ++q) cwl[q * 128 + tid] = cwv[q]; }
        __syncthreads();
        for (int st = 0; st < 8; ++st) {
            const int t0 = tc0 + st * 64;
            SC_BARRIER();
            if (PASS == 2 && st > 0) { SC_STORE_OUT(t0 - 64); }
#pragma unroll
            for (int k = 0; k < 3; ++k) { const int p = tid + 512 * k; if (p < 67 * 16) *(LAS v4u*)(lds + SC_RAWU + p * 16) = pu[k]; }
            if (PASS == 2) {
#pragma unroll
                for (int k = 0; k < 2; ++k) { const int p = tid + 512 * k, t = p >> 4; *(LAS v4u*)(lds + SC_RAWG + ((16 * ((t >> 2) & 3) + 4 * (t >> 4) + (t & 3)) * 16 + (p & 15)) * 16) = pgt[k]; } }
            SC_BARRIER();
            { const int stn = st + 1 < 8 ? st + 1 : 7; SC_PREFETCH(stn); SC_KACC(); SC_KLOAD(stn); }
#pragma unroll 1
            for (int k = 0; k < 2; ++k) { const int t = (tid >> 4) + 32 * k; float uc[8];
                f32x2s u2[4];
                { const LAS f32x4* cb4 = (const LAS f32x4*)(lds + SC_CW + (4 * 128 + 8 * cg) * 4); const f32x4 b0 = cb4[0], b1 = cb4[1];
                  u2[0] = (f32x2s){b0[0], b0[1]}; u2[1] = (f32x2s){b0[2], b0[3]}; u2[2] = (f32x2s){b1[0], b1[1]}; u2[3] = (f32x2s){b1[2], b1[3]}; }
#pragma unroll
                for (int q = 0; q < 4; ++q) { const v4u rw = *(const LAS v4u*)(lds + SC_RAWU + ((t + q) * 16 + cg) * 16);
                    const LAS f32x4* cw4 = (const LAS f32x4*)(lds + SC_CW + (q * 128 + 8 * cg) * 4); const f32x4 w0 = cw4[0], w1 = cw4[1];
                    u2[0] += (f32x2s){w0[0], w0[1]} * (f32x2s){bflo(rw.x), bfhi(rw.x)}; u2[1] += (f32x2s){w0[2], w0[3]} * (f32x2s){bflo(rw.y), bfhi(rw.y)};
                    u2[2] += (f32x2s){w1[0], w1[1]} * (f32x2s){bflo(rw.z), bfhi(rw.z)}; u2[3] += (f32x2s){w1[2], w1[3]} * (f32x2s){bflo(rw.w), bfhi(rw.w)}; }
                uc[0] = u2[0].x; uc[1] = u2[0].y; uc[2] = u2[1].x; uc[3] = u2[1].y; uc[4] = u2[2].x; uc[5] = u2[2].y; uc[6] = u2[3].x; uc[7] = u2[3].y;
                v4u o; o.x = cvt_pk_bf16(uc[0], uc[1]); o.y = cvt_pk_bf16(uc[2], uc[3]); o.z = cvt_pk_bf16(uc[4], uc[5]); o.w = cvt_pk_bf16(uc[6], uc[7]);
                const int tr = 16 * ((t >> 2) & 3) + 4 * (t >> 4) + (t & 3);
                *(LAS v4u*)(lds + SC_AT + tr * SC_AT_PITCH + cg * 16) = o;
                LAS float* uf = (LAS float*)(lds + SC_UCF) + tr * SC_UCF_PITCH + 8 * cg;
                *(LAS f32x4*)uf = (f32x4){uc[0], uc[1], uc[2], uc[3]}; *(LAS f32x4*)(uf + 4) = (f32x4){uc[4], uc[5], uc[6], uc[7]}; }
            SC_BARRIER();
            float av[16], bv[16];
#pragma unroll
            for (int s = 0; s < 4; ++s) {
                f32x4 aa = (f32x4){0.f, 0.f, 0.f, 0.f}, ai = (f32x4){0.f, 0.f, 0.f, 0.f};
#pragma unroll
                for (int ks = 0; ks < 4; ++ks) { const bf16x8 af = *(const LAS bf16x8*)(lds + SC_AT + (16 * s + fr) * SC_AT_PITCH + ks * 64 + fq * 16); aa = mfma16(af, Ba[ks], aa); ai = mfma16(af, Bi[ks], ai); }
#pragma unroll
                for (int i = 0; i < 4; i += 2) { const LAS float* up = (const LAS float*)(lds + SC_UCF) + (16 * s + 4 * fq + i) * SC_UCF_PITCH + chl; const f32x2s ucv = (f32x2s){up[0], up[SC_UCF_PITCH]};
                    f32x2s a2, b2; lru_ab2((f32x2s){aa[i], aa[i + 1]}, (f32x2s){ai[i], ai[i + 1]}, nba, nbi, cch2, ucv, a2, b2);
                    av[4 * s + i] = a2.x; av[4 * s + i + 1] = a2.y; bv[4 * s + i] = b2.x; bv[4 * s + i + 1] = b2.y; }
            }
            float Ac = 1.f, Bc = 0.f;
#pragma unroll
            for (int i = 0; i < 16; ++i) { Bc = av[i] * Bc + bv[i]; Ac = av[i] * Ac; }
            { const float Ap = __shfl_up(Ac, 16), Bp = __shfl_up(Bc, 16); if (fq >= 1) { Bc = Ac * Bp + Bc; Ac = Ac * Ap; } }
            { const float Ap = __shfl_up(Ac, 32), Bp = __shfl_up(Bc, 32); if (fq >= 2) { Bc = Ac * Bp + Bc; Ac = Ac * Ap; } }
            const float Atot = __shfl(Ac, 48 + fr), Btot = __shfl(Bc, 48 + fr);
            if (PASS == 1) { Brun = Atot * Brun + Btot; Arun = Atot * Arun; }
            else {
                float Ae = __shfl_up(Ac, 16), Be = __shfl_up(Bc, 16); if (fq == 0) { Ae = 1.f; Be = 0.f; }
                float h = Ae * hin + Be;
#pragma unroll
                for (int i = 0; i < 16; ++i) { const int tl = 16 * fq + i; h = av[i] * h + bv[i];
                    const float gv = bf2f(((const LAS unsigned short*)(lds + SC_RAWG))[(16 * (i >> 2) + 4 * fq + (i & 3)) * 128 + chl]);
                    ((LAS unsigned short*)(lds + SC_OUT))[tl * 128 + chl] = f2bf1(h * gv);
                    if (c == 15 && st == 7 && fq == 3 && i == 15) F.out[O_PH + (size_t)(l * 2 + b) * 1024 + ch] = h; }
                hin = Atot * hin + Btot;
            }
        }
        if (PASS == 2) { SC_BARRIER(); SC_STORE_OUT(tc0 + 448); }
        if (PASS == 1 && fq == 0) { gu64_t* g = SUMG + (size_t)((b * 8 + cb) * 16 + c) * 256 + chl;
            __hip_atomic_store(g, ((unsigned long long)epoch << 32) | __float_as_uint(Arun), __ATOMIC_RELAXED, __HIP_MEMORY_SCOPE_AGENT);
            __hip_atomic_store(g + 128, ((unsigned long long)epoch << 32) | __float_as_uint(Brun), __ATOMIC_RELAXED, __HIP_MEMORY_SCOPE_AGENT); }
        { LAS f32x4* red = (LAS f32x4*)(lds + SC_KRED); red[(tid >> 7) * 128 + (tid & 127)] = ksum; __syncthreads();
          if (tid < 128) { const f32x4 t = (red[tid] + red[128 + tid]) + (red[256 + tid] + red[384 + tid]); *((f32x4*)((float*)(ws + WS_KMC) + (size_t)ku * 512) + tid) = t * (1.0f / 256.0f); } }
        __syncthreads();
    }
}
__device__ __forceinline__ void srg_step(Frame& F, const Args& A, int l) {
    unsigned char* ws = F.ws; LAS unsigned char* lds = F.lds;
    const float* PROJ = (const float*)(ws + WS_PROJS); bf16* HGS = (bf16*)(ws + WS_HGS);
    const int lane = F.lane, fr = lane & 15, fq = lane >> 4, w = F.wave, tid = F.tid;
    for (int cb = F.bid; cb < 8; cb += F.G) {
        const int ch0 = cb * 128, chl = 16 * w + fr, ch = ch0 + chl;
        __syncthreads();
        { const int b = tid >> 4, cg = tid & 15; const int c0 = ch0 + 8 * cg;
          const float* sc = (const float*)A.in[4] + (size_t)((l * SB + b) * 3) * 1024 + c0;
          float* sco = F.out + O_SCONV + (size_t)((l * SB + b) * 3) * 1024 + c0;
          const float* cwp = (const float*)A.in[10] + (size_t)l * 4 * 1024 + c0;
          f32x4 sv[3][2], un[2], wv[4][2], bv[2];
#pragma unroll
          for (int q = 0; q < 3; ++q) { sv[q][0] = *(const f32x4*)(sc + q * 1024); sv[q][1] = *(const f32x4*)(sc + q * 1024 + 4); }
          un[0] = *(const f32x4*)(PROJ + b * 2048 + 1024 + c0); un[1] = *(const f32x4*)(PROJ + b * 2048 + 1024 + c0 + 4);
#pragma unroll
          for (int q = 0; q < 4; ++q) { wv[q][0] = *(const f32x4*)(cwp + q * 1024); wv[q][1] = *(const f32x4*)(cwp + q * 1024 + 4); }
          bv[0] = *(const f32x4*)((const float*)A.in[11] + l * 1024 + c0); bv[1] = *(const f32x4*)((const float*)A.in[11] + l * 1024 + c0 + 4);
          f32x4 u0 = bv[0] + wv[0][0] * sv[0][0] + wv[1][0] * sv[1][0] + wv[2][0] * sv[2][0] + wv[3][0] * un[0];
          f32x4 u1 = bv[1] + wv[0][1] * sv[0][1] + wv[1][1] * sv[1][1] + wv[2][1] * sv[2][1] + wv[3][1] * un[1];
          *(f32x4*)sco = sv[1][0]; *(f32x4*)(sco + 4) = sv[1][1]; *(f32x4*)(sco + 1024) = sv[2][0]; *(f32x4*)(sco + 1024 + 4) = sv[2][1]; *(f32x4*)(sco + 2048) = un[0]; *(f32x4*)(sco + 2048 + 4) = un[1];
          v4u o; o.x = cvt_pk_bf16(u0[0], u0[1]); o.y = cvt_pk_bf16(u0[2], u0[3]); o.z = cvt_pk_bf16(u1[0], u1[1]); o.w = cvt_pk_bf16(u1[2], u1[3]);
          *(LAS v4u*)(lds + SC_AT + b * SC_AT_PITCH + cg * 16) = o;
          LAS float* uf = (LAS float*)(lds + SC_UCF) + b * SC_UCF_PITCH + 8 * cg;
          *(LAS f32x4*)uf = u0; *(LAS f32x4*)(uf + 4) = u1; }
        __syncthreads();
        const float ba = ((const float*)A.in[13])[l * 1024 + ch], bi = ((const float*)A.in[15])[l * 1024 + ch];
        const float lam = ((const float*)A.in[16])[l * 1024 + ch];
        const float sp = softplus_neg(lam); const float cch = -8.0f * sp;
        const bf16* wg = (const bf16*)(ws + WS_WG) + ((size_t)(l * 8 + cb) * 256 + chl) * 128 + 8 * fq;
        bf16x8 Ba[4], Bi[4]; float h0v[2][4], gtv[2][4];
#pragma unroll
        for (int ks = 0; ks < 4; ++ks) { Ba[ks] = ld_bf16x8_g(wg + 32 * ks); Bi[ks] = ld_bf16x8_g(wg + 128 * 128 + 32 * ks); }
#pragma unroll
        for (int s = 0; s < 2; ++s)
#pragma unroll
            for (int i = 0; i < 4; ++i) { const int b = 16 * s + 4 * fq + i; h0v[s][i] = ((const float*)A.in[5])[(size_t)(l * SB + b) * 1024 + ch]; gtv[s][i] = PROJ[b * 2048 + ch]; }
#pragma unroll
        for (int s = 0; s < 2; ++s) {
            f32x4 aa = (f32x4){0.f, 0.f, 0.f, 0.f}, ai = (f32x4){0.f, 0.f, 0.f, 0.f};
#pragma unroll
            for (int ks = 0; ks < 4; ++ks) { const bf16x8 af = *(const LAS bf16x8*)(lds + SC_AT + (16 * s + fr) * SC_AT_PITCH + ks * 64 + fq * 16); aa = mfma16(af, Ba[ks], aa); ai = mfma16(af, Bi[ks], ai); }
#pragma unroll
            for (int i = 0; i < 4; ++i) { const int b = 16 * s + 4 * fq + i; const float ucv = ((const LAS float*)(lds + SC_UCF))[b * SC_UCF_PITCH + chl]; float a, bb; lru_ab(aa[i], ai[i], -1.44269504089f * ba, -1.44269504089f * bi, 1.44269504089f * cch, ucv, a, bb);
                const float h = a * h0v[s][i] + bb;
                F.out[O_SH + (size_t)(l * SB + b) * 1024 + ch] = h;
                HGS[b * 1024 + ch] = f2bf1(h * gelu_tanh(gtv[s][i])); }
        }
    }
}

constexpr int AT_K = 0, AT_KP = 256, AT_V = 65536, AT_VP = 544, AT_MISC = 135168;
__device__ __forceinline__ void sel_phase(Frame& F, int a, bool dry) {
    unsigned char* ws = F.ws; LAS unsigned char* lds = F.lds;
    const bf16* Q = (const bf16*)(ws + WS_Q); const float* KM = (const float*)(ws + WS_KM);
    unsigned* CNT = (unsigned*)(ws + WS_CNT) + a * 256 + (dry ? 1024 : 0); unsigned* LIST = (unsigned*)(ws + (dry ? WS_END : WS_LIST));
    LAS unsigned* cnt = (LAS unsigned*)(lds + AT_MISC); LAS unsigned* base = cnt + 32;
    const int lane = F.lane, r32 = lane & 31, hh5 = lane >> 5, tid = F.tid;
    for (int u = F.bid; u < 248; u += F.G) {
        const int bg = u / 31, qt = u % 31 + 1, b = bg >> 2, g = bg & 3;
        __syncthreads();
        if (tid < 32) cnt[tid] = 0u;
        __syncthreads();
        bf16x8 kmh[8], kml[8];
        { const float* kp = KM + (size_t)(b * 32 + r32) * 512 + g * 128 + 8 * hh5; f32x4 kx[8][2];
#pragma unroll
          for (int ks = 0; ks < 8; ++ks) { kx[ks][0] = *(const f32x4*)(kp + 16 * ks); kx[ks][1] = *(const f32x4*)(kp + 16 * ks + 4); }
#pragma unroll
          for (int ks = 0; ks < 8; ++ks) { const f32x4 x0 = kx[ks][0], x1 = kx[ks][1]; float x[8] = {x0[0], x0[1], x0[2], x0[3], x1[0], x1[1], x1[2], x1[3]};
              unsigned hw[4], lw[4];
#pragma unroll
              for (int j = 0; j < 4; ++j) { hw[j] = cvt_pk_bf16(x[2 * j], x[2 * j + 1]); lw[j] = cvt_pk_bf16(x[2 * j] - bflo(hw[j]), x[2 * j + 1] - bfhi(hw[j])); }
              v4u hv = (v4u){hw[0], hw[1], hw[2], hw[3]}, lv = (v4u){lw[0], lw[1], lw[2], lw[3]};
              kmh[ks] = __builtin_bit_cast(bf16x8, hv); kml[ks] = __builtin_bit_cast(bf16x8, lv); } }
        int selj[2][3]; unsigned rank[2][3];
        const int nsel = qt < 3 ? qt : 3;
        bf16x8 qf8[2][8];
#pragma unroll
        for (int tk = 0; tk < 2; ++tk) { const int task = F.wave + 8 * tk, hh = task >> 3, s32 = task & 7, h = 2 * g + hh;
            const bf16* qp = Q + ((size_t)(b * T + 256 * qt + 32 * s32 + r32)) * 1024 + h * 128 + 8 * hh5;
#pragma unroll
            for (int ks = 0; ks < 8; ++ks) qf8[tk][ks] = ld_bf16x8_g(qp + 16 * ks); }
        __builtin_amdgcn_sched_barrier(0);
#pragma unroll
        for (int tk = 0; tk < 2; ++tk) {
            const int task = F.wave + 8 * tk, hh = task >> 3, s32 = task & 7;
            f32x16 acc;
#pragma unroll
            for (int i = 0; i < 16; ++i) acc[i] = 0.f;
#pragma unroll
            for (int ks = 0; ks < 8; ++ks) { acc = __builtin_amdgcn_mfma_f32_32x32x16_bf16(kmh[ks], qf8[tk][ks], acc, 0, 0, 0); acc = __builtin_amdgcn_mfma_f32_32x32x16_bf16(kml[ks], qf8[tk][ks], acc, 0, 0, 0); }
            float sc[16];
#pragma unroll
            for (int i = 0; i < 16; ++i) { const int blk = (i & 3) + 8 * (i >> 2) + 4 * hh5; sc[i] = blk < qt ? acc[i] : -3.0e38f; }
#pragma unroll
            for (int rd = 0; rd < 3; ++rd) {
                float bv = -3.4e38f; int bi = 64;
#pragma unroll
                for (int i = 0; i < 16; ++i) { const int blk = (i & 3) + 8 * (i >> 2) + 4 * hh5; if (sc[i] > bv) { bv = sc[i]; bi = blk; } }
                const float ov = __shfl_xor(bv, 32); const int oi = __shfl_xor(bi, 32);
                if (ov > bv || (ov == bv && oi < bi)) { bv = ov; bi = oi; }
                selj[tk][rd] = bi;
#pragma unroll
                for (int i = 0; i < 16; ++i) { const int blk = (i & 3) + 8 * (i >> 2) + 4 * hh5; if (blk == bi) sc[i] = -3.4e38f; }
            }
            if (lane < 32) {
#pragma unroll
                for (int sl = 0; sl < 3; ++sl) if (sl < nsel) rank[tk][sl] = atomicAdd((unsigned*)(cnt + selj[tk][sl]), 1u);
            }
        }
        __syncthreads();
        if (tid < 32) { const unsigned n = cnt[tid]; base[tid] = n ? atomicAdd(CNT + (b * 4 + g) * 32 + tid, n) : 0u; }
        __syncthreads();
        if (lane < 32) {
#pragma unroll
            for (int tk = 0; tk < 2; ++tk) { const int task = F.wave + 8 * tk, hh = task >> 3, s32 = task & 7; const unsigned t = (unsigned)(256 * qt + 32 * s32 + r32);
#pragma unroll
                for (int sl = 0; sl < 3; ++sl) if (sl < nsel) { const int j = selj[tk][sl]; LIST[((size_t)((b * 4 + g) * 32 + j)) * 16384 + base[j] + rank[tk][sl]] = t | ((unsigned)hh << 13) | ((unsigned)sl << 14); } }
        }
    }
}
__device__ __forceinline__ void load_kv_block(Frame& F, int b, int g, int j) {
    const bf16* KB = (const bf16*)(F.ws + WS_KB) + ((size_t)(b * T + 256 * j)) * 512 + g * 128;
    const bf16* VT = (const bf16*)(F.ws + WS_VT) + ((size_t)(b * 4 + g) * 128) * 8192 + 256 * j;
    v4u kr[8], vr[8];
#pragma unroll
    for (int k = 0; k < 8; ++k) { const int p = F.tid + 512 * k; kr[k] = *(const v4u*)(KB + (size_t)(p >> 4) * 512 + 8 * (p & 15)); }
#pragma unroll
    for (int k = 0; k < 8; ++k) { const int p = F.tid + 512 * k; vr[k] = *(const v4u*)(VT + (size_t)(p >> 5) * 8192 + 8 * (p & 31)); }
#pragma unroll
    for (int k = 0; k < 8; ++k) { const int p = F.tid + 512 * k, key = p >> 4; *(LAS v4u*)(F.lds + AT_K + key * AT_KP + (((p & 15) ^ ((key & 3) + 4 * ((key >> 3) & 3))) * 16)) = kr[k]; }
#pragma unroll
    for (int k = 0; k < 8; ++k) { const int p = F.tid + 512 * k; *(LAS v4u*)(F.lds + AT_V + (p >> 5) * AT_VP + (p & 31) * 16) = vr[k]; }
}
__device__ __forceinline__ void kv_block_fetch(Frame& F, int b, int g, int j, v4u (&kr)[8], v4u (&vr)[8]) {
    const bf16* KB = (const bf16*)(F.ws + WS_KB) + ((size_t)(b * T + 256 * j)) * 512 + g * 128;
    const bf16* VT = (const bf16*)(F.ws + WS_VT) + ((size_t)(b * 4 + g) * 128) * 8192 + 256 * j;
#pragma unroll
    for (int k = 0; k < 8; ++k) { const int p = F.tid + 512 * k; kr[k] = *(const v4u*)(KB + (size_t)(p >> 4) * 512 + 8 * (p & 15)); }
#pragma unroll
    for (int k = 0; k < 8; ++k) { const int p = F.tid + 512 * k; vr[k] = *(const v4u*)(VT + (size_t)(p >> 5) * 8192 + 8 * (p & 31)); }
}
__device__ __forceinline__ void kv_block_store(Frame& F, const v4u (&kr)[8], const v4u (&vr)[8]) {
#pragma unroll
    for (int k = 0; k < 8; ++k) { const int p = F.tid + 512 * k, key = p >> 4; *(LAS v4u*)(F.lds + AT_K + key * AT_KP + (((p & 15) ^ ((key & 3) + 4 * ((key >> 3) & 3))) * 16)) = kr[k]; }
#pragma unroll
    for (int k = 0; k < 8; ++k) { const int p = F.tid + 512 * k; *(LAS v4u*)(F.lds + AT_V + (p >> 5) * AT_VP + (p & 31) * 16) = vr[k]; }
}
#define AT_SCHED __builtin_amdgcn_sched_barrier(0)
typedef float f32x2_t __attribute__((ext_vector_type(2)));
__device__ __forceinline__ float vmax3(float a, float b, float c_) { float r; asm("v_max3_f32 %0, %1, %2, %3" : "=v"(r) : "v"(a), "v"(b), "v"(c_)); return r; }
__device__ __forceinline__ f32x2_t vpk_sub(f32x2_t a, f32x2_t b) { f32x2_t r; asm("v_pk_add_f32 %0, %1, %2 neg_lo:[0,1] neg_hi:[0,1]" : "=v"(r) : "v"(a), "v"(b)); return r; }
__device__ __forceinline__ float vmax2(float a, float b) { float r; asm("v_max_f32 %0, %1, %2" : "=v"(r) : "v"(a), "v"(b)); return r; }
template <bool CAUSAL, bool DB = true>
__device__ __forceinline__ void attn_scores(LAS const unsigned char* lds, const bf16x8 (&qf)[4], int qidx, int fr, int fq, float mfloor, float& m_out, float& l_out, bf16x8 (&pf)[8], bf16x8 (&fb)[2][8]) {
    f32x4 s[16];
    LAS const unsigned char* kb4[4];
#pragma unroll
    for (int ks = 0; ks < 4; ++ks) kb4[ks] = lds + AT_K + (8 * (fr >> 2) + (fr & 3)) * AT_KP + (((4 * ks + fq) ^ fr) * 16);
#define AT_LOADK(buf, p) do { _Pragma("unroll") for (int odd = 0; odd < 2; ++odd) _Pragma("unroll") for (int ks = 0; ks < 4; ++ks) \
        fb[buf][odd * 4 + ks] = *(const LAS bf16x8*)(kb4[ks] + (32 * (p) + 4 * odd) * AT_KP); } while (0)
    AT_LOADK(0, 0);
#pragma unroll
    for (int p = 0; p < 8; ++p) {
        if (DB && p + 1 < 8) AT_LOADK((p + 1) & 1, p + 1);
        AT_SCHED;
#pragma unroll
        for (int odd = 0; odd < 2; ++odd) { f32x4 acc = (f32x4){0.f, 0.f, 0.f, 0.f};
#pragma unroll
            for (int ks = 0; ks < 4; ++ks) acc = mfma16(fb[DB ? (p & 1) : 0][odd * 4 + ks], qf[ks], acc);
            if (CAUSAL) {
#pragma unroll
                for (int i = 0; i < 4; ++i) if (32 * p + 8 * fq + 4 * odd + i > qidx) acc[i] = -1.0e30f; }
            s[2 * p + odd] = acc; }
        AT_SCHED;
        if (!DB && p + 1 < 8) AT_LOADK(0, p + 1);
    }
#undef AT_LOADK
    LAS const unsigned char* vbase = lds + AT_V + fr * AT_VP + fq * 16;
#pragma unroll
    for (int dt = 0; dt < 8; ++dt) fb[0][dt] = *(const LAS bf16x8*)(vbase + 16 * dt * AT_VP);
    float m0 = mfloor, m1 = -3.0e38f;
#pragma unroll
    for (int t = 0; t < 16; ++t) { m0 = vmax3(m0, s[t][0], s[t][1]); m1 = vmax3(m1, s[t][2], s[t][3]); }
    float m = vmax2(m0, m1);
    m = vmax2(m, __shfl_xor(m, 16)); m = vmax2(m, __shfl_xor(m, 32));
    f32x4 l4 = (f32x4){0.f, 0.f, 0.f, 0.f}; const f32x2_t m2 = (f32x2_t){m, m};
#pragma unroll
    for (int t = 0; t < 16; ++t) { const f32x2_t d0 = vpk_sub((f32x2_t){s[t][0], s[t][1]}, m2), d1 = vpk_sub((f32x2_t){s[t][2], s[t][3]}, m2);
        const f32x4 e = (f32x4){fast_exp2(d0.x), fast_exp2(d0.y), fast_exp2(d1.x), fast_exp2(d1.y)}; s[t] = e; l4 += e; }
    float l = (l4[0] + l4[1]) + (l4[2] + l4[3]);
    l += __shfl_xor(l, 16); l += __shfl_xor(l, 32);
#pragma unroll
    for (int p = 0; p < 8; ++p) { v4u pw; pw.x = cvt_pk_bf16(s[2 * p][0], s[2 * p][1]); pw.y = cvt_pk_bf16(s[2 * p][2], s[2 * p][3]); pw.z = cvt_pk_bf16(s[2 * p + 1][0], s[2 * p + 1][1]); pw.w = cvt_pk_bf16(s[2 * p + 1][2], s[2 * p + 1][3]);
        pf[p] = __builtin_bit_cast(bf16x8, pw); }
    m_out = m; l_out = l;
}
template <bool DB, bool ZERO>
__device__ __forceinline__ void attn_pv(LAS const unsigned char* lds, const bf16x8 (&pf)[8], int fr, int fq, f32x4 (&o)[8], bf16x8 (&fb)[2][8]) {
    LAS const unsigned char* vbase = lds + AT_V + fr * AT_VP + fq * 16;
    if (ZERO) {
#pragma unroll
        for (int dt = 0; dt < 8; ++dt) o[dt] = (f32x4){0.f, 0.f, 0.f, 0.f}; }
#pragma unroll
    for (int p = 0; p < 8; ++p) {
        if (DB && p + 1 < 8) {
#pragma unroll
            for (int dt = 0; dt < 8; ++dt) fb[(p + 1) & 1][dt] = *(const LAS bf16x8*)(vbase + 16 * dt * AT_VP + (p + 1) * 64); }
        AT_SCHED;
#pragma unroll
        for (int dt = 0; dt < 8; ++dt) o[dt] = mfma16(fb[DB ? (p & 1) : 0][dt], pf[p], o[dt]);
        AT_SCHED;
        if (!DB && p + 1 < 8) {
#pragma unroll
            for (int dt = 0; dt < 8; ++dt) fb[0][dt] = *(const LAS bf16x8*)(vbase + 16 * dt * AT_VP + (p + 1) * 64); }
    }
}
template <bool CAUSAL>
__device__ __forceinline__ void attn_tile(LAS const unsigned char* lds, const bf16x8 (&qf)[4], int npair, int qidx, int fr, int fq, float& m_out, float& l_out, f32x4 (&o)[8]) {
    bf16x8 pf[8], fb[2][8]; (void)npair;
    attn_scores<CAUSAL>(lds, qf, qidx, fr, fq, -1.0e30f, m_out, l_out, pf, fb);
    attn_pv<true, true>(lds, pf, fr, fq, o, fb);
}
__device__ __forceinline__ void att1_phase(Frame& F, const Args& A, int a, bool stage_next, bool with_satt) {
    unsigned char* ws = F.ws; LAS unsigned char* lds = F.lds;
    const bf16* Q = (const bf16*)(ws + WS_Q); const unsigned* CNT = (const unsigned*)(ws + WS_CNT) + a * 256; const unsigned* LIST = (const unsigned*)(ws + WS_LIST);
    unsigned char* PARTO = (unsigned char*)(ws + WS_PARTO); float* PARTML = (float*)(ws + WS_PARTML);
    LAS int* pre = (LAS int*)(lds + AT_MISC);
    const int lane = F.lane, fr = lane & 15, fq = lane >> 4, tid = F.tid;
    const bool sa_on = with_satt && F.bid < SB * NH;
    const int sb_ = F.bid >> 3, sh_ = F.bid & 7, sg_ = sh_ >> 1, r32 = lane & 31, hw = tid >> 5;
    const GAS float* sck = (const GAS float*)A.in[2]; const GAS float* scv = (const GAS float*)A.in[3];
    LAS float* q_s = (LAS float*)(lds + AT_MISC + 2048); LAS float* sc_s = q_s + 128; LAS int* sel_s = (LAS int*)(sc_s + 32); LAS int* pg_s = sel_s + 4;
    LAS int* cnt_s = (LAS int*)(lds + AT_MISC + 3072);
    int craw = 0; if (tid < 256) craw = (int)CNT[tid];
    const int cchunks = (craw + 127) >> 7;
    float qv_ = 0.f; f32x4 kg0 = (f32x4){0.f, 0.f, 0.f, 0.f}, kg1 = kg0;
    if (sa_on) { const float* QS = (const float*)(ws + WS_QS); const float* KMC = (const float*)(ws + WS_KMC);
        if (tid < 128) qv_ = QS[sb_ * 1024 + sh_ * 128 + tid];
        const float* kp = KMC + (size_t)(sb_ * 32 + (tid >> 4)) * 512 + sg_ * 128 + 8 * (tid & 15); kg0 = *(const f32x4*)kp; kg1 = *(const f32x4*)(kp + 4); }
    __builtin_amdgcn_sched_barrier(0);
    __syncthreads();
    if (tid < 8) pg_s[tid] = 0;
    int cscan = cchunks;
#pragma unroll
    for (int o = 1; o < 64; o <<= 1) { const int y = __shfl_up(cscan, o); if (lane >= o) cscan += y; }
    if (tid < 256 && lane == 63) pre[260 + F.wave] = cscan;
    if (tid < 256) cnt_s[tid] = craw;
    if (sa_on && tid < 128) q_s[tid] = qv_;
    __syncthreads();
    if (tid < 256) { int base = 0;
#pragma unroll
        for (int w = 0; w < 3; ++w) if (w < F.wave) base += pre[260 + w];
        pre[tid + 1] = base + cscan; }
    if (tid == 0) pre[0] = 0;
    if (sa_on) {
        const int* pt = (const int*)A.in[6];
        { const int j = tid >> 4, dg = tid & 15; float s = 0.f;
#pragma unroll
          for (int i = 0; i < 4; ++i) s += q_s[8 * dg + i] * kg0[i];
#pragma unroll
          for (int i = 0; i < 4; ++i) s += q_s[8 * dg + 4 + i] * kg1[i];
          s += __shfl_xor(s, 1); s += __shfl_xor(s, 2); s += __shfl_xor(s, 4); s += __shfl_xor(s, 8);
          if (dg == 0) sc_s[j] = s; }
        __syncthreads();
        if (tid < 32) { const float mine = sc_s[tid]; int rk = 0;
#pragma unroll
            for (int i = 0; i < 32; ++i) { const float ov = sc_s[i]; rk += (ov > mine || (ov == mine && i < tid)) ? 1 : 0; }
            if (rk < 3) sel_s[rk] = tid; }
        __syncthreads();
        if (tid < 6) pg_s[tid] = pt[sb_ * NPG + 2 * sel_s[tid >> 1] + (tid & 1)];
    }
    __syncthreads();
    f32x4 sq4 = (f32x4){0.f, 0.f, 0.f, 0.f}, sacc = (f32x4){0.f, 0.f, 0.f, 0.f}; float sm = -1.0e30f, sl_ = 0.f; int ski = sa_on ? 0 : 48;
    if (sa_on) sq4 = *(const LAS f32x4*)(q_s + 4 * r32);
    f32x4 skb[2], svb[2];
#define SA_LOADN(KB_, VB_, N_, BASE_) do { _Pragma("unroll") for (int j_ = 0; j_ < (N_); ++j_) { const int i_ = (BASE_) + j_ < 48 ? (BASE_) + j_ : 47; \
        const size_t o_ = ((size_t)(pg_s[i_ >> 3] * PAGE + hw + 16 * (i_ & 7)) * 4 + sg_) * 128 + 4 * r32; KB_[j_] = *(const GAS f32x4*)(sck + o_); VB_[j_] = *(const GAS f32x4*)(scv + o_); } } while (0)
#define SA_FOLDN(KB_, VB_, N_) do { _Pragma("unroll") for (int j_ = 0; j_ < (N_); ++j_) { float s_ = sq4[0] * KB_[j_][0] + sq4[1] * KB_[j_][1] + sq4[2] * KB_[j_][2] + sq4[3] * KB_[j_][3]; \
        s_ += __shfl_xor(s_, 1); s_ += __shfl_xor(s_, 2); s_ += __shfl_xor(s_, 4); s_ += __shfl_xor(s_, 8); s_ += __shfl_xor(s_, 16); \
        if (ski + j_ < 48) { const float mn_ = fmaxf(sm, s_), cs_ = fast_exp2(sm - mn_), p_ = fast_exp2(s_ - mn_); sl_ = sl_ * cs_ + p_; sacc = sacc * cs_ + VB_[j_] * p_; sm = mn_; } } ski += (N_); } while (0)
#define SA_ISSUE() SA_LOADN(skb, svb, 2, ski)
#define SA_CONSUME() do { float s0_ = sq4[0] * skb[0][0] + sq4[1] * skb[0][1] + sq4[2] * skb[0][2] + sq4[3] * skb[0][3], s1_ = sq4[0] * skb[1][0] + sq4[1] * skb[1][1] + sq4[2] * skb[1][2] + sq4[3] * skb[1][3]; \
        s0_ += __shfl_xor(s0_, 1); s1_ += __shfl_xor(s1_, 1); s0_ += __shfl_xor(s0_, 2); s1_ += __shfl_xor(s1_, 2); s0_ += __shfl_xor(s0_, 4); s1_ += __shfl_xor(s1_, 4); \
        s0_ += __shfl_xor(s0_, 8); s1_ += __shfl_xor(s1_, 8); s0_ += __shfl_xor(s0_, 16); s1_ += __shfl_xor(s1_, 16); \
        const float a0_ = ski < 48 ? s0_ : -3.0e38f, a1_ = ski + 1 < 48 ? s1_ : -3.0e38f; const float mn_ = vmax3(sm, a0_, a1_); \
        const float cs_ = fast_exp2(sm - mn_), p0_ = fast_exp2(a0_ - mn_), p1_ = fast_exp2(a1_ - mn_); \
        sl_ = sl_ * cs_ + (p0_ + p1_); sacc = sacc * cs_ + (svb[0] * p0_ + svb[1] * p1_); sm = mn_; ski += 2; } while (0)
    const int NI = pre[256];
    const int vb = (F.G & 7) == 0 ? (F.bid & 7) * (F.G >> 3) + (F.bid >> 3) : F.bid;
    const int i0 = (int)(((long)vb * NI) / F.G), i1 = (int)(((long)(vb + 1) * NI) / F.G);
    int li = 0;
    for (int it = i0; it < i1;) {
        while (pre[li + 1] <= it) ++li;
        const int seg_end = pre[li + 1] < i1 ? pre[li + 1] : i1;
        const int b = li >> 7, g = (li >> 5) & 3, j = li & 31, n = cnt_s[li];
        const int r0 = (it - pre[li]) * 128, r1t = (seg_end - pre[li]) * 128, r1 = r1t < n ? r1t : n, ng = (r1 - r0 + 15) >> 4;
        const unsigned* LL = LIST + (size_t)li * 16384;
#define A1_ENTRY(gi_) LL[(r0 + 16 * (gi_) + fr) < r1 ? (r0 + 16 * (gi_) + fr) : (r0 + 16 * (gi_))]
#define A1_LOADQ(dst, ent_) do { const bf16* qp_ = Q + ((size_t)(b * T + (int)((ent_) & 8191u))) * 1024 + (2 * g + (int)(((ent_) >> 13) & 1u)) * 128 + 8 * fq; \
        _Pragma("unroll") for (int ks = 0; ks < 4; ++ks) dst[ks] = ld_bf16x8_g(qp_ + 32 * ks); } while (0)
        int gi = F.wave; bf16x8 qf[4];
        unsigned ent_c, ent_n;
        { v4u kr[8], vr[8]; f32x4 pka[4], pva[4];
          { const int g0 = gi < ng ? gi : 0, g1 = gi + 8 < ng ? gi + 8 : g0; ent_c = A1_ENTRY(g0); ent_n = A1_ENTRY(g1); }
          AT_SCHED;
          kv_block_fetch(F, b, g, j, kr, vr);
          AT_SCHED;
          A1_LOADQ(qf, ent_c);
          SA_LOADN(pka, pva, 4, ski);
          __syncthreads();
          kv_block_store(F, kr, vr); __syncthreads();
          SA_FOLDN(pka, pva, 4); }
        if (F.wave & 4) __builtin_amdgcn_s_sleep(32);
        if (F.wave < ng) {
#pragma unroll 1
            for (; gi < ng; gi += 8) {
                const int g2 = gi + 16 < ng ? gi + 16 : gi; const unsigned ent_nn = A1_ENTRY(g2);
                SA_ISSUE();
                const bool valid = (r0 + 16 * gi + fr) < r1;
                const int t = ent_c & 8191, hh = (ent_c >> 13) & 1, sl = ent_c >> 14, h = 2 * g + hh; const size_t row = (size_t)(b * T + t);
                float m, l; f32x4 o[8];
                { bf16x8 pf[8], fb[2][8]; attn_scores<false, false>(lds, qf, 0, fr, fq, -1.0e30f, m, l, pf, fb);
                  AT_SCHED;
                  A1_LOADQ(qf, ent_n);
                  attn_pv<false, true>(lds, pf, fr, fq, o, fb); }
                const float inv = __builtin_amdgcn_rcpf(l); const size_t pb = (row * 8 + h) * 3 + sl;
                unsigned char* po = valid ? PARTO + pb * 128 + 32 * fq : (unsigned char*)(ws + WS_END) + 32 * lane; float* pm = valid ? PARTML + pb * 2 : (float*)(ws + WS_END + 65536) + 2 * lane;
                unsigned w8[8];
#pragma unroll
                for (int dt = 0; dt < 8; ++dt) { const f32x4 on = o[dt] * inv; int w_ = __builtin_amdgcn_cvt_pk_fp8_f32(on[0], on[1], 0, false); w_ = __builtin_amdgcn_cvt_pk_fp8_f32(on[2], on[3], w_, true); w8[dt] = (unsigned)w_; }
                *(v4u*)po = (v4u){w8[0], w8[1], w8[2], w8[3]}; *(v4u*)(po + 16) = (v4u){w8[4], w8[5], w8[6], w8[7]};
                if (fq == 0) { f32x2_t ml; ml.x = m; ml.y = l; *(f32x2_t*)pm = ml; }
                SA_CONSUME();
                ent_c = ent_n; ent_n = ent_nn;
            }
        }
#undef A1_ENTRY
#undef A1_LOADQ
        it = seg_end;
    }
    if (ski < 48) { f32x4 tka[8], tva[8], tkb[8], tvb[8];
        SA_LOADN(tka, tva, 8, ski);
#pragma unroll 1
        for (;;) { SA_LOADN(tkb, tvb, 8, ski + 8); SA_FOLDN(tka, tva, 8); if (ski >= 48) break;
                   SA_LOADN(tka, tva, 8, ski + 8); SA_FOLDN(tkb, tvb, 8); if (ski >= 48) break; } }
#undef SA_ISSUE
#undef SA_CONSUME
#undef SA_LOADN
#undef SA_FOLDN
    if (sa_on) {
        LAS float* comb = (LAS float*)lds;
        const float* sk = F.out + O_SK; const float* sv = F.out + O_SV; bf16* OSB = (bf16*)(ws + WS_OSB);
        __syncthreads();
        *(LAS f32x4*)(comb + hw * 132 + 4 + 4 * r32) = sacc; if (r32 == 0) { comb[hw * 132] = sm; comb[hw * 132 + 1] = sl_; }
        if (hw == 0) { const f32x4 k4 = *((const f32x4*)(sk + (size_t)(sb_ * 4 + sg_) * 128) + r32); float s = sq4[0] * k4[0] + sq4[1] * k4[1] + sq4[2] * k4[2] + sq4[3] * k4[3];
            s += __shfl_xor(s, 1); s += __shfl_xor(s, 2); s += __shfl_xor(s, 4); s += __shfl_xor(s, 8); s += __shfl_xor(s, 16);
            if (r32 == 0) comb[16 * 132] = s; }
        __syncthreads();
        if (tid < 128) { const float ss = comb[16 * 132]; float M_ = ss;
#pragma unroll
            for (int i = 0; i < 16; ++i) M_ = fmaxf(M_, comb[i * 132]);
            const float es = fast_exp2(ss - M_); float den = es, num = es * sv[(size_t)(sb_ * 4 + sg_) * 128 + tid];
#pragma unroll
            for (int i = 0; i < 16; ++i) { const float e = fast_exp2(comb[i * 132] - M_); den += e * comb[i * 132 + 1]; num += e * comb[i * 132 + 4 + tid]; }
            OSB[sb_ * 1024 + sh_ * 128 + tid] = f2bf1(num * __builtin_amdgcn_rcpf(den)); }
    }
    if (stage_next && F.bid < 256) {
        __syncthreads(); load_kv_block(F, F.bid >> 7, (F.bid >> 5) & 3, F.bid & 31); }
}
__device__ __forceinline__ void att2_phase(Frame& F, bool staged) {
    unsigned char* ws = F.ws; LAS unsigned char* lds = F.lds;
    const bf16* Q = (const bf16*)(ws + WS_Q); const unsigned char* PARTO = (const unsigned char*)(ws + WS_PARTO); const float* PARTML = (const float*)(ws + WS_PARTML); bf16* OB = (bf16*)(ws + WS_OB);
    const int lane = F.lane, fr = lane & 15, fq = lane >> 4;
    for (int u = F.bid; u < 256; u += F.G) {
        const int b = u >> 7, g = (u >> 5) & 3, qb = u & 31;
        const int nsl = qb < 3 ? qb : 3;
        bf16x8 qf[4]; f32x2_t ml[3], mln[3];
#define A2_ROW(k_) ((size_t)(b * T + 256 * qb + 16 * ((F.wave + 8 * (k_)) & 15) + fr))
#define A2_HEAD(k_) (2 * g + ((F.wave + 8 * (k_)) >> 4))
#define A2_LOAD(QD, MLD, k_) do { const size_t row_ = A2_ROW(k_); const int h_ = A2_HEAD(k_); const bf16* qp_ = Q + row_ * 1024 + h_ * 128 + 8 * fq; \
        _Pragma("unroll") for (int ks = 0; ks < 4; ++ks) QD[ks] = ld_bf16x8_g(qp_ + 32 * ks); \
        _Pragma("unroll") for (int sl = 0; sl < 3; ++sl) { MLD[sl].x = -1.0e30f; MLD[sl].y = 0.f; if (sl < nsl) MLD[sl] = *(const f32x2_t*)(PARTML + ((row_ * 8 + h_) * 3 + sl) * 2); } } while (0)
        A2_LOAD(qf, ml, 0);
        if (!(staged && u == F.bid)) { __syncthreads(); load_kv_block(F, b, g, qb); }
        __syncthreads();
        if (F.wave & 4) __builtin_amdgcn_s_sleep(32);
#pragma unroll 1
        for (int k = 0; k < 4; ++k) {
            const size_t row = A2_ROW(k); const int h = A2_HEAD(k), qidx = 16 * ((F.wave + 8 * k) & 15) + fr;
            v4u pw[3][2]; const unsigned char* po = PARTO + ((row * 8 + h) * 3) * 128 + 32 * fq;
#pragma unroll
            for (int sl = 0; sl < 3; ++sl) if (sl < nsl) { pw[sl][0] = *(const v4u*)(po + sl * 128); pw[sl][1] = *(const v4u*)(po + sl * 128 + 16); }
            float m, l; f32x4 o[8]; bf16x8 pf[8], fb[2][8];
            const float mfl = fmaxf(fmaxf(ml[0].x, ml[1].x), ml[2].x);
            attn_scores<true, false>(lds, qf, qidx, fr, fq, mfl, m, l, pf, fb);
            AT_SCHED;
            { const int k1 = k + 1 < 4 ? k + 1 : k; A2_LOAD(qf, mln, k1); }
            float den = l, wsl[3];
#pragma unroll
            for (int sl = 0; sl < 3; ++sl) { wsl[sl] = (sl < nsl) ? ml[sl].y * fast_exp2(ml[sl].x - m) : 0.f; den += wsl[sl]; }
#pragma unroll
            for (int dt = 0; dt < 8; ++dt) { f32x4 r = (f32x4){0.f, 0.f, 0.f, 0.f};
#pragma unroll
                for (int sl = 0; sl < 3; ++sl) if (sl < nsl) { const int w_ = (int)pw[sl][dt >> 2][dt & 3]; const f32x2_t lo = __builtin_amdgcn_cvt_pk_f32_fp8(w_, false), hi = __builtin_amdgcn_cvt_pk_f32_fp8(w_, true);
                    r[0] += wsl[sl] * lo.x; r[1] += wsl[sl] * lo.y; r[2] += wsl[sl] * hi.x; r[3] += wsl[sl] * hi.y; }
                o[dt] = r; }
            attn_pv<false, false>(lds, pf, fr, fq, o, fb);
            const float inv = __builtin_amdgcn_rcpf(den);
#pragma unroll
            for (int dt = 0; dt < 8; ++dt) { const f32x4 on = o[dt] * inv; u32x2 w; w.x = cvt_pk_bf16(on[0], on[1]); w.y = cvt_pk_bf16(on[2], on[3]);
                *(u32x2*)(OB + row * 1024 + h * 128 + 16 * dt + 4 * fq) = w; }
#pragma unroll
            for (int sl = 0; sl < 3; ++sl) ml[sl] = mln[sl];
        }
#undef A2_LOAD
#undef A2_ROW
#undef A2_HEAD
    }
}
constexpr int SA_Q = 0, SA_SC = 512, SA_SEL = 640, SA_PG = 672, SA_LG = 1024, SA_RED = 4352, SA_OP = 4608;
#define SA_BARRIER() do { asm volatile("s_waitcnt lgkmcnt(0)" ::: "memory"); __builtin_amdgcn_s_barrier(); asm volatile("" ::: "memory"); } while (0)
__device__ __forceinline__ void satt_phase(Frame& F, const Args& A) {
    unsigned char* ws = F.ws; LAS unsigned char* lds = F.lds;
    const float* QS = (const float*)(ws + WS_QS); const float* KMC = (const float*)(ws + WS_KMC); bf16* OSB = (bf16*)(ws + WS_OSB);
    const float* ck = (const float*)A.in[2]; const float* cv = (const float*)A.in[3]; const int* pt = (const int*)A.in[6];
    const float* sk = F.out + O_SK; const float* sv = F.out + O_SV;
    LAS float* q_s = (LAS float*)(lds + SA_Q); LAS float* sc_s = (LAS float*)(lds + SA_SC); LAS int* sel_s = (LAS int*)(lds + SA_SEL); LAS int* pg_s = (LAS int*)(lds + SA_PG); LAS float* lg = (LAS float*)(lds + SA_LG);
    LAS float* red = (LAS float*)(lds + SA_RED); LAS f32x4* op = (LAS f32x4*)(lds + SA_OP);
    const int tid = F.tid, lane = F.lane;
    for (int u = F.bid; u < SB * NH; u += F.G) {
        const int b = u >> 3, h = u & 7, g = h >> 1;
        __syncthreads();
        if (tid < 128) q_s[tid] = QS[b * 1024 + h * 128 + tid];
        __syncthreads();
        { const int j = tid >> 4, dg = tid & 15; const float* kp = KMC + (size_t)(b * 32 + j) * 512 + g * 128 + 8 * dg; float s = 0.f;
#pragma unroll
          for (int i = 0; i < 8; ++i) s += q_s[8 * dg + i] * kp[i];
          s += __shfl_xor(s, 1); s += __shfl_xor(s, 2); s += __shfl_xor(s, 4); s += __shfl_xor(s, 8);
          if (dg == 0) sc_s[j] = s; }
        __syncthreads();
        if (tid == 0) { float v[32];
#pragma unroll
            for (int i = 0; i < 32; ++i) v[i] = sc_s[i];
#pragma unroll
            for (int rd = 0; rd < 3; ++rd) { float bv = -3.4e38f; int bi = 0;
#pragma unroll
                for (int i = 0; i < 32; ++i) if (v[i] > bv) { bv = v[i]; bi = i; }
                sel_s[rd] = bi;
#pragma unroll
                for (int i = 0; i < 32; ++i) if (i == bi) v[i] = -3.4e38f; } }
        __syncthreads();
        if (tid < 6) pg_s[tid] = pt[b * NPG + 2 * sel_s[tid >> 1] + (tid & 1)];
        __syncthreads();
        const int r32 = lane & 31, hw = tid >> 5;
        const f32x4 q4 = *(const LAS f32x4*)(q_s + 4 * r32);
        f32x4 ka[8], kb[8];
#define SA_LOAD(dst, base_, bt_) do { const f32x4* p_ = (const f32x4*)((base_) + ((size_t)(pg_s[bt_] * PAGE + hw) * 4 + g) * 128) + r32; _Pragma("unroll") for (int i = 0; i < 8; ++i) dst[i] = p_[(size_t)i * 2048]; } while (0)
#define SA_DOT(src, bt_) do { _Pragma("unroll") for (int i = 0; i < 8; ++i) { float s = q4[0] * src[i][0] + q4[1] * src[i][1] + q4[2] * src[i][2] + q4[3] * src[i][3]; \
            s += __shfl_xor(s, 1); s += __shfl_xor(s, 2); s += __shfl_xor(s, 4); s += __shfl_xor(s, 8); s += __shfl_xor(s, 16); if (r32 == 0) lg[(bt_) * 128 + hw + 16 * i] = s; } } while (0)
        SA_LOAD(ka, ck, 0);
#pragma unroll
        for (int bt = 0; bt < 6; bt += 2) {
            SA_LOAD(kb, ck, bt + 1); SA_DOT(ka, bt);
            if (bt + 2 < 6) SA_LOAD(ka, ck, bt + 2); else SA_LOAD(ka, cv, 0);
            SA_DOT(kb, bt + 1);
        }
        if (hw == 0) { const f32x4 k4 = *((const f32x4*)(sk + (size_t)(b * 4 + g) * 128) + r32); float s = q4[0] * k4[0] + q4[1] * k4[1] + q4[2] * k4[2] + q4[3] * k4[3];
            s += __shfl_xor(s, 1); s += __shfl_xor(s, 2); s += __shfl_xor(s, 4); s += __shfl_xor(s, 8); s += __shfl_xor(s, 16);
            if (r32 == 0) lg[768] = s; }
        SA_BARRIER();
        float mx = -3.4e38f;
        for (int i = tid; i < 769; i += NTHR) mx = fmaxf(mx, lg[i]);
        mx = wave_max(mx); if (lane == 0) red[F.wave] = mx;
        SA_BARRIER();
        mx = red[0];
#pragma unroll
        for (int i = 1; i < 8; ++i) mx = fmaxf(mx, red[i]);
        SA_BARRIER();
        float sm = 0.f;
        for (int i = tid; i < 769; i += NTHR) { const float e = fast_exp2(lg[i] - mx); lg[i] = e; sm += e; }
        sm = wave_sum(sm); if (lane == 0) red[F.wave] = sm;
        SA_BARRIER();
        sm = 0.f;
#pragma unroll
        for (int i = 0; i < 8; ++i) sm += red[i];
        f32x4 acc = (f32x4){0.f, 0.f, 0.f, 0.f};
#define SA_ACC(src, bt_) do { _Pragma("unroll") for (int i = 0; i < 8; ++i) acc += src[i] * lg[(bt_) * 128 + hw + 16 * i]; } while (0)
#pragma unroll
        for (int bt = 0; bt < 6; bt += 2) {
            SA_LOAD(kb, cv, bt + 1); SA_ACC(ka, bt);
            if (bt + 2 < 6) SA_LOAD(ka, cv, bt + 2);
            SA_ACC(kb, bt + 1);
        }
#undef SA_ACC
#undef SA_DOT
#undef SA_LOAD
        if (hw == 0) { const f32x4 v4 = *((const f32x4*)(sv + (size_t)(b * 4 + g) * 128) + r32); acc += v4 * lg[768]; }
        op[hw * 32 + r32] = acc;
        __syncthreads();
        if (tid < 32) { f32x4 t = op[tid];
#pragma unroll
            for (int i = 1; i < 16; ++i) t += op[i * 32 + tid];
            t = t * (1.0f / sm);
            u32x2 w; w.x = cvt_pk_bf16(t[0], t[1]); w.y = cvt_pk_bf16(t[2], t[3]); *(u32x2*)(OSB + b * 1024 + h * 128 + 4 * tid) = w; }
    }
}
__device__ __forceinline__ void final_phase(Frame& F, const Args& A) {
    unsigned char* ws = F.ws; const float* gf = (const float*)A.in[24];
    const int gw = F.bid * NWAVES + F.wave, NGW = F.G * NWAVES;
    f32x4 gv[4];
#pragma unroll
    for (int j = 0; j < 4; ++j) gv[j] = *((const f32x4*)gf + F.lane + 64 * j);
#pragma unroll 1
    for (int m0 = gw; m0 < M + SB; m0 += 2 * NGW) {
        f32x4 xv[2][4]; rss_t sv[2]; float* yp[2]; bool live[2];
#pragma unroll
        for (int k = 0; k < 2; ++k) { const int m = m0 + k * NGW < M + SB ? m0 + k * NGW : m0; live[k] = (k == 0) || (m0 + NGW < M + SB); const bool P = m < M; const int r = P ? m : m - M;
            sv[k] = P ? ((const rss_t*)(ws + WS_RSS))[8 * M + r] : ((const rss_t*)(ws + WS_RSSS))[8 * SB + r];
            yp[k] = P ? F.out + O_YP + (size_t)r * D : F.out + O_YS + (size_t)r * D;
            if (P) { const u32x2* xbr = (const u32x2*)((const bf16*)(ws + WS_XB) + (size_t)r * D);
#pragma unroll
                for (int j = 0; j < 4; ++j) { const u32x2 w = xbr[F.lane + 64 * j]; xv[k][j] = (f32x4){bflo(w.x), bfhi(w.x), bflo(w.y), bfhi(w.y)}; }
            } else { const float* x = (const float*)(ws + WS_XS) + (size_t)r * D;
#pragma unroll
                for (int j = 0; j < 4; ++j) xv[k][j] = *((const f32x4*)x + F.lane + 64 * j); } }
#pragma unroll
        for (int k = 0; k < 2; ++k) { const float rs = 1.0f / sqrtf((float)sv[k] * (1.0f / 16777216.0f) * (1.0f / 1024.0f) + EPS);
            if (live[k]) {
#pragma unroll
                for (int j = 0; j < 4; ++j) *((f32x4*)yp[k] + F.lane + 64 * j) = xv[k][j] * rs * gv[j]; } }
    }
}

constexpr int NPH = 30;
#ifndef MK_MULTI
#define MK_MULTI 0
#endif
__global__ void __launch_bounds__(NTHR, 2) yoco_fwd(Args args) {
    extern __shared__ __attribute__((aligned(16))) unsigned char lds_raw[];
    LAS unsigned char* const lds_base = (LAS unsigned char*)lds_raw;
    volatile LAS unsigned* MISC = (volatile LAS unsigned*)(lds_base + LDS_MISC_OFF);
    if (threadIdx.x < 32) MISC[threadIdx.x] = 0u;
    const int wave_s = __builtin_amdgcn_readfirstlane((int)threadIdx.x >> 6);
    __syncthreads();
#ifndef REPMASK
#define REPMASK 0u
#endif
#define REPMASK_IS_ZERO (REPMASK == 0u)
#define lo (args.ph_lo)
#define hi (args.ph_hi)
#define hi_bar ((gridDim.x == 256 && lo <= 28 && hi > 29 && REPMASK_IS_ZERO) ? 29 : hi)
    unsigned* ctl = (unsigned*)(args.ws + WS_CTL);
    XcdBarrier bar; bar.bar = ctl + CW_BAR; bar.x = 0; bar.st = MISC + 8;
    if (hi - lo > 1) bar = xcd_barrier_post(ctl + CW_BAR, MISC + 8);
#ifndef PHMASK
#define PHMASK 0xFFFFFFFFu
#endif
#define PH_BEGIN(id, bit) if (((PHMASK >> (bit)) & 1u) && lo <= (id) && (id) < hi) { Frame F = make_frame(args, lds_base, wave_s); unsigned char* ws = F.ws; \
    rss_t* RSS = (rss_t*)(ws + WS_RSS); rss_t* RSSS = (rss_t*)(ws + WS_RSSS); bf16* XB = (bf16*)(ws + WS_XB); float* X = (float*)(ws + WS_X); float* XS = (float*)(ws + WS_XS); bf16* XSB = (bf16*)(ws + WS_XSB); \
    LAS unsigned char* ring = F.lds + RING_OFF; (void)RSS; (void)RSSS; (void)XB; (void)X; (void)XS; (void)XSB; (void)ring; \
    const rss_t* rss_in = RSS + (size_t)(2 * l) * M; rss_t* rss_mid = RSS + (size_t)(2 * l + 1) * M; rss_t* rss_out = RSS + (size_t)(2 * l + 2) * M; \
    const rss_t* rsss_in = RSSS + (2 * l) * SB; rss_t* rsss_mid = RSSS + (2 * l + 1) * SB; rss_t* rsss_out = RSSS + (2 * l + 2) * SB; (void)rss_in; (void)rss_mid; (void)rss_out; (void)rsss_in; (void)rsss_mid; (void)rsss_out; \
    for (int rep = (int)((REPMASK >> (bit)) & 1u); rep >= 0; --rep) { const bool dry = rep > 0; (void)dry;
#ifndef PROBE_SCAN1_EXTRA
#define PROBE_SCAN1_EXTRA
#endif
#ifndef PROBE_SCAN2_EXTRA
#define PROBE_SCAN2_EXTRA
#endif
#define RS_TAB ((LAS float*)(F.lds + 140544))
#define RS_LOAD(rssp) rss_t rs_raw_ = (hasu && F.tid < 256) ? (rssp)[u0.pm * 256 + F.tid] : (rss_t)0
#define RS_STORE() do { if (hasu && F.tid < 256) RS_TAB[F.tid] = pg8::rs_of(rs_raw_); } while (0)
#ifndef PROBE_BAR_EXTRA
#define PROBE_BAR_EXTRA
#endif
#define PH_END(id) } if ((id) + 1 < hi_bar) { xcd_barrier(bar, pg8::tid_of(wave_s) == 0); PROBE_BAR_EXTRA } }

    { const int l = 0; PH_BEGIN(0, 0) p0_prologue(F, args); PH_END(0) }

    for (int l = 0; l < 4; ++l) {
        const int pb = 1 + 7 * l;
        if (l < 2) {
            PH_BEGIN(pb + 0, 1)
                pg8::StaticOrder SO; SO.init(M, 2048, F.G, F.bid); pg8::Unit u0{}; const bool hasu = SO.next(0, u0);
                auto hook = [&]() { RS_LOAD(rss_in); { SgArgs S{}; S.A = XSB; S.lda = 1024; S.Bt = (const bf16*)(ws + WS_WRGIN) + (size_t)l * 2048 * 1024; S.K = 1024; S.nunits = 64; S.rss_in = rsss_in; S.fout = (float*)(ws + WS_PROJS);
                  sgemm_units<SG_RGIN, 1024>(F, S, 0); }
                  if (!dry) { conv_shadow(F, args, l, 0, 0, 64); } RS_STORE(); __syncthreads(); };
                { pg8::Gemm g{XB, (const bf16*)(ws + WS_WRGIN) + (size_t)l * 2048 * 1024, M, 2048, 1024}; g.wv = F.wave; pg8::StaticOrder S = SO;
                  pg8::EpiRgIn E{rss_in, (bf16*)(ws + WS_GATE), (bf16*)(ws + WS_U), F.out + O_PCONV + (size_t)l * 2 * 3 * 1024}; E.rsl = RS_TAB; E.rs_pm = hasu ? u0.pm : -1;
                  pg8::gemm_phase<pg8::EpiRgIn, pg8::StaticOrder, true, true, false>(ring, g, S, E, hook); }
            PH_END(pb + 0)
            PH_BEGIN(pb + 1, 2) scan_phase<1>(F, args, l); PROBE_SCAN1_EXTRA srg_step(F, args, l); scan_phase<2>(F, args, l); PROBE_SCAN2_EXTRA PH_END(pb + 1)
            PH_BEGIN(pb + 4, 4)
                auto hook = [&]() { { SgArgs S{}; S.A = (const bf16*)(ws + WS_HGS); S.lda = 1024; S.Bt = (const bf16*)(ws + WS_WRGOUT) + (size_t)l * 1024 * 1024; S.K = 1024; S.nunits = 32;
                  S.xin = l == 0 ? (const float*)args.in[1] : XS; S.xout = XS; S.xbout = XSB; S.rss_out = rsss_mid; if (!dry) sgemm_units<SG_RESID, 1024>(F, S, 0); }
                  if (!dry) { conv_shadow(F, args, l, 1, 0, 32); } __syncthreads(); };
                { pg8::Gemm g{(const bf16*)(ws + WS_HG), (const bf16*)(ws + WS_WRGOUT) + (size_t)l * 1024 * 1024, M, 1024, 1024}; g.wv = F.wave; pg8::StaticOrder S; S.init(M, 1024, F.G, F.bid);
                  pg8::EpiResid E{XB, dry ? (bf16*)(ws + WS_DXB) : XB, dry ? (rss_t*)(ws + WS_DRSS) : rss_mid};
                  pg8::gemm_phase<pg8::EpiResid, pg8::StaticOrder, true, true, false>(ring, g, S, E, hook); }
            PH_END(pb + 4)
        } else {
            const int a = l - 2;
            PH_BEGIN(pb + 0, 5)
                pg8::StaticOrder SO; SO.init(M, a ? 1024 : 2048, F.G, F.bid); pg8::Unit u0{}; const bool hasu = SO.next(0, u0);
                auto hook = [&]() { RS_LOAD(rss_in); { SgArgs S{}; S.A = XSB; S.lda = 1024; S.Bt = (const bf16*)(ws + WS_WQKV) + (size_t)(a ? 2048 : 0) * 1024; S.K = 1024; S.nunits = a ? 32 : 64; S.rss_in = rsss_in;
                  S.fout = (float*)(ws + WS_QS); S.sk = F.out + O_SK; S.sv = F.out + O_SV; if (!dry) sgemm_units<SG_QKV, 1024>(F, S, 0); }
                  if (!dry && a == 0) { conv_shadow(F, args, l, 0, 0, 64); } RS_STORE(); __syncthreads(); };
                { const int N = a ? 1024 : 2048; pg8::Gemm g{XB, (const bf16*)(ws + WS_WQKV) + (size_t)(a ? 2048 : 0) * 1024, M, N, 1024}; g.wv = F.wave; pg8::StaticOrder S = SO;
                  pg8::EpiQkv E{rss_in, (bf16*)(ws + WS_Q), (bf16*)(ws + WS_KB), (bf16*)(ws + WS_VT), F.out + O_PK, F.out + O_PV, (float*)(ws + (dry ? WS_DKM : WS_KM))}; E.rsl = RS_TAB; E.rs_pm = hasu ? u0.pm : -1;
                  pg8::gemm_phase<pg8::EpiQkv, pg8::StaticOrder, true, true, false>(ring, g, S, E, hook); }
            PH_END(pb + 0)
            PH_BEGIN(pb + 1, 6) sel_phase(F, a, dry); if (lo > pb + 1 || hi <= pb + 2) satt_phase(F, args); PH_END(pb + 1)
            PH_BEGIN(pb + 2, 7) att1_phase(F, args, a, REPMASK == 0u && pb + 3 < hi, lo <= pb + 1); PH_END(pb + 2)
            PH_BEGIN(pb + 3, 8) att2_phase(F, REPMASK == 0u && lo <= pb + 2); PH_END(pb + 3)
            PH_BEGIN(pb + 4, 9)
                auto hook = [&]() { { SgArgs S{}; S.A = (const bf16*)(ws + WS_OSB); S.lda = 1024; S.Bt = (const bf16*)(ws + WS_WO) + (size_t)a * 1024 * 1024; S.K = 1024; S.nunits = 32;
                  S.xin = XS; S.xout = XS; S.xbout = XSB; S.rss_out = rsss_mid; if (!dry) sgemm_units<SG_RESID, 1024>(F, S, 0); }
                  if (!dry && a == 0) { conv_shadow(F, args, l, 1, 0, 32); } __syncthreads(); };
                { pg8::Gemm g{(const bf16*)(ws + WS_OB), (const bf16*)(ws + WS_WO) + (size_t)a * 1024 * 1024, M, 1024, 1024}; g.wv = F.wave; pg8::StaticOrder S; S.init(M, 1024, F.G, F.bid);
                  pg8::EpiResid E{XB, dry ? (bf16*)(ws + WS_DXB) : XB, dry ? (rss_t*)(ws + WS_DRSS) : rss_mid};
                  pg8::gemm_phase<pg8::EpiResid, pg8::StaticOrder, true, true, false>(ring, g, S, E, hook); }
            PH_END(pb + 4)
        }
        PH_BEGIN(pb + 5, 10)
            pg8::StaticOrder SO; SO.init(M, NF2, F.G, F.bid); pg8::Unit u0{}; const bool hasu = SO.next(0, u0);
            const int nfull_ = (64 * 22) / F.G; pg8::HalfOrder HS; HS.init(M, NF2, F.G, F.bid); HS.maxr = nfull_; pg8::Unit uh{}; const bool hasuh = (2 * (64 * 22 - nfull_ * F.G) <= F.G) && HS.next(0, uh);
            auto hook = [&]() { RS_LOAD(rss_mid); const rss_t rs_raw2_ = (hasuh && F.tid < 128) ? rss_mid[uh.pm * 256 + uh.rofs + F.tid] : (rss_t)0;
              { SgArgs S{}; S.A = XSB; S.lda = 1024; S.Bt = (const bf16*)(ws + WS_WFIN) + (size_t)l * NF2 * 1024; S.K = 1024; S.nunits = 88; S.rss_in = rsss_mid; S.bout = (bf16*)(ws + WS_ACTS);
              sgemm_units<SG_FFNIN, 1024>(F, S, 128); }
              if (!dry) { conv_shadow(F, args, l, 2, 128, 88); } RS_STORE(); if (hasuh && F.tid < 128) (RS_TAB + 256)[F.tid] = pg8::rs_of(rs_raw2_); __syncthreads(); };
            { pg8::Gemm g{XB, (const bf16*)(ws + WS_WFIN) + (size_t)l * NF2 * 1024, M, NF2, 1024}; g.wv = F.wave;
              const int nfull = (64 * 22) / F.G;
              { pg8::RoundsOrder S; S.init(M, NF2, F.G, F.bid); S.maxr = nfull; pg8::EpiFfnIn<false> E{rss_mid, (bf16*)(ws + WS_ACT)}; E.rsl = RS_TAB; E.rs_pm = hasu ? u0.pm : -1;
                pg8::gemm_phase<pg8::EpiFfnIn<false>, pg8::RoundsOrder, true, true, false>(ring, g, S, E, hook); }
              if (2 * (64 * 22 - nfull * F.G) <= F.G) { pg8::HalfOrder S; S.init(M, NF2, F.G, F.bid); S.maxr = nfull; pg8::EpiFfnIn<true> E{rss_mid, (bf16*)(ws + WS_ACT)}; E.rsl = RS_TAB + 256 - uh.rofs; E.rs_pm = hasuh ? uh.pm : -1;
                pg8::gemm_phase<pg8::EpiFfnIn<true>, pg8::HalfOrder, true, true, true>(ring, g, S, E); }
              else { pg8::HalfOrder S0; (void)S0; struct Rest : pg8::StaticOrder { int r0; __device__ bool next(int i, pg8::Unit& u) const { return pg8::StaticOrder::next(i + r0, u); } } S; S.init(M, NF2, F.G, F.bid); S.r0 = nfull; pg8::EpiFfnIn<false> E{rss_mid, (bf16*)(ws + WS_ACT)};
                pg8::gemm_phase<pg8::EpiFfnIn<false>, Rest, true, true>(ring, g, S, E); } }
        PH_END(pb + 5)
        PH_BEGIN(pb + 6, 11)
            const bool fuse_fin = (l == 3) && F.G == 256 && hi > 29 && !dry && REPMASK == 0u;
            unsigned* fctl = (unsigned*)(ws + WS_CTL);
            auto hook = [&]() { { SgArgs S{}; S.A = (const bf16*)(ws + WS_ACTS); S.lda = FF; S.Bt = (const bf16*)(ws + WS_WFOUT) + (size_t)l * 1024 * FF; S.K = FF; S.nunits = 32;
              S.xin = XS; S.xout = XS; S.xbout = XSB; S.rss_out = rsss_out;
              if (fuse_fin) { S.fcnt = fctl + CW_FINS; S.gfin = (const float*)args.in[24]; S.fout = F.out + O_YS; sgemm_units<SG_RESFIN, FF>(F, S, 0); }
              else if (!dry) sgemm_units<SG_RESID, FF>(F, S, 0); }
              if (!dry) { conv_shadow(F, args, l, 3, 0, 32); } __syncthreads(); };
            { pg8::Gemm g{(const bf16*)(ws + WS_ACT), (const bf16*)(ws + WS_WFOUT) + (size_t)l * 1024 * FF, M, 1024, FF}; g.wv = F.wave; pg8::StaticOrder S; S.init(M, 1024, F.G, F.bid);
              if (fuse_fin) { pg8::EpiResidFinal E{XB, rss_out, fctl + CW_FINP, (const float*)args.in[24], F.out + O_YP};
                pg8::gemm_phase<pg8::EpiResidFinal, pg8::StaticOrder, false, true, false>(ring, g, S, E, hook); }
              else { pg8::EpiResid E{XB, dry ? (bf16*)(ws + WS_DXB) : XB, dry ? (rss_t*)(ws + WS_DRSS) : rss_out};
                pg8::gemm_phase<pg8::EpiResid, pg8::StaticOrder, true, true, false>(ring, g, S, E, hook); } }
        PH_END(pb + 6)
    }
    if (!(gridDim.x == 256 && lo <= 28 && hi > 29 && REPMASK == 0u)) { const int l = 0; PH_BEGIN(29, 12) final_phase(F, args); PH_END(29) }
#undef PH_BEGIN
#undef PH_END
#undef lo
#undef hi
#undef hi_bar
}

extern "C" void kernel_launch(void* const* d_in, const int* in_sizes, int n_in, void* d_out, int out_size, void* d_ws, size_t ws_size, hipStream_t stream) {
    static int grid = 0;
    if (grid == 0) {
        if (n_in != 25 || out_size != (int)O_END || ws_size < WS_NEED) { fprintf(stderr, "kernel_launch: unexpected shapes (n_in %d, out %d, ws %zu); nothing launched\n", n_in, out_size, ws_size); grid = -1; return; }
        int dev = 0, cus = 0, per_cu = 0;
        if (hipGetDevice(&dev) != hipSuccess || hipDeviceGetAttribute(&cus, hipDeviceAttributeMultiprocessorCount, dev) != hipSuccess) { fprintf(stderr, "kernel_launch: device query failed\n"); grid = -1; return; }
        if (hipFuncSetAttribute((const void*)yoco_fwd, hipFuncAttributeMaxDynamicSharedMemorySize, LDS_BYTES) != hipSuccess) { fprintf(stderr, "kernel_launch: hipFuncSetAttribute failed\n"); grid = -1; return; }
        if (hipOccupancyMaxActiveBlocksPerMultiprocessor(&per_cu, (const void*)yoco_fwd, NTHR, LDS_BYTES) != hipSuccess || per_cu < 1) { fprintf(stderr, "kernel_launch: occupancy query says %d blocks per CU\n", per_cu); per_cu = 1; }
        (void)hipGetLastError();
        grid = cus;
    }
    if (grid < 0) return;
    (void)in_sizes;
    if (hipMemsetAsync(d_ws, 0, ZERO_BYTES, stream) != hipSuccess) { fprintf(stderr, "kernel_launch: memset failed\n"); return; }
    Args a; memset(&a, 0, sizeof(a));
    for (int i = 0; i < 25; ++i) a.in[i] = d_in[i];
    a.out = (float*)d_out; a.ws = (unsigned char*)d_ws;
#if MK_MULTI
    for (int p = 0; p < NPH; ++p) {
        if (p >= 1 && p <= 28) { const int l = (p - 1) / 7, k = (p - 1) % 7; if (l < 2 && (k == 2 || k == 3)) continue; }
        a.ph_lo = p; a.ph_hi = p + 1;
        hipLaunchKernelGGL(yoco_fwd, dim3(grid), dim3(NTHR), LDS_BYTES, stream, a);
    }
#else
    a.ph_lo = 0; a.ph_hi = NPH;
    hipLaunchKernelGGL(yoco_fwd, dim3(grid), dim3(NTHR), LDS_BYTES, stream, a);
#endif
    const hipError_t le = hipPeekAtLastError();
    if (le != hipSuccess) fprintf(stderr, "kernel_launch: launch failed: %s\n", hipGetErrorName(le));
}
```
